# Optimizing an MI355X kernel written in HIP

```python
import math
import jax, jax.numpy as jnp
from jax import lax
import numpy as np

D_MODEL = 2048
BATCH = 1
SEQ = 16384
DEPTH = 4

HEAD_DIM = 128
N_MIX_HEADS = 8
GDN_QK_HEADS = 4
MIX_WIDTH = N_MIX_HEADS * HEAD_DIM
GDN_QK_WIDTH = GDN_QK_HEADS * HEAD_DIM
N_MEM = 256
MEM_HEADS = 4
MEM_WIDTH = MEM_HEADS * HEAD_DIM
CONV_WIDTH = 4
GDN_CHUNK = 64
SB_BLOCK = 128
SB_SUB = 32
PEER_HEADS = 4
PEER_NKEYS = 128
PEER_EXPERTS = PEER_NKEYS * PEER_NKEYS
PEER_QDIM = 256
PEER_HALF = PEER_QDIM // 2
PEER_HALF_TOPK = 16
PEER_TOPK = 8
PEER_BLOCK = 128
N_MIXERS = 2
N_GDN_LAYERS = (DEPTH + 1) // 2
N_SB_LAYERS = DEPTH // 2
DN_ALPHA = (2.0 * DEPTH) ** 0.25
DN_BETA = (8.0 * DEPTH) ** -0.25
LN_EPS = 1e-5
RMS_EPS = 1e-6
GDN_CONV_CH = 2 * GDN_QK_WIDTH + MIX_WIDTH
GDN_IN = 2 * GDN_QK_WIDTH + 2 * MIX_WIDTH + 2 * N_MIX_HEADS + MEM_WIDTH
SB_IN = 3 * MIX_WIDTH + MEM_WIDTH

kernel_name = 'hybrid_gdn_stickbreak_peer_deepnorm'


def layer_norm(x, g, b):
    xf = x.astype(jnp.float32)
    mu = jnp.mean(xf, -1, keepdims=True)
    var = jnp.mean(jnp.square(xf - mu), -1, keepdims=True)
    y = (xf - mu) * lax.rsqrt(var + LN_EPS) * g.astype(jnp.float32) + b.astype(jnp.float32)
    return y.astype(x.dtype)


def rms_norm(x, g):
    xf = x.astype(jnp.float32)
    return xf * lax.rsqrt(jnp.mean(xf * xf, -1, keepdims=True) + RMS_EPS) * g.astype(jnp.float32)


def l2norm(x):
    xf = x.astype(jnp.float32)
    return xf * lax.rsqrt(jnp.sum(xf * xf, -1, keepdims=True) + RMS_EPS)


def causal_conv(x, w):
    return lax.conv_general_dilated(x, w[:, None, :], window_strides=(1,), padding=[(CONV_WIDTH - 1, 0)],
                                    dimension_numbers=('NWC', 'WIO', 'NWC'), feature_group_count=x.shape[-1])


def gated_deltanet(q, k, v, z, b, a, conv_w, a_log, dt_bias, onorm_g):
    B_, S_, _ = q.shape
    f32 = jnp.float32
    C = GDN_CHUNK
    qkv = jax.nn.silu(causal_conv(jnp.concatenate([q, k, v], -1), conv_w))
    q, k, v = jnp.split(qkv, [GDN_QK_WIDTH, 2 * GDN_QK_WIDTH], axis=-1)
    rep = N_MIX_HEADS // GDN_QK_HEADS
    q = jnp.repeat(l2norm(q.reshape(B_, S_, GDN_QK_HEADS, HEAD_DIM)), rep, axis=2) * (HEAD_DIM ** -0.5)
    k = jnp.repeat(l2norm(k.reshape(B_, S_, GDN_QK_HEADS, HEAD_DIM)), rep, axis=2)
    v = v.reshape(B_, S_, N_MIX_HEADS, HEAD_DIM).astype(f32)
    beta = jax.nn.sigmoid(b.astype(f32))
    g = -jnp.exp(a_log.astype(f32)) * jax.nn.softplus(a.astype(f32) + dt_bias.astype(f32))
    n = S_ // C

    def chunks(t):
        return jnp.moveaxis(t.reshape(B_, n, C, *t.shape[2:]), 3, 1)

    qc, kc, vc, bc, gc = chunks(q), chunks(k), chunks(v), chunks(beta), chunks(g)
    gcum = jnp.cumsum(gc, axis=-1)
    glast = gcum[..., -1]
    causal = jnp.tril(jnp.ones((C, C), bool))
    strict = jnp.tril(jnp.ones((C, C), bool), -1)
    decay = jnp.exp(jnp.where(causal, gcum[..., :, None] - gcum[..., None, :], -jnp.inf))
    kb = kc * bc[..., None]
    m_low = jnp.where(strict, jnp.einsum('bhncd,bhnsd->bhncs', kb, kc) * decay, 0.0)
    eye = jnp.eye(C, dtype=f32)
    rhs = jnp.concatenate([vc * bc[..., None], kb * jnp.exp(gcum)[..., None]], -1)
    sol = lax.linalg.triangular_solve(eye + m_low, rhs, left_side=True, lower=True, unit_diagonal=True)
    u, w = sol[..., :HEAD_DIM], sol[..., HEAD_DIM:]
    aqk = jnp.einsum('bhncd,bhnsd->bhncs', qc, kc) * decay
    qg = qc * jnp.exp(gcum)[..., None]
    kd = kc * jnp.exp(glast[..., None] - gcum)[..., None]

    def step(state, inp):
        qg_n, kd_n, u_n, w_n, aqk_n, gl_n = inp
        v_new = u_n - jnp.einsum('bhck,bhkv->bhcv', w_n, state)
        o = jnp.einsum('bhck,bhkv->bhcv', qg_n, state) + jnp.einsum('bhcs,bhsv->bhcv', aqk_n, v_new)
        state = state * jnp.exp(gl_n)[..., None, None] + jnp.einsum('bhck,bhcv->bhkv', kd_n, v_new)
        return state, o

    xs = tuple(jnp.moveaxis(t, 2, 0) for t in (qg, kd, u, w, aqk, glast))
    s0 = jnp.zeros((B_, N_MIX_HEADS, HEAD_DIM, HEAD_DIM), f32)
    _, o = lax.scan(step, s0, xs)
    o = jnp.moveaxis(o, 0, 2).transpose(0, 2, 3, 1, 4).reshape(B_, S_, N_MIX_HEADS, HEAD_DIM)
    o = rms_norm(o, onorm_g) * jax.nn.silu(z.reshape(B_, S_, N_MIX_HEADS, HEAD_DIM).astype(f32))
    return o.reshape(B_, S_, MIX_WIDTH).astype(z.dtype)


def stick_breaking(q, k, v):
    B_, S_, _ = q.shape
    f32 = jnp.float32
    hi = lax.Precision.HIGHEST
    q = q.reshape(B_, S_, N_MIX_HEADS, HEAD_DIM).astype(f32) * (HEAD_DIM ** -0.5)
    k = k.reshape(B_, S_, N_MIX_HEADS, HEAD_DIM).astype(f32)
    vf = v.reshape(B_, S_, N_MIX_HEADS, HEAD_DIM).astype(f32)
    nb = S_ // SB_BLOCK
    tri_sub = (jnp.arange(SB_SUB)[:, None] > jnp.arange(SB_SUB)[None, :]).astype(f32)
    outs = []
    for blk in range(nb):
        L = (blk + 1) * SB_BLOCK
        n_sub = L // SB_SUB
        q_blk = q[:, blk * SB_BLOCK:(blk + 1) * SB_BLOCK]
        zs = jnp.einsum('bqhd,bshd->bhqs', q_blk, k[:, :L])
        q_pos = blk * SB_BLOCK + jnp.arange(SB_BLOCK)
        mask = jnp.arange(L)[None, :] < q_pos[:, None]
        zs = jnp.where(mask, zs, -jnp.inf)
        log_not = jax.nn.log_sigmoid(-zs)
        ln_sub = log_not.reshape(B_, N_MIX_HEADS, SB_BLOCK, n_sub, SB_SUB)
        within = jnp.einsum('bhqnj,js->bhqns', ln_sub, tri_sub, precision=hi)
        tri_blk = (jnp.arange(n_sub)[:, None] > jnp.arange(n_sub)[None, :]).astype(f32)
        offs = jnp.einsum('bhqm,mn->bhqn', jnp.sum(ln_sub, -1), tri_blk, precision=hi)
        later = (within + offs[..., None]).reshape(B_, N_MIX_HEADS, SB_BLOCK, L)
        att = jnp.exp(log_not + zs + later)
        outs.append(jnp.einsum('bhqs,bshd->bqhd', att, vf[:, :L]))
    o = jnp.concatenate(outs, axis=1)
    return o.reshape(B_, S_, MIX_WIDTH).astype(v.dtype)


def memory_attention(qm, mem, w_kv):
    B_, S_, _ = qm.shape
    km, vm = jnp.split(mem @ w_kv, 2, axis=-1)
    q = qm.reshape(B_, S_, MEM_HEADS, HEAD_DIM)
    km = km.reshape(B_, N_MEM, MEM_HEADS, HEAD_DIM)
    vm = vm.reshape(B_, N_MEM, MEM_HEADS, HEAD_DIM)
    s = jnp.einsum('bqhd,bmhd->bhqm', q, km).astype(jnp.float32) * (HEAD_DIM ** -0.5)
    p = jax.nn.softmax(s, axis=-1)
    o = jnp.einsum('bhqm,bmhd->bqhd', p.astype(vm.dtype), vm)
    return o.reshape(B_, S_, MEM_WIDTH)


def peer(x, w_q, sub_keys, u_tab, v_tab):
    B_, S_, D = x.shape
    f32 = jnp.float32
    T = B_ * S_
    xt = x.reshape(T, D)
    qry = (xt @ w_q).reshape(T, PEER_HEADS, 2, PEER_HALF).astype(f32)
    s = jnp.einsum('thpc,pnc->thpn', qry, sub_keys.astype(f32))
    sv, si = lax.top_k(s, PEER_HALF_TOPK)
    cand = (sv[:, :, 0, :, None] + sv[:, :, 1, None, :]).reshape(T, PEER_HEADS, PEER_HALF_TOPK * PEER_HALF_TOPK)
    cv, ci = lax.top_k(cand, PEER_TOPK)
    i1 = jnp.take_along_axis(si[:, :, 0], ci // PEER_HALF_TOPK, axis=-1)
    i2 = jnp.take_along_axis(si[:, :, 1], ci % PEER_HALF_TOPK, axis=-1)
    expert = (i1 * PEER_NKEYS + i2).reshape(T, PEER_HEADS * PEER_TOPK)
    gate = jax.nn.softmax(cv, axis=-1).reshape(T, PEER_HEADS * PEER_TOPK)
    nb = T // PEER_BLOCK

    def block(args):
        xb, eb, gb = args
        h = jnp.einsum('td,ted->te', xb, u_tab[eb])
        act = (jax.nn.gelu(h.astype(f32), approximate=False) * gb).astype(x.dtype)
        return jnp.einsum('te,ted->td', act, v_tab[eb])

    out = lax.map(block, (xt.reshape(nb, PEER_BLOCK, D), expert.reshape(nb, PEER_BLOCK, -1),
                          gate.reshape(nb, PEER_BLOCK, -1)))
    return out.reshape(B_, S_, D)


def setup_inputs(seed: int = 0) -> dict:
    key = jax.random.key(seed)
    ks = jax.random.split(key, 20)
    f32 = jnp.float32
    D = D_MODEL

    def nrm(k, shape, scale):
        return jax.random.normal(k, shape, f32) * scale

    x = nrm(ks[0], (BATCH, SEQ, D), 1.0)
    mem = nrm(ks[1], (BATCH, N_MEM, D), 1.0)
    v0 = 2 * GDN_QK_WIDTH
    gdn_scale = jnp.ones((GDN_IN,), f32).at[v0:v0 + MIX_WIDTH].set(DN_BETA)
    gdn_w_in = nrm(ks[2], (N_GDN_LAYERS, D, GDN_IN), D ** -0.5) * gdn_scale
    gdn_conv = nrm(ks[3], (N_GDN_LAYERS, CONV_WIDTH, GDN_CONV_CH), CONV_WIDTH ** -0.5)
    gdn_a_log = jnp.log(jax.random.uniform(ks[4], (N_GDN_LAYERS, N_MIX_HEADS), f32, 1.0, 16.0))
    dt = jnp.exp(jax.random.uniform(ks[5], (N_GDN_LAYERS, N_MIX_HEADS), f32, math.log(1e-3), math.log(1e-1)))
    gdn_dt_bias = dt + jnp.log(-jnp.expm1(-dt))
    gdn_onorm = 1.0 + nrm(ks[6], (N_GDN_LAYERS, HEAD_DIM), 0.02)
    sb_scale = jnp.ones((SB_IN,), f32).at[2 * MIX_WIDTH:3 * MIX_WIDTH].set(DN_BETA)
    sb_w_in = nrm(ks[7], (N_SB_LAYERS, D, SB_IN), D ** -0.5) * sb_scale
    mem_scale = jnp.ones((2 * MEM_WIDTH,), f32).at[MEM_WIDTH:].set(DN_BETA)
    mem_w_kv = nrm(ks[8], (DEPTH, D, 2 * MEM_WIDTH), D ** -0.5) * mem_scale
    w_out = nrm(ks[9], (DEPTH, MIX_WIDTH + MEM_WIDTH, D), (MIX_WIDTH + MEM_WIDTH) ** -0.5 * DN_BETA)
    ln_mix_g = 1.0 + nrm(ks[10], (DEPTH, D), 0.02)
    ln_mix_b = nrm(ks[11], (DEPTH, D), 0.02)
    peer_w_q = nrm(ks[12], (DEPTH, D, PEER_HEADS * PEER_QDIM), D ** -0.5)
    peer_keys = nrm(ks[13], (DEPTH, 2, PEER_NKEYS, PEER_HALF), PEER_HALF ** -0.5)
    peer_u = nrm(ks[14], (DEPTH, PEER_EXPERTS, D), D ** -0.5)
    peer_v = nrm(ks[15], (DEPTH, PEER_EXPERTS, D), DN_BETA * PEER_HEADS ** -0.5)
    ln_ffn_g = 1.0 + nrm(ks[16], (DEPTH, D), 0.02)
    ln_ffn_b = nrm(ks[17], (DEPTH, D), 0.02)
    return {'x': x, 'mem': mem, 'gdn_w_in': gdn_w_in, 'gdn_conv': gdn_conv, 'gdn_a_log': gdn_a_log,
            'gdn_dt_bias': gdn_dt_bias, 'gdn_onorm': gdn_onorm, 'sb_w_in': sb_w_in, 'mem_w_kv': mem_w_kv,
            'w_out': w_out, 'ln_mix_g': ln_mix_g, 'ln_mix_b': ln_mix_b, 'peer_w_q': peer_w_q,
            'peer_keys': peer_keys, 'peer_u': peer_u, 'peer_v': peer_v, 'ln_ffn_g': ln_ffn_g, 'ln_ffn_b': ln_ffn_b}


def reference(x, mem, gdn_w_in, gdn_conv, gdn_a_log, gdn_dt_bias, gdn_onorm, sb_w_in, mem_w_kv, w_out,
              ln_mix_g, ln_mix_b, peer_w_q, peer_keys, peer_u, peer_v, ln_ffn_g, ln_ffn_b):
    q_w, v_w = GDN_QK_WIDTH, MIX_WIDTH
    gdn_splits = [q_w, 2 * q_w, 2 * q_w + v_w, 2 * q_w + 2 * v_w, 2 * q_w + 2 * v_w + N_MIX_HEADS,
                  2 * q_w + 2 * v_w + 2 * N_MIX_HEADS]
    sb_splits = [MIX_WIDTH, 2 * MIX_WIDTH, 3 * MIX_WIDTH]
    for i in range(DEPTH):
        li = i // N_MIXERS
        if i % N_MIXERS == 0:
            p = x @ gdn_w_in[li]
            q, k, v, z, b, a, qm = jnp.split(p, gdn_splits, axis=-1)
            mix = gated_deltanet(q, k, v, z, b, a, gdn_conv[li], gdn_a_log[li], gdn_dt_bias[li], gdn_onorm[li])
        else:
            p = x @ sb_w_in[li]
            q, k, v, qm = jnp.split(p, sb_splits, axis=-1)
            mix = stick_breaking(q, k, v)
        mem_o = memory_attention(qm, mem, mem_w_kv[i])
        y = jnp.concatenate([mix, mem_o], axis=-1) @ w_out[i]
        x = layer_norm(DN_ALPHA * x + y, ln_mix_g[i], ln_mix_b[i])
        f = peer(x, peer_w_q[i], peer_keys[i], peer_u[i], peer_v[i])
        x = layer_norm(DN_ALPHA * x + f, ln_ffn_g[i], ln_ffn_b[i])
    return x
```

```cpp
#include <hip/hip_runtime.h>
#include <stdio.h>
#include <stdint.h>

#define LAS __attribute__((address_space(3)))
typedef unsigned short bf16_t;
typedef short bf16x8 __attribute__((ext_vector_type(8)));
typedef short s16x4 __attribute__((ext_vector_type(4)));
typedef float f32x2 __attribute__((ext_vector_type(2)));
typedef float f32x4 __attribute__((ext_vector_type(4)));
typedef float f32x16 __attribute__((ext_vector_type(16)));
typedef unsigned u32x2 __attribute__((ext_vector_type(2)));
typedef unsigned u32x4 __attribute__((ext_vector_type(4)));
typedef __bf16 bfx2 __attribute__((ext_vector_type(2)));
#define DI __device__ __forceinline__

DI unsigned pk2(float lo, float hi) { f32x2 v = {lo, hi}; return __builtin_bit_cast(unsigned, __builtin_convertvector(v, bfx2)); }
DI bf16_t f2bf(float f) { return (bf16_t)(pk2(f, 0.f) & 0xffffu); }
DI float bf_lo(unsigned w) { return __uint_as_float(w << 16); }
DI float bf_hi(unsigned w) { return __uint_as_float(w & 0xffff0000u); }
DI float bf2f(bf16_t b) { return __uint_as_float(((unsigned)b) << 16); }
DI float wave_sum(float v) {
#pragma unroll
    for (int o = 32; o >= 1; o >>= 1) v += __shfl_xor(v, o);
    return v; }
DI float fast_exp(float x) { return __builtin_amdgcn_exp2f(x * 1.44269504088896f); }
DI float sigmoidf_(float x) { return __builtin_amdgcn_rcpf(1.0f + fast_exp(-x)); }
DI float siluf_(float x) { return x * sigmoidf_(x); }
DI bf16x8 pack8(float a0, float a1, float a2, float a3, float a4, float a5, float a6, float a7) {
    u32x4 p; p.x = pk2(a0, a1); p.y = pk2(a2, a3); p.z = pk2(a4, a5); p.w = pk2(a6, a7); return __builtin_bit_cast(bf16x8, p); }
#define MFMA32(a, b, c) __builtin_amdgcn_mfma_f32_32x32x16_bf16((a), (b), (c), 0, 0, 0)
#define MFMA16(a, b, c) __builtin_amdgcn_mfma_f32_16x16x32_bf16((a), (b), (c), 0, 0, 0)

constexpr int M_TOK = 16384, DM = 2048, DEPTH = 4, NMEM = 256, HD = 128;
constexpr int LDP = 3840;
constexpr int GDN_NP = 3840, SB_NP = 2560;
constexpr int MIXW = 1536;
constexpr float DN_ALPHA = 1.681792830507429f;
constexpr float LN_EPS = 1e-5f, RMS_EPS = 1e-6f;
constexpr int NTHREADS = 512;
constexpr int LDS_BYTES = 160 * 1024;
constexpr int LDS_CTL = LDS_BYTES - 256;

constexpr int GC_Q = 0, GC_K = 512, GC_V = 1024, GC_Z = 2048, GC_QM = 3072, GC_B = 3584, GC_A = 3592;
constexpr int SC_Q = 0, SC_K = 1024, SC_QM = 2048;

constexpr int REC_W = 0, REC_QG = 16384, REC_KDT = 32768, REC_AQK = 49152, REC_U = 57344, REC_BYTES = 73728;

constexpr size_t al256(size_t x) { return (x + 255) & ~(size_t)255; }
constexpr size_t WS_CTL = 0;
constexpr size_t WS_CTL_BYTES = 65536;
constexpr size_t WS_XB = WS_CTL + WS_CTL_BYTES;
constexpr size_t WS_F0 = WS_XB + (size_t)M_TOK * DM * 2;
constexpr size_t WS_F1 = WS_F0 + (size_t)M_TOK * DM * 4;
constexpr size_t WS_F2 = WS_F1 + (size_t)M_TOK * DM * 4;
constexpr size_t WS_P = WS_F2 + (size_t)M_TOK * DM * 4;
constexpr size_t WS_VT = WS_P + (size_t)M_TOK * LDP * 2;
constexpr size_t WS_REC = WS_VT + (size_t)1024 * M_TOK * 2;
constexpr size_t WS_GAM = WS_REC + (size_t)2048 * REC_BYTES;
constexpr size_t WS_OG = WS_GAM + 8192;
constexpr size_t WS_MIX = WS_OG + (size_t)M_TOK * 1024 * 4;
constexpr size_t WS_SC = WS_MIX + (size_t)M_TOK * MIXW * 2;
constexpr size_t WS_MEMB = WS_SC + (size_t)M_TOK * 1024 * 4;
constexpr size_t WS_KM = WS_MEMB + (size_t)NMEM * DM * 2;
constexpr size_t WS_VMT = WS_KM + (size_t)NMEM * 2048 * 2;
constexpr size_t WS_WG = WS_VMT + (size_t)2048 * NMEM * 2;
constexpr size_t WS_WSB = WS_WG + (size_t)2 * GDN_NP * DM * 2;
constexpr size_t WS_WSBV = WS_WSB + (size_t)2 * SB_NP * DM * 2;
constexpr size_t WS_WK = WS_WSBV + (size_t)2 * 1024 * DM * 2;
constexpr size_t WS_WV = WS_WK + (size_t)2048 * DM * 2;
constexpr size_t WS_WO = WS_WV + (size_t)2048 * DM * 2;
constexpr size_t WS_WP = WS_WO + (size_t)4 * DM * MIXW * 2;
constexpr size_t WS_UT = WS_WP + (size_t)4 * 1024 * DM * 2;
constexpr size_t WS_VTAB = WS_UT + (size_t)4 * 16384 * DM * 2;
constexpr size_t WS_END = WS_VTAB + (size_t)4 * 16384 * DM * 2;

struct Args {
    const float* x; const float* mem; const float* gdn_w_in; const float* gdn_conv; const float* gdn_a_log; const float* gdn_dt_bias; const float* gdn_onorm;
    const float* sb_w_in; const float* mem_w_kv; const float* w_out; const float* ln_mix_g; const float* ln_mix_b; const float* peer_w_q; const float* peer_keys;
    const float* peer_u; const float* peer_v; const float* ln_ffn_g; const float* ln_ffn_b;
    float* out; unsigned char* ws; int ph_lo, ph_hi;
};
namespace pg8 {
#define PG8_LAS __attribute__((address_space(3)))
typedef unsigned short bf16_t;
typedef short bf16x8 __attribute__((ext_vector_type(8)));
typedef float f32x4 __attribute__((ext_vector_type(4)));
typedef unsigned u32x4 __attribute__((ext_vector_type(4)));
constexpr int BM = 256, BK = 64, HALF = 128, HTB = HALF * BK * 2  , STAGE_BYTES = 8 * HTB, NXCD = 8, WGM = 8;

__host__ __device__ __forceinline__ int lds_byte(int r, int c) { const int st = (r >> 4) * 2 + (c >> 5), rr = r & 15, cc = c & 31, ob = rr * 64 + cc * 2; return st * 1024 + (ob ^ (((ob >> 9) & 1) << 5)); }
__host__ __device__ __forceinline__ void stage_rc(int b, int& R, int& C) { const int st = b / 1024, sb = b % 1024, swz = sb ^ (((sb >> 9) & 1) << 5); R = (st >> 1) * 16 + swz / 64; C = (st & 1) * 32 + (swz % 64) / 2; }
__host__ __device__ __forceinline__ int perm32(int rho) { const int n = rho >> 4, i = rho & 15; return 8 * (i >> 2) + 4 * n + (i & 3); }

struct Unit { int pm, pn, job; };
struct Gemm { const bf16_t* A; const bf16_t* Bt; int M, N, K; };

struct StaticOrder {
    int nM, nN, nwg, G, c;
    __host__ __device__ void init(int M, int N, int G_, int c_) { nM = M / BM; nN = N / BM; nwg = nM * nN; G = G_; c = c_; }
    __host__ __device__ bool next(int i, Unit& u) const {
        const long L = (long)i * G + c; if (L >= nwg) return false;
        int wgid = (int)L; { const int q = nwg / NXCD, r = nwg % NXCD, xcd = wgid % NXCD, off = wgid / NXCD; wgid = (xcd < r ? xcd * (q + 1) : r * (q + 1) + (xcd - r) * q) + off; }
        const int nig = WGM * nN, gid = wgid / nig, fm = gid * WGM, gsz = (nM - fm) < WGM ? (nM - fm) : WGM;
        u.pm = fm + ((wgid % nig) % gsz); u.pn = (wgid % nig) / gsz; u.job = 0; return true;
    }
    __device__ __forceinline__ const char* ptrA(const Gemm& g, const Unit&) const { return (const char*)g.A; }
    __device__ __forceinline__ const char* ptrB(const Gemm& g, const Unit&) const { return (const char*)g.Bt; }
    __device__ __forceinline__ void a_ready(const Unit&) const {}
    __device__ __forceinline__ void done(const Unit&) const {}
};
struct EpiF32 {
    static constexpr bool PERM = false, AFTER_DRAIN = false;
    float* C; int ldc;
    __device__ __forceinline__ void operator()(const f32x4 (&acc)[2][2][4][2], const Unit& u, int wr, int wc, int fr, int fq) const {
        const int row0 = u.pm * BM + wr * 64 + fr, col0 = u.pn * BM + wc * 32 + 4 * fq;
#pragma unroll
        for (int ai = 0; ai < 2; ++ai)
#pragma unroll
            for (int m = 0; m < 4; ++m) { float* rowp = C + (size_t)(row0 + ai * HALF + m * 16) * ldc + col0;
#pragma unroll
                for (int bj = 0; bj < 2; ++bj)
#pragma unroll
                    for (int n = 0; n < 2; ++n) *(f32x4*)(rowp + bj * HALF + n * 16) = acc[ai][bj][m][n]; }
    }
};
struct EpiResid {
    static constexpr bool PERM = false, AFTER_DRAIN = false;
    const float* X; float* T; int ldc; float alpha;
    __device__ __forceinline__ void operator()(const f32x4 (&acc)[2][2][4][2], const Unit& u, int wr, int wc, int fr, int fq) const {
        const int row0 = u.pm * BM + wr * 64 + fr, col0 = u.pn * BM + wc * 32 + 4 * fq;
#pragma unroll
        for (int ai = 0; ai < 2; ++ai)
#pragma unroll
            for (int m = 0; m < 4; ++m) { const size_t off = (size_t)(row0 + ai * HALF + m * 16) * ldc + col0;
                f32x4 xv[2][2];
#pragma unroll
                for (int bj = 0; bj < 2; ++bj)
#pragma unroll
                    for (int n = 0; n < 2; ++n) xv[bj][n] = *(const f32x4*)(X + off + bj * HALF + n * 16);
#pragma unroll
                for (int bj = 0; bj < 2; ++bj)
#pragma unroll
                    for (int n = 0; n < 2; ++n) *(f32x4*)(T + off + bj * HALF + n * 16) = xv[bj][n] * alpha + acc[ai][bj][m][n];
                asm volatile("" ::: "memory"); }
    }
};
struct EpiBf16 {
    static constexpr bool PERM = true, AFTER_DRAIN = false;
    bf16_t* O; int ldc;
    __device__ __forceinline__ void operator()(const f32x4 (&acc)[2][2][4][2], const Unit& u, int wr, int wc, int fr, int fq) const {
        const int row0 = u.pm * BM + wr * 64 + fr, col0 = u.pn * BM + wc * 32 + 8 * fq;
#pragma unroll
        for (int ai = 0; ai < 2; ++ai)
#pragma unroll
            for (int m = 0; m < 4; ++m) { bf16_t* rowp = O + (size_t)(row0 + ai * HALF + m * 16) * ldc + col0;
#pragma unroll
                for (int bj = 0; bj < 2; ++bj) { const f32x4 v0 = acc[ai][bj][m][0], v1 = acc[ai][bj][m][1];
                    u32x4 w; w.x = ::pk2(v0[0], v0[1]); w.y = ::pk2(v0[2], v0[3]); w.z = ::pk2(v1[0], v1[1]); w.w = ::pk2(v1[2], v1[3]);
                    *(u32x4*)(rowp + bj * HALF) = w; } }
    }
};

struct Job { const bf16_t* A; const bf16_t* Bt; bf16_t* O; int M, N, ldc; };
struct MultiOrder {
    Job j[4]; int nj, G, c;
    __device__ __forceinline__ bool next(int i, Unit& u) const {
        long L = (long)i * G + c; int job = -1, M = 0, N = 0;
#pragma unroll
        for (int k = 0; k < 4; ++k) { if (job < 0 && k < nj) { const int n = (j[k].M / BM) * (j[k].N / BM); if (L < n) { job = k; M = j[k].M; N = j[k].N; } else L -= n; } }
        if (job < 0) return false;
        const int nM = M / BM, nN = N / BM, nwg = nM * nN;
        int wgid = (int)L; { const int q = nwg / NXCD, r = nwg % NXCD, xcd = wgid % NXCD, off = wgid / NXCD; wgid = (xcd < r ? xcd * (q + 1) : r * (q + 1) + (xcd - r) * q) + off; }
        const int nig = WGM * nN, gid = wgid / nig, fm = gid * WGM, gsz = (nM - fm) < WGM ? (nM - fm) : WGM;
        u.pm = fm + ((wgid % nig) % gsz); u.pn = (wgid % nig) / gsz; u.job = job; return true;
    }
    __device__ __forceinline__ const char* ptrA(const Gemm&, const Unit& u) const { return (const char*)(u.job == 0 ? j[0].A : u.job == 1 ? j[1].A : u.job == 2 ? j[2].A : j[3].A); }
    __device__ __forceinline__ const char* ptrB(const Gemm&, const Unit& u) const { return (const char*)(u.job == 0 ? j[0].Bt : u.job == 1 ? j[1].Bt : u.job == 2 ? j[2].Bt : j[3].Bt); }
    __device__ __forceinline__ void a_ready(const Unit&) const {}
    __device__ __forceinline__ void done(const Unit&) const {}
};
struct EpiBf16Multi {
    static constexpr bool PERM = true, AFTER_DRAIN = false;
    bf16_t* O0; bf16_t* O1; bf16_t* O2; bf16_t* O3; int l0, l1, l2, l3;
    __device__ __forceinline__ void operator()(const f32x4 (&acc)[2][2][4][2], const Unit& u, int wr, int wc, int fr, int fq) const {
        bf16_t* O = u.job == 0 ? O0 : u.job == 1 ? O1 : u.job == 2 ? O2 : O3; const int ldc = u.job == 0 ? l0 : u.job == 1 ? l1 : u.job == 2 ? l2 : l3;
        const int row0 = u.pm * BM + wr * 64 + fr, col0 = u.pn * BM + wc * 32 + 8 * fq;
#pragma unroll
        for (int ai = 0; ai < 2; ++ai)
#pragma unroll
            for (int m = 0; m < 4; ++m) { bf16_t* rowp = O + (size_t)(row0 + ai * HALF + m * 16) * ldc + col0;
#pragma unroll
                for (int bj = 0; bj < 2; ++bj) { const f32x4 v0 = acc[ai][bj][m][0], v1 = acc[ai][bj][m][1];
                    u32x4 w; w.x = ::pk2(v0[0], v0[1]); w.y = ::pk2(v0[2], v0[3]); w.z = ::pk2(v1[0], v1[1]); w.w = ::pk2(v1[2], v1[3]);
                    *(u32x4*)(rowp + bj * HALF) = w; } }
    }
};
template <class Epi, class Sched, bool STAMP = false>
__device__ __forceinline__ void gemm_phase(PG8_LAS unsigned char* lds, const Gemm g, const Sched& S, const Epi& E, unsigned long long* stamps) {
    int tid_ = threadIdx.x; asm volatile("" : "+v"(tid_));
    const int tid = tid_, wid = __builtin_amdgcn_readfirstlane(tid >> 6), lane = tid & 63, wr = wid >> 2, wc = wid & 3, fr = lane & 15, fq = lane >> 4;
    const int K = g.K, nt = K / BK;
    int ts_lo = 0, ts_hi = 0, nts = 0; const unsigned long long rt_entry = STAMP ? (unsigned long long)wall_clock64() : 0ull;
#define PG8_STAMP() do { if (STAMP && wid == 0 && nts < 64) { const unsigned long long _c = (unsigned long long)clock64(); \
        ts_lo = (lane == nts) ? (int)(unsigned)_c : ts_lo; ts_hi = (lane == nts) ? (int)(unsigned)(_c >> 32) : ts_hi; ++nts; } } while (0)
    PG8_STAMP();
    unsigned voffA[2], voffB[2];
#pragma unroll
    for (int i = 0; i < 2; ++i) { int R, C; stage_rc(tid * 16 + i * 8192, R, C); const int Rb = Epi::PERM ? ((R & ~31) + perm32(R & 31)) : R;
        voffA[i] = (unsigned)(R * K + C) * 2u; voffB[i] = (unsigned)(Rb * K + C) * 2u; }
    const size_t kstep = (size_t)(BK * 2);
    const size_t hstep = (size_t)HALF * K * 2;
    const size_t tstep = 2 * hstep;
    const unsigned ldsw = (unsigned)wid * 1024u;
    const int aoff = lds_byte(wr * 64 + fr, fq * 8), boff = lds_byte(wc * 32 + fr, fq * 8);
#define PG8_SA(b, h) (((b) * 2 + (h)) * HTB)
#define PG8_SB(b, h) ((4 + (b) * 2 + (h)) * HTB)
#define PG8_STAGE(bufoff, gbase, voff) do { _Pragma("unroll") for (int _i = 0; _i < 2; ++_i) \
        __builtin_amdgcn_global_load_lds((const unsigned*)((const char*)(gbase) + (voff)[_i]), (PG8_LAS unsigned*)(lds + (bufoff) + ldsw + _i * 8192), 16, 0, 0); } while (0)
#define PG8_LDA(dst, b, h) do { _Pragma("unroll") for (int m = 0; m < 4; ++m) _Pragma("unroll") for (int k = 0; k < 2; ++k) dst[m][k] = *(const PG8_LAS bf16x8*)(lds + PG8_SA(b, h) + aoff + m * 2048 + k * 1024); } while (0)
#define PG8_LDB(dst, b, h) do { _Pragma("unroll") for (int n = 0; n < 2; ++n) _Pragma("unroll") for (int k = 0; k < 2; ++k) dst[n][k] = *(const PG8_LAS bf16x8*)(lds + PG8_SB(b, h) + boff + n * 2048 + k * 1024); } while (0)
#define PG8_MMA(ai, bj, At, Bt) do { __builtin_amdgcn_s_setprio(1); _Pragma("unroll") for (int m = 0; m < 4; ++m) _Pragma("unroll") for (int n = 0; n < 2; ++n) _Pragma("unroll") for (int k = 0; k < 2; ++k) \
        acc[ai][bj][m][n] = __builtin_amdgcn_mfma_f32_16x16x32_bf16(Bt[n][k], At[m][k], acc[ai][bj][m][n], 0, 0, 0); __builtin_amdgcn_s_setprio(0); } while (0)
#define PG8_WAIT_V(n) asm volatile("s_waitcnt vmcnt(" #n ")" ::: "memory")
#define PG8_WAIT_L(n) asm volatile("s_waitcnt lgkmcnt(" #n ")" ::: "memory")
#define PG8_BAR __builtin_amdgcn_s_barrier()
#define PG8_SCHED __builtin_amdgcn_sched_barrier(0)
    Unit cur, nxt; int ui = 0;
    if (!S.next(0, cur)) return;
    f32x4 acc[2][2][4][2];
#pragma unroll
    for (int a = 0; a < 2; ++a)
#pragma unroll
        for (int b = 0; b < 2; ++b)
#pragma unroll
            for (int m = 0; m < 4; ++m)
#pragma unroll
                for (int n = 0; n < 2; ++n) acc[a][b][m][n] = (f32x4){0.f, 0.f, 0.f, 0.f};
    bf16x8 At[4][2], B0[2][2], B1[2][2];
    const char* cA = S.ptrA(g, cur) + (size_t)cur.pm * tstep; const char* cB = S.ptrB(g, cur) + (size_t)cur.pn * tstep;
    S.a_ready(cur);
    PG8_STAGE(PG8_SB(0, 0), cB, voffB); PG8_STAGE(PG8_SA(0, 0), cA, voffA); PG8_STAGE(PG8_SB(0, 1), cB + hstep, voffB); PG8_STAGE(PG8_SA(0, 1), cA + hstep, voffA);
    if (wr == 1) PG8_BAR;
    PG8_WAIT_V(4); PG8_BAR;
    PG8_STAGE(PG8_SB(1, 0), cB + kstep, voffB); PG8_STAGE(PG8_SA(1, 0), cA + kstep, voffA); PG8_STAGE(PG8_SB(1, 1), cB + hstep + kstep, voffB);
    PG8_WAIT_V(6); PG8_BAR;
    PG8_STAMP();
    for (;;) {
        const bool has_next = S.next(ui + 1, nxt);
        const char* nA = has_next ? S.ptrA(g, nxt) + (size_t)nxt.pm * tstep : cA; const char* nB = has_next ? S.ptrB(g, nxt) + (size_t)nxt.pn * tstep : cB;
        for (int t = 0; t < nt; t += 2) {
            const bool last = (t == nt - 2);
            const char* a1 = cA + (size_t)(t + 1) * kstep;
            const char* a2 = last ? nA : cA + (size_t)(t + 2) * kstep; const char* b2 = last ? nB : cB + (size_t)(t + 2) * kstep;
            const char* a3 = a2 + kstep; const char* b3 = b2 + kstep;
            if (last && has_next) S.a_ready(nxt);
            PG8_LDB(B0, 0, 0); PG8_SCHED; PG8_LDA(At, 0, 0); PG8_STAGE(PG8_SA(1, 1), a1 + hstep, voffA);
            PG8_WAIT_L(8); PG8_BAR; PG8_WAIT_L(0); PG8_MMA(0, 0, At, B0); PG8_BAR; PG8_SCHED;
            PG8_LDB(B1, 0, 1); PG8_STAGE(PG8_SB(0, 0), b2, voffB);
            PG8_BAR; PG8_WAIT_L(0); PG8_MMA(0, 1, At, B1); PG8_BAR;
            PG8_LDA(At, 0, 1); PG8_STAGE(PG8_SA(0, 0), a2, voffA);
            PG8_BAR; PG8_WAIT_L(0); PG8_MMA(1, 0, At, B0); PG8_BAR; PG8_SCHED;
            PG8_STAGE(PG8_SB(0, 1), b2 + hstep, voffB);
            PG8_WAIT_V(6); PG8_BAR; PG8_MMA(1, 1, At, B1); PG8_BAR;
            PG8_LDB(B0, 1, 0); PG8_SCHED; PG8_LDA(At, 1, 0); PG8_STAGE(PG8_SA(0, 1), a2 + hstep, voffA);
            PG8_WAIT_L(8); PG8_BAR; PG8_WAIT_L(0); PG8_MMA(0, 0, At, B0); PG8_BAR; PG8_SCHED;
            PG8_LDB(B1, 1, 1); PG8_STAGE(PG8_SB(1, 0), b3, voffB);
            PG8_BAR; PG8_WAIT_L(0); PG8_MMA(0, 1, At, B1); PG8_BAR;
            PG8_LDA(At, 1, 1); PG8_STAGE(PG8_SA(1, 0), a3, voffA);
            PG8_BAR; PG8_WAIT_L(0); PG8_MMA(1, 0, At, B0); PG8_BAR; PG8_SCHED;
            PG8_STAGE(PG8_SB(1, 1), b3 + hstep, voffB);
            PG8_WAIT_V(6); PG8_BAR; PG8_MMA(1, 1, At, B1); PG8_BAR;
        }
        PG8_STAMP();
        if constexpr (!Epi::AFTER_DRAIN) { E(acc, cur, wr, wc, fr, fq); S.done(cur); }
        PG8_STAMP();
        if (!has_next) break;
#pragma unroll
        for (int a = 0; a < 2; ++a)
#pragma unroll
            for (int b = 0; b < 2; ++b)
#pragma unroll
                for (int m = 0; m < 4; ++m)
#pragma unroll
                    for (int n = 0; n < 2; ++n) acc[a][b][m][n] = (f32x4){0.f, 0.f, 0.f, 0.f};
        cur = nxt; cA = nA; cB = nB; ++ui;
    }
    PG8_WAIT_V(0);
    if (wr == 0) PG8_BAR;
    PG8_BAR;
    if constexpr (Epi::AFTER_DRAIN) { E.fused(acc, cur, wr, wc, fr, fq, lds, wid, lane); S.done(cur); }
    PG8_STAMP();
    if (STAMP && wid == 0) { stamps[lane] = lane < nts ? (((unsigned long long)(unsigned)ts_hi << 32) | (unsigned)ts_lo) : 0ull;
        if (lane == 62) stamps[62] = rt_entry; if (lane == 63) stamps[63] = (unsigned long long)wall_clock64(); }
#undef PG8_STAMP
#undef PG8_SA
#undef PG8_SB
#undef PG8_STAGE
#undef PG8_LDA
#undef PG8_LDB
#undef PG8_MMA
#undef PG8_WAIT_V
#undef PG8_WAIT_L
#undef PG8_BAR
#undef PG8_SCHED
}
}
#define XB_TMO      128
#define XB_XCNT(j)  (256  + 64 * (j))
#define XB_XSUB(j)  (1280 + 64 * (j))
#define XB_XGEN(j)  (2304 + 64 * (j))
#define XB_TOP      3328
#define XB_TOPGEN   3392
#define XCD_BAR_WORDS 3456
#define XB_SPIN_CAP (1u << 18)

__device__ __forceinline__ unsigned xb_ld(unsigned* p)              { return __hip_atomic_load(p, __ATOMIC_RELAXED, __HIP_MEMORY_SCOPE_AGENT); }
__device__ __forceinline__ unsigned xb_add(unsigned* p, unsigned v) { return __hip_atomic_fetch_add(p, v, __ATOMIC_RELAXED, __HIP_MEMORY_SCOPE_AGENT); }
__device__ __forceinline__ unsigned xb_xcc_id() { return (unsigned)__builtin_amdgcn_s_getreg((3 << 11) | 20) & 0xFu; }
#define XB_SPIN(cond, bar) do { unsigned _sp = 0; while (cond) { __builtin_amdgcn_s_sleep(1); \
    if ((++_sp & 255u) == 0u) { if (xb_ld(&(bar)[XB_TMO])) break; if (_sp > XB_SPIN_CAP) { atomicAdd(&(bar)[XB_TMO], 1u); break; } } } } while (0)

struct XcdBarrier {
    unsigned* bar; unsigned x;
    volatile LAS unsigned* st;
};

__device__ __forceinline__ XcdBarrier xcd_barrier_post(unsigned* bar, volatile LAS unsigned* st) {
    XcdBarrier b; b.bar = bar; b.x = xb_xcc_id(); b.st = st;
    if (threadIdx.x == 0) (void)xb_add(&bar[XB_XCNT(b.x)], 1u);
    return b;
}
__device__ __forceinline__ void xcd_barrier_complete(unsigned* bar, unsigned x, unsigned& nloc, unsigned& nx) {
    const unsigned G = gridDim.x * gridDim.y * gridDim.z;
    unsigned sum, cnt, mine, sp = 0u;
    for (;;) {
        sum = 0u; cnt = 0u; mine = 0u;
#pragma unroll
        for (unsigned j = 0; j < 16; ++j) { const unsigned c = xb_ld(&bar[XB_XCNT(j)]); sum += c; cnt += (c > 0u) ? 1u : 0u; mine = (j == x) ? c : mine; }
        if (sum == G) break;
        __builtin_amdgcn_s_sleep(1);
        if ((++sp & 255u) == 0u) { if (xb_ld(&bar[XB_TMO])) break; if (sp > XB_SPIN_CAP) { atomicAdd(&bar[XB_TMO], 1u); break; } }
    }
    nloc = mine > 0u ? mine : 1u; nx = cnt > 0u ? cnt : 1u;
}

__device__ __forceinline__ void xcd_barrier(const XcdBarrier& b) {
    asm volatile("s_waitcnt vmcnt(0)" ::: "memory");
    __syncthreads();
    if (threadIdx.x == 0) {
        unsigned* bar = b.bar;
        __builtin_amdgcn_s_waitcnt(0);
        unsigned nloc = b.st[0], nx = b.st[1];
        if (nloc == 0u) { xcd_barrier_complete(bar, b.x, nloc, nx); b.st[0] = nloc; b.st[1] = nx; }
        const unsigned old = xb_add(&bar[XB_XSUB(b.x)], 1u);
        const unsigned gen = old / nloc;
        if (old + 1u == (gen + 1u) * nloc) {
            __builtin_amdgcn_fence(__ATOMIC_RELEASE, "agent");
            asm volatile("s_waitcnt vmcnt(0)" ::: "memory");
            const unsigned og = xb_add(&bar[XB_TOP], 1u);
            const unsigned tg = og / nx;
            if (og + 1u == (tg + 1u) * nx) xb_add(&bar[XB_TOPGEN], 1u);
            else XB_SPIN(xb_ld(&bar[XB_TOPGEN]) == tg, bar);
            __builtin_amdgcn_fence(__ATOMIC_ACQUIRE, "agent");
            xb_add(&bar[XB_XGEN(b.x)], 1u);
            asm volatile("s_waitcnt vmcnt(0)" ::: "memory");
        } else {
            XB_SPIN(xb_ld(&bar[XB_XGEN(b.x)]) == gen, bar);
            __builtin_amdgcn_fence(__ATOMIC_ACQUIRE, "agent");
            asm volatile("s_waitcnt vmcnt(0)" ::: "memory");
        }
    }
    __syncthreads();
}
typedef const __attribute__((address_space(4))) Args* ArgsP;
struct Ctx {
    ArgsP a; LAS unsigned char* lds; int tid, lane, wave, G, bid;
};

DI void transpose_job(const Ctx& c, const float* src, int ld, int col0, int nvalid, bf16_t* dst, int K, int row0, int ncols) {
    LAS float* tile = (LAS float*)c.lds;
    const int tilesN = ncols / 64, nt = tilesN * (K / 64);
    for (int t = c.bid; t < nt; t += c.G) {
        const int tn = t % tilesN, tk = t / tilesN;
        {   const int kk = c.tid >> 4, n4 = (c.tid & 15) * 4;
#pragma unroll
            for (int i = 0; i < 2; ++i) {
                const int k = kk + 32 * i;
                const f32x4 v = *(const f32x4*)(src + (size_t)(tk * 64 + k) * ld + col0 + tn * 64 + n4);
#pragma unroll
                for (int e = 0; e < 4; ++e) tile[k * 65 + n4 + e] = (tn * 64 + n4 + e < nvalid) ? v[e] : 0.f;
            } }
        __syncthreads();
        {   const int n = c.tid >> 3, k8 = (c.tid & 7) * 8;
            float v[8];
#pragma unroll
            for (int e = 0; e < 8; ++e) v[e] = tile[(k8 + e) * 65 + n];
            u32x4 w; w.x = pk2(v[0], v[1]); w.y = pk2(v[2], v[3]); w.z = pk2(v[4], v[5]); w.w = pk2(v[6], v[7]);
            *(u32x4*)(dst + (size_t)(row0 + tn * 64 + n) * K + tk * 64 + k8) = w; }
        __syncthreads();
    }
}
DI void convert_job(const Ctx& c, const float* src, bf16_t* dst, size_t n, bool nt) {
    const size_t stride = (size_t)c.G * NTHREADS * 8;
    for (size_t i = ((size_t)c.bid * NTHREADS + c.tid) * 8; i < n; i += stride) {
        f32x4 a, b;
        if (nt) { a = __builtin_nontemporal_load((const f32x4*)(src + i)); b = __builtin_nontemporal_load((const f32x4*)(src + i + 4)); }
        else { a = *(const f32x4*)(src + i); b = *(const f32x4*)(src + i + 4); }
        u32x4 w; w.x = pk2(a[0], a[1]); w.y = pk2(a[2], a[3]); w.z = pk2(b[0], b[1]); w.w = pk2(b[2], b[3]);
        *(u32x4*)(dst + i) = w;
    }
}
DI void fold_peer(const Ctx& c) {
    LAS float* kk = (LAS float*)c.lds;
    LAS float* wt = kk + 128 * 129;
    bf16_t* WP = (bf16_t*)(c.a->ws + WS_WP);
    const int ntile = 4 * 8 * 32, per = (ntile + c.G - 1) / c.G;
    int last = -1;
    for (int t = c.bid * per; t < ntile && t < (c.bid + 1) * per; ++t) {
        const int ihp = t >> 5, dt = t & 31, i = ihp >> 3, hp = ihp & 7, p = hp & 1;
        __syncthreads();
        if (ihp != last) { last = ihp;
            const float* ks = c.a->peer_keys + (size_t)(i * 2 + p) * 128 * 128;
            for (int e = c.tid * 4; e < 128 * 128; e += NTHREADS * 4) { const f32x4 v = *(const f32x4*)(ks + e); const int n = e >> 7, cc = e & 127;
#pragma unroll
                for (int j = 0; j < 4; ++j) kk[n * 129 + cc + j] = v[j]; } }
        {   const float* wq = c.a->peer_w_q + (size_t)i * DM * 1024 + (size_t)(dt * 64) * 1024 + hp * 128;
            for (int e = c.tid * 4; e < 64 * 128; e += NTHREADS * 4) { const int d = e >> 7, cc = e & 127; const f32x4 v = *(const f32x4*)(wq + (size_t)d * 1024 + cc);
#pragma unroll
                for (int j = 0; j < 4; ++j) wt[d * 129 + cc + j] = v[j]; } }
        __syncthreads();
        const int ng = c.tid >> 4, dg = c.tid & 15;
        float acc[4][4];
#pragma unroll
        for (int x = 0; x < 4; ++x)
#pragma unroll
            for (int y = 0; y < 4; ++y) acc[x][y] = 0.f;
        for (int cc = 0; cc < 128; ++cc) {
            float av[4], bv[4];
#pragma unroll
            for (int x = 0; x < 4; ++x) { av[x] = kk[(ng * 4 + x) * 129 + cc]; bv[x] = wt[(dg * 4 + x) * 129 + cc]; }
#pragma unroll
            for (int x = 0; x < 4; ++x)
#pragma unroll
                for (int y = 0; y < 4; ++y) acc[x][y] += av[x] * bv[y];
        }
#pragma unroll
        for (int x = 0; x < 4; ++x) {
            u32x2 w; w.x = pk2(acc[x][0], acc[x][1]); w.y = pk2(acc[x][2], acc[x][3]);
            *(u32x2*)(WP + ((size_t)i * 1024 + hp * 128 + ng * 4 + x) * DM + dt * 64 + dg * 4) = w; }
    }
    __syncthreads();
}
DI void phase_prologue(const Ctx& c) {
    unsigned char* ws = c.a->ws;
    convert_job(c, c.a->x, (bf16_t*)(ws + WS_XB), (size_t)M_TOK * DM, false);
    convert_job(c, c.a->mem, (bf16_t*)(ws + WS_MEMB), (size_t)NMEM * DM, false);
    for (int li = 0; li < 2; ++li) {
        const float* src = c.a->gdn_w_in + (size_t)li * DM * 3600; bf16_t* dst = (bf16_t*)(ws + WS_WG) + (size_t)li * GDN_NP * DM;
        transpose_job(c, src, 3600, 0, 3072, dst, DM, 0, 3072);
        transpose_job(c, src, 3600, 3088, 512, dst, DM, GC_QM, 512);
        transpose_job(c, src, 3600, 3072, 16, dst, DM, GC_B, 256);
        const float* s2 = c.a->sb_w_in + (size_t)li * DM * 3584; bf16_t* d2 = (bf16_t*)(ws + WS_WSB) + (size_t)li * SB_NP * DM;
        transpose_job(c, s2, 3584, 0, 2048, d2, DM, 0, 2048);
        transpose_job(c, s2, 3584, 3072, 512, d2, DM, SC_QM, 512);
        transpose_job(c, s2, 3584, 2048, 1024, (bf16_t*)(ws + WS_WSBV) + (size_t)li * 1024 * DM, DM, 0, 1024);
    }
    for (int i = 0; i < DEPTH; ++i) {
        const float* kv = c.a->mem_w_kv + (size_t)i * DM * 1024;
        transpose_job(c, kv, 1024, 0, 512, (bf16_t*)(ws + WS_WK), DM, i * 512, 512);
        transpose_job(c, kv, 1024, 512, 512, (bf16_t*)(ws + WS_WV), DM, i * 512, 512);
        transpose_job(c, c.a->w_out + (size_t)i * MIXW * DM, DM, 0, DM, (bf16_t*)(ws + WS_WO) + (size_t)i * DM * MIXW, MIXW, 0, DM);
    }
    fold_peer(c);
    convert_job(c, c.a->peer_u, (bf16_t*)(ws + WS_UT), (size_t)4 * 16384 * DM, true);
    convert_job(c, c.a->peer_v, (bf16_t*)(ws + WS_VTAB), (size_t)4 * 16384 * DM, true);
}
DI int swap23(int x) { return (x & ~12) | ((x & 4) << 1) | ((x & 8) >> 1); }
constexpr int G2_KBF = 0, G2_QBF = 17408, G2_RHST = 34816, G2_KDT = 71680, G2_MM = 90112, G2_TM = 107520, G2_XS = 124928, G2_GATE = 131456;
DI void phase_gdn_prep(const Ctx& c, int li) {
    unsigned char* ws = c.a->ws;
    const bf16_t* P = (const bf16_t*)(ws + WS_P);
    const float* convw = c.a->gdn_conv + (size_t)li * 4 * 2048;
    LAS unsigned char* L = c.lds;
    LAS float* gate = (LAS float*)(L + G2_GATE);
    LAS float* Mm = (LAS float*)(L + G2_MM);
    LAS float* Tm = (LAS float*)(L + G2_TM);
    LAS float* Xs = (LAS float*)(L + G2_XS);
    const int tid = c.tid, lane = c.lane, w = c.wave;
    for (int u = c.bid; u < 2048; u += c.G) {
        const int h = u & 7, n = u >> 3, t0 = n * 64;
        unsigned char* rec = ws + WS_REC + (size_t)(h * 256 + n) * REC_BYTES;
        for (int e = tid; e < 64 * 68; e += NTHREADS) Tm[e] = 0.f;
        if (w == 0) {
            const size_t row = (size_t)(t0 + lane) * LDP;
            const float b = bf2f(P[row + GC_B + h]), a = bf2f(P[row + GC_A + h]);
            const float beta = sigmoidf_(b);
            const float xx = a + c.a->gdn_dt_bias[li * 8 + h];
            const float sp = fmaxf(xx, 0.f) + __logf(1.0f + __expf(-fabsf(xx)));
            float g = -__expf(c.a->gdn_a_log[li * 8 + h]) * sp;
#pragma unroll
            for (int o = 1; o < 64; o <<= 1) { const float v = __shfl_up(g, o); if (lane >= o) g += v; }
            const float gl = __shfl(g, 63);
            gate[lane] = beta; gate[64 + lane] = g; gate[128 + lane] = __expf(g); gate[192 + lane] = __expf(gl - g);
            if (lane == 0) ((float*)(ws + WS_GAM))[h * 256 + n] = __expf(gl);
        }
        __syncthreads();
#pragma unroll 1
        for (int j = 0; j < 6; ++j) {
            const int rest = (tid >> 4) + 32 * j, s = rest & 63, sec = rest >> 6, cg = tid & 15;
            const int col = (sec == 0 ? GC_Q + (h >> 1) * 128 : sec == 1 ? GC_K + (h >> 1) * 128 : GC_V + h * 128) + cg * 8;
            float acc[8];
#pragma unroll
            for (int e = 0; e < 8; ++e) acc[e] = 0.f;
#pragma unroll
            for (int jj = 0; jj < 4; ++jj) {
                const int tt = t0 + s - 3 + jj;
                if (tt >= 0) {
                    const u32x4 xv = *(const u32x4*)(P + (size_t)tt * LDP + col);
                    const f32x4 w0 = *(const f32x4*)(convw + jj * 2048 + col), w1 = *(const f32x4*)(convw + jj * 2048 + col + 4);
                    acc[0] += w0[0] * bf_lo(xv.x); acc[1] += w0[1] * bf_hi(xv.x); acc[2] += w0[2] * bf_lo(xv.y); acc[3] += w0[3] * bf_hi(xv.y);
                    acc[4] += w1[0] * bf_lo(xv.z); acc[5] += w1[1] * bf_hi(xv.z); acc[6] += w1[2] * bf_lo(xv.w); acc[7] += w1[3] * bf_hi(xv.w);
                }
            }
            float ss = 0.f;
#pragma unroll
            for (int e = 0; e < 8; ++e) { acc[e] = siluf_(acc[e]); ss += acc[e] * acc[e]; }
            const float beta = gate[s], eg = gate[128 + s], egl = gate[192 + s];
            if (sec < 2) {
                ss += __shfl_xor(ss, 1); ss += __shfl_xor(ss, 2); ss += __shfl_xor(ss, 4); ss += __shfl_xor(ss, 8);
                const float r = __builtin_amdgcn_rsqf(ss + RMS_EPS) * (sec == 0 ? 0.08838834764831845f : 1.0f);
#pragma unroll
                for (int e = 0; e < 8; ++e) acc[e] *= r;
                u32x4 wv; wv.x = pk2(acc[0], acc[1]); wv.y = pk2(acc[2], acc[3]); wv.z = pk2(acc[4], acc[5]); wv.w = pk2(acc[6], acc[7]);
                *(LAS u32x4*)(L + (sec == 0 ? G2_QBF : G2_KBF) + s * 272 + cg * 16) = wv;
                if (sec == 0) {
                    u32x2 lo, hi; lo.x = pk2(acc[0] * eg, acc[1] * eg); lo.y = pk2(acc[2] * eg, acc[3] * eg); hi.x = pk2(acc[4] * eg, acc[5] * eg); hi.y = pk2(acc[6] * eg, acc[7] * eg);
                    bf16_t* qg = (bf16_t*)(rec + REC_QG) + s * 128 + 16 * (cg >> 1) + 4 * (cg & 1);
                    *(u32x2*)qg = lo; *(u32x2*)(qg + 8) = hi;
                } else {
                    const int ps = (s & ~15) | swap23(s & 15);
#pragma unroll
                    for (int e = 0; e < 8; ++e) {
                        *(LAS bf16_t*)(L + G2_RHST + (128 + cg * 8 + e) * 144 + s * 2) = f2bf(acc[e] * beta * eg);
                        *(LAS bf16_t*)(L + G2_KDT + (cg * 8 + e) * 144 + ps * 2) = f2bf(acc[e] * egl); }
                }
            } else {
#pragma unroll
                for (int e = 0; e < 8; ++e) *(LAS bf16_t*)(L + G2_RHST + (cg * 8 + e) * 144 + s * 2) = f2bf(acc[e] * beta);
            }
        }
        __syncthreads();
        {   const int sel = w >> 2, i = w & 3, r = lane & 15, q = lane >> 4;
            bf16x8 af[4];
#pragma unroll
            for (int ks = 0; ks < 4; ++ks) af[ks] = *(const LAS bf16x8*)(L + (sel ? G2_QBF : G2_KBF) + (16 * i + r) * 272 + (32 * ks + 8 * q) * 2);
#pragma unroll
            for (int j = 0; j < 4; ++j) {
                f32x4 acc = {0.f, 0.f, 0.f, 0.f};
#pragma unroll
                for (int ks = 0; ks < 4; ++ks) { const bf16x8 bfr = *(const LAS bf16x8*)(L + G2_KBF + (16 * j + r) * 272 + (32 * ks + 8 * q) * 2); acc = MFMA16(af[ks], bfr, acc); }
                const int s = 16 * j + r; const float gs = gate[64 + s];
#pragma unroll
                for (int e = 0; e < 4; ++e) {
                    const int cc = 16 * i + 4 * q + e; const float dec = __expf(gate[64 + cc] - gs);
                    if (sel == 0) Mm[cc * 68 + s] = (s < cc) ? gate[cc] * acc[e] * dec : 0.f;
                    else { const int ps = (s & ~15) | swap23(s & 15); ((bf16_t*)(rec + REC_AQK))[cc * 64 + ps] = f2bf((s <= cc) ? acc[e] * dec : 0.f); }
                }
            }
        }
        __syncthreads();
        if (w < 4 && lane < 16) {
            float mrow[16], tr[16];
#pragma unroll
            for (int i = 0; i < 16; ++i) mrow[i] = Mm[(16 * w + i) * 68 + 16 * w + lane];
#pragma unroll
            for (int i = 0; i < 16; ++i) {
                float acc = (lane == i) ? 1.f : 0.f;
#pragma unroll
                for (int j = 0; j < i; ++j) acc -= __shfl(mrow[i], j, 16) * tr[j];
                tr[i] = acc;
            }
#pragma unroll
            for (int i = 0; i < 16; ++i) Tm[(16 * w + i) * 68 + 16 * w + lane] = tr[i];
        }
        __syncthreads();
#pragma unroll 1
        for (int d = 1; d < 4; ++d) {
            const int nb = 4 - d;
            for (int o = tid; o < nb * 256; o += NTHREADS) {
                const int b = o >> 8, r = (o >> 4) & 15, cc = o & 15, J = b, I = J + d;
                float sum = 0.f;
                for (int K = J; K < I; ++K)
#pragma unroll
                    for (int e = 0; e < 16; ++e) sum += Mm[(16 * I + r) * 68 + 16 * K + e] * Tm[(16 * K + e) * 68 + 16 * J + cc];
                Xs[(b * 16 + r) * 17 + cc] = sum;
            }
            __syncthreads();
            for (int o = tid; o < nb * 256; o += NTHREADS) {
                const int b = o >> 8, r = (o >> 4) & 15, cc = o & 15, J = b, I = J + d;
                float sum = 0.f;
#pragma unroll
                for (int e = 0; e < 16; ++e) sum += Tm[(16 * I + r) * 68 + 16 * I + e] * Xs[(b * 16 + e) * 17 + cc];
                Tm[(16 * I + r) * 68 + 16 * J + cc] = -sum;
            }
            __syncthreads();
        }
        {   const int r = lane & 15, q = lane >> 4;
            f32x4 acc[4][2];
#pragma unroll
            for (int i = 0; i < 4; ++i) { acc[i][0] = (f32x4){0.f, 0.f, 0.f, 0.f}; acc[i][1] = (f32x4){0.f, 0.f, 0.f, 0.f}; }
#pragma unroll
            for (int ks = 0; ks < 2; ++ks) {
                bf16x8 bfr[2];
#pragma unroll
                for (int jt = 0; jt < 2; ++jt) bfr[jt] = *(const LAS bf16x8*)(L + G2_RHST + (32 * w + 16 * jt + r) * 144 + (32 * ks + 8 * q) * 2);
#pragma unroll
                for (int i = 0; i < 4; ++i) {
                    const LAS float* tp = Tm + (16 * i + r) * 68 + 32 * ks + 8 * q;
                    const f32x4 t0v = *(const LAS f32x4*)tp, t1v = *(const LAS f32x4*)(tp + 4);
                    const bf16x8 af = pack8(t0v[0], t0v[1], t0v[2], t0v[3], t1v[0], t1v[1], t1v[2], t1v[3]);
                    acc[i][0] = MFMA16(af, bfr[0], acc[i][0]); acc[i][1] = MFMA16(af, bfr[1], acc[i][1]);
                }
            }
#pragma unroll
            for (int jt = 0; jt < 2; ++jt) {
                const int nn = 32 * w + 16 * jt + r;
                if (w < 4) {
#pragma unroll
                    for (int i = 0; i < 4; ++i) {
                        u32x2 wv; wv.x = pk2(acc[i][jt][0], acc[i][jt][1]); wv.y = pk2(acc[i][jt][2], acc[i][jt][3]);
                        *(u32x2*)(rec + REC_U + (size_t)((((nn >> 5) * 2 + (i >> 1)) * 64 + (nn & 31) + 32 * (q & 1)) * 32 + (8 * (i & 1) + 4 * (q >> 1)) * 2)) = wv; }
                } else {
                    const int dk = nn - 128, pd = (dk & ~15) | swap23(dk & 15);
#pragma unroll
                    for (int i = 0; i < 4; ++i)
#pragma unroll
                        for (int e = 0; e < 4; ++e) ((bf16_t*)(rec + REC_W))[(16 * i + 4 * q + e) * 128 + pd] = f2bf(acc[i][jt][e]);
                }
            }
#pragma unroll
            for (int pz = 0; pz < 2; ++pz) { const int piece = tid + NTHREADS * pz, row = piece >> 3, seg = piece & 7;
                *(u32x4*)(rec + REC_KDT + row * 128 + seg * 16) = *(const LAS u32x4*)(L + G2_KDT + row * 144 + seg * 16); }
        }
        __syncthreads();
    }
}
DI void mem_attn_task(const Ctx& c, int layer, int qcol, int task) {
    unsigned char* ws = c.a->ws;
    const bf16_t* P = (const bf16_t*)(ws + WS_P);
    const bf16_t* KM = (const bf16_t*)(ws + WS_KM) + layer * 512;
    const bf16_t* VMT = (const bf16_t*)(ws + WS_VMT) + (size_t)(layer * 512) * NMEM;
    bf16_t* MIX = (bf16_t*)(ws + WS_MIX);
    const int hm = task & 3, t0 = (task >> 2) * 16, r = c.lane & 15, q = c.lane >> 4;
    bf16x8 qf[4];
#pragma unroll
    for (int ks = 0; ks < 4; ++ks) qf[ks] = *(const bf16x8*)(P + (size_t)(t0 + r) * LDP + qcol + hm * 128 + 32 * ks + 8 * q);
    f32x4 st[16];
    {   bf16x8 kf[2][4];
#pragma unroll
        for (int ks = 0; ks < 4; ++ks) kf[0][ks] = *(const bf16x8*)(KM + (size_t)r * 2048 + hm * 128 + 32 * ks + 8 * q);
#pragma unroll
        for (int kt = 0; kt < 16; ++kt) {
            if (kt + 1 < 16) {
#pragma unroll
                for (int ks = 0; ks < 4; ++ks) kf[(kt + 1) & 1][ks] = *(const bf16x8*)(KM + (size_t)(16 * (kt + 1) + r) * 2048 + hm * 128 + 32 * ks + 8 * q); }
            f32x4 acc = {0.f, 0.f, 0.f, 0.f};
#pragma unroll
            for (int ks = 0; ks < 4; ++ks) acc = MFMA16(kf[kt & 1][ks], qf[ks], acc);
            st[kt] = acc;
            asm volatile("" ::: "memory");
        } }
    const float sc = 0.08838834764831845f * 1.44269504088896f;
    float mx = -3.0e38f;
#pragma unroll
    for (int kt = 0; kt < 16; ++kt)
#pragma unroll
        for (int e = 0; e < 4; ++e) mx = fmaxf(mx, st[kt][e]);
    mx = fmaxf(mx, __shfl_xor(mx, 16)); mx = fmaxf(mx, __shfl_xor(mx, 32));
    float sum = 0.f;
#pragma unroll
    for (int kt = 0; kt < 16; ++kt)
#pragma unroll
        for (int e = 0; e < 4; ++e) { const float p = __builtin_amdgcn_exp2f((st[kt][e] - mx) * sc); st[kt][e] = p; sum += p; }
    sum += __shfl_xor(sum, 16); sum += __shfl_xor(sum, 32);
    const float inv = __builtin_amdgcn_rcpf(sum);
    f32x4 ot[8];
#pragma unroll
    for (int dt = 0; dt < 8; ++dt) ot[dt] = (f32x4){0.f, 0.f, 0.f, 0.f};
    {   s16x4 vl[2][8][2];
        const bf16_t* vbase = VMT + (size_t)(hm * 128 + r) * NMEM + 4 * q;
#pragma unroll
        for (int dt = 0; dt < 8; ++dt) { vl[0][dt][0] = *(const s16x4*)(vbase + (size_t)(16 * dt) * NMEM); vl[0][dt][1] = *(const s16x4*)(vbase + (size_t)(16 * dt) * NMEM + 16); }
#pragma unroll
        for (int kk = 0; kk < 8; ++kk) {
            if (kk + 1 < 8) {
#pragma unroll
                for (int dt = 0; dt < 8; ++dt) { vl[(kk + 1) & 1][dt][0] = *(const s16x4*)(vbase + (size_t)(16 * dt) * NMEM + 32 * (kk + 1)); vl[(kk + 1) & 1][dt][1] = *(const s16x4*)(vbase + (size_t)(16 * dt) * NMEM + 32 * (kk + 1) + 16); } }
            const bf16x8 pb = pack8(st[2 * kk][0], st[2 * kk][1], st[2 * kk][2], st[2 * kk][3], st[2 * kk + 1][0], st[2 * kk + 1][1], st[2 * kk + 1][2], st[2 * kk + 1][3]);
#pragma unroll
            for (int dt = 0; dt < 8; ++dt) {
                const bf16x8 vf = __builtin_shufflevector(vl[kk & 1][dt][0], vl[kk & 1][dt][1], 0, 1, 2, 3, 4, 5, 6, 7);
                ot[dt] = MFMA16(vf, pb, ot[dt]); }
            asm volatile("" ::: "memory");
        } }
#pragma unroll
    for (int dt = 0; dt < 8; ++dt) {
        u32x2 wv; wv.x = pk2(ot[dt][0] * inv, ot[dt][1] * inv); wv.y = pk2(ot[dt][2] * inv, ot[dt][3] * inv);
        *(u32x2*)(MIX + (size_t)(t0 + r) * MIXW + 1024 + hm * 128 + 16 * dt + 4 * q) = wv; }
}
DI void mem_attn_all(const Ctx& c, int layer, int qcol, int brank, int nblk) {
    if (nblk <= 0) return;
    for (int task = brank * 8 + c.wave; task < (M_TOK / 16) * 4; task += nblk * 8) mem_attn_task(c, layer, qcol, task);
}

DI bf16x8 packS(const f32x16& x, int s) { return pack8(x[8 * s], x[8 * s + 1], x[8 * s + 2], x[8 * s + 3], x[8 * s + 4], x[8 * s + 5], x[8 * s + 6], x[8 * s + 7]); }
DI void scan_load_record(LAS unsigned char* buf, const unsigned char* rec, int lw, int lane) {
    asm volatile("" : "+s"(rec));
    const unsigned vA = (unsigned)((lane >> 4) * 256 + (((lane & 15) ^ ((lw * 4 + (lane >> 4)) & 15)) * 16));
    const unsigned vB = (unsigned)((lane >> 3) * 128 + (((lane & 7) ^ (((lane >> 4) + 4 * (lw & 1)) & 7)) * 16));
    const unsigned vC = (unsigned)(lane * 16);
#pragma unroll
    for (int i = 0; i < 18; ++i) {
        const int qq = lw + 4 * i;
        const unsigned char* gp = rec + qq * 1024;
        const unsigned vo = (i < 8) ? vA : (i < 14) ? vB : vC;
        __builtin_amdgcn_global_load_lds((const unsigned*)(gp + vo), (LAS unsigned*)(buf + qq * 1024), 16, 0, 0);
    }
}
template <int G_> DI void scan_ld(const LAS unsigned char* buf, int r, int hh, bf16x8 (&f)[4]) {
    if constexpr (G_ < 4) {
#pragma unroll
        for (int rho = 0; rho < 2; ++rho)
#pragma unroll
            for (int s = 0; s < 2; ++s) { const int cr = 32 * rho + r, p = (4 * G_ + 2 * s + hh) ^ (cr & 15); f[rho * 2 + s] = *(const LAS bf16x8*)(buf + REC_W + cr * 256 + p * 16); } }
    else if constexpr (G_ < 10 && ((G_ - 4) % 3) < 2) { constexpr int rho = (G_ - 4) / 3, i0 = 2 * ((G_ - 4) % 3); const int cr = 32 * rho + r;
#pragma unroll
        for (int ii = 0; ii < 2; ++ii)
#pragma unroll
            for (int s = 0; s < 2; ++s) { const int p = (4 * (i0 + ii) + 2 * s + hh) ^ (cr & 15); f[ii * 2 + s] = *(const LAS bf16x8*)(buf + REC_QG + cr * 256 + p * 16); } }
    else { constexpr int row0 = (G_ < 10) ? 32 * ((G_ - 4) / 3) : 32 * (G_ - 10); constexpr int base = (G_ < 10) ? REC_AQK : REC_KDT; const int rr = row0 + r;
#pragma unroll
        for (int ts = 0; ts < 4; ++ts) { const int p = (2 * ts + hh) ^ ((rr >> 1) & 7); f[ts] = *(const LAS bf16x8*)(buf + base + rr * 128 + p * 16); } }
}
DI void phase_gdn_scan(const Ctx& c, int layer, int head) {
    unsigned char* ws = c.a->ws;
    LAS unsigned char* L = c.lds;
    const int lane = c.lane, w = c.wave, r = lane & 31, hh = lane >> 5;
    const unsigned char* recs = ws + WS_REC + (size_t)head * 256 * REC_BYTES;
    const float* gam = (const float*)(ws + WS_GAM) + head * 256;
    float* OGT = (float*)(ws + WS_OG);
    f32x16 S[4];
#pragma unroll
    for (int i = 0; i < 4; ++i)
#pragma unroll
        for (int e = 0; e < 16; ++e) S[i][e] = 0.f;
    if (w >= 4) { scan_load_record(L, recs, w - 4, lane); asm volatile("s_waitcnt vmcnt(0)" ::: "memory"); }
    __syncthreads();
#pragma unroll 1
    for (int n = 0; n < 256; ++n) {
        LAS unsigned char* buf = L + (n & 1) * REC_BYTES;
        if (w >= 4) {
            if (n + 1 < 256) { scan_load_record(L + ((n + 1) & 1) * REC_BYTES, recs + (size_t)(n + 1) * REC_BYTES, w - 4, lane); asm volatile("s_waitcnt vmcnt(0)" ::: "memory"); }
        } else {
            const float gamma = gam[n];
            u32x4 uu[2][2];
#pragma unroll
            for (int rho = 0; rho < 2; ++rho) { const LAS u32x4* up = (const LAS u32x4*)(buf + REC_U + ((w * 2 + rho) * 64 + lane) * 32); uu[rho][0] = up[0]; uu[rho][1] = up[1]; }
            bf16x8 fr[2][4];
            scan_ld<0>(buf, r, hh, fr[0]);
#define SCAN_NEXT(g) do { if ((g) + 1 < 14) scan_ld<(g) + 1>(buf, r, hh, fr[((g) + 1) & 1]); } while (0)
#define SCAN_END() asm volatile("" ::: "memory")
            bf16x8 Vb[2][2];
            {   f32x16 Y[2];
#pragma unroll
                for (int e = 0; e < 16; ++e) { Y[0][e] = 0.f; Y[1][e] = 0.f; }
#define SCAN_Y(g) do { SCAN_NEXT(g); const bf16x8 sb0 = packS(S[g], 0), sb1 = packS(S[g], 1); \
                    Y[0] = MFMA32(fr[(g) & 1][0], sb0, Y[0]); Y[1] = MFMA32(fr[(g) & 1][2], sb0, Y[1]); Y[0] = MFMA32(fr[(g) & 1][1], sb1, Y[0]); Y[1] = MFMA32(fr[(g) & 1][3], sb1, Y[1]); SCAN_END(); } while (0)
                SCAN_Y(0); SCAN_Y(1); SCAN_Y(2); SCAN_Y(3);
#undef SCAN_Y
#pragma unroll
                for (int rho = 0; rho < 2; ++rho) {
                    const u32x4 u0 = uu[rho][0], u1 = uu[rho][1];
                    Y[rho][0] = bf_lo(u0.x) - Y[rho][0]; Y[rho][1] = bf_hi(u0.x) - Y[rho][1]; Y[rho][2] = bf_lo(u0.y) - Y[rho][2]; Y[rho][3] = bf_hi(u0.y) - Y[rho][3];
                    Y[rho][4] = bf_lo(u0.z) - Y[rho][4]; Y[rho][5] = bf_hi(u0.z) - Y[rho][5]; Y[rho][6] = bf_lo(u0.w) - Y[rho][6]; Y[rho][7] = bf_hi(u0.w) - Y[rho][7];
                    Y[rho][8] = bf_lo(u1.x) - Y[rho][8]; Y[rho][9] = bf_hi(u1.x) - Y[rho][9]; Y[rho][10] = bf_lo(u1.y) - Y[rho][10]; Y[rho][11] = bf_hi(u1.y) - Y[rho][11];
                    Y[rho][12] = bf_lo(u1.z) - Y[rho][12]; Y[rho][13] = bf_hi(u1.z) - Y[rho][13]; Y[rho][14] = bf_lo(u1.w) - Y[rho][14]; Y[rho][15] = bf_hi(u1.w) - Y[rho][15];
                    Vb[rho][0] = packS(Y[rho], 0); Vb[rho][1] = packS(Y[rho], 1);
                }
            }
#define SCAN_Z(g0, rho) do { f32x16 Z; _Pragma("unroll") for (int e = 0; e < 16; ++e) Z[e] = 0.f; \
                SCAN_NEXT(g0); { const bf16x8 a0 = packS(S[0], 0), a1 = packS(S[0], 1), a2 = packS(S[1], 0), a3 = packS(S[1], 1); \
                    Z = MFMA32(fr[(g0) & 1][0], a0, Z); Z = MFMA32(fr[(g0) & 1][1], a1, Z); Z = MFMA32(fr[(g0) & 1][2], a2, Z); Z = MFMA32(fr[(g0) & 1][3], a3, Z); } SCAN_END(); \
                SCAN_NEXT((g0) + 1); { const bf16x8 a0 = packS(S[2], 0), a1 = packS(S[2], 1), a2 = packS(S[3], 0), a3 = packS(S[3], 1); \
                    Z = MFMA32(fr[((g0) + 1) & 1][0], a0, Z); Z = MFMA32(fr[((g0) + 1) & 1][1], a1, Z); Z = MFMA32(fr[((g0) + 1) & 1][2], a2, Z); Z = MFMA32(fr[((g0) + 1) & 1][3], a3, Z); } SCAN_END(); \
                SCAN_NEXT((g0) + 2); Z = MFMA32(fr[((g0) + 2) & 1][0], Vb[0][0], Z); Z = MFMA32(fr[((g0) + 2) & 1][1], Vb[0][1], Z); Z = MFMA32(fr[((g0) + 2) & 1][2], Vb[1][0], Z); Z = MFMA32(fr[((g0) + 2) & 1][3], Vb[1][1], Z); \
                { f32x4* op = (f32x4*)(OGT + ((size_t)((head * 256 + n) * 8 + w * 2 + (rho)) * 64 + lane) * 16); \
                  op[0] = (f32x4){Z[0], Z[1], Z[2], Z[3]}; op[1] = (f32x4){Z[4], Z[5], Z[6], Z[7]}; op[2] = (f32x4){Z[8], Z[9], Z[10], Z[11]}; op[3] = (f32x4){Z[12], Z[13], Z[14], Z[15]}; } SCAN_END(); } while (0)
            SCAN_Z(4, 0); SCAN_Z(7, 1);
#undef SCAN_Z
#define SCAN_S(g, i) do { SCAN_NEXT(g); _Pragma("unroll") for (int e = 0; e < 16; ++e) S[i][e] *= gamma; \
                S[i] = MFMA32(fr[(g) & 1][0], Vb[0][0], S[i]); S[i] = MFMA32(fr[(g) & 1][1], Vb[0][1], S[i]); S[i] = MFMA32(fr[(g) & 1][2], Vb[1][0], S[i]); S[i] = MFMA32(fr[(g) & 1][3], Vb[1][1], S[i]); SCAN_END(); } while (0)
            SCAN_S(10, 0); SCAN_S(11, 1); SCAN_S(12, 2); SCAN_S(13, 3);
#undef SCAN_S
#undef SCAN_NEXT
#undef SCAN_END
        }
        __syncthreads();
    }
}
DI void phase_gdn_out(const Ctx& c, int li) {
    unsigned char* ws = c.a->ws;
    const float* OGT = (const float*)(ws + WS_OG); const bf16_t* P = (const bf16_t*)(ws + WS_P); bf16_t* MIX = (bf16_t*)(ws + WS_MIX);
    const float* gn = c.a->gdn_onorm + li * 128;
    const int lane = c.lane, r = lane & 31, hh = lane >> 5;
    float gv[4];
#pragma unroll
    for (int j = 0; j < 4; ++j) gv[j] = gn[32 * j + r];
    for (int u = c.bid * 8 + c.wave; u < 8 * 256 * 2; u += c.G * 8) {
        const int rho = u & 1, hn = u >> 1, h = hn >> 8, n = hn & 255;
        f32x4 v[4][4];
#pragma unroll
        for (int j = 0; j < 4; ++j) { const f32x4* ip = (const f32x4*)(OGT + ((size_t)(hn * 8 + j * 2 + rho) * 64 + lane) * 16);
#pragma unroll
            for (int k = 0; k < 4; ++k) v[j][k] = ip[k]; }
#pragma unroll
        for (int k = 0; k < 4; ++k)
#pragma unroll
            for (int e = 0; e < 4; ++e) {
                float ss = v[0][k][e] * v[0][k][e] + v[1][k][e] * v[1][k][e] + v[2][k][e] * v[2][k][e] + v[3][k][e] * v[3][k][e];
                ss += __shfl_xor(ss, 1); ss += __shfl_xor(ss, 2); ss += __shfl_xor(ss, 4); ss += __shfl_xor(ss, 8); ss += __shfl_xor(ss, 16);
                const float rr = __builtin_amdgcn_rsqf(ss * (1.0f / 128.0f) + RMS_EPS);
                const int reg = 4 * k + e, t = n * 64 + 32 * rho + (reg & 3) + 8 * (reg >> 2) + 4 * hh;
                const bf16_t* zp = P + (size_t)t * LDP + GC_Z + h * 128 + r; bf16_t* mp = MIX + (size_t)t * MIXW + h * 128 + r;
#pragma unroll
                for (int j = 0; j < 4; ++j) mp[32 * j] = f2bf(v[j][k][e] * rr * gv[j] * siluf_(bf2f(zp[32 * j])));
            }
    }
}

DI void ln_row(const float (&v)[32], const float* g, const float* b, float* dstf, bf16_t* dstb, int lane) {
    float s = 0.f;
#pragma unroll
    for (int i = 0; i < 32; ++i) s += v[i];
    const float mu = wave_sum(s) * (1.0f / 2048.0f);
    float qv = 0.f;
#pragma unroll
    for (int i = 0; i < 32; ++i) { const float d = v[i] - mu; qv += d * d; }
    const float rstd = __builtin_amdgcn_rsqf(wave_sum(qv) * (1.0f / 2048.0f) + LN_EPS);
#pragma unroll
    for (int i = 0; i < 4; ++i) {
        const int e0 = 512 * i + 8 * lane;
        const f32x4 ga = *(const f32x4*)(g + e0), gb = *(const f32x4*)(g + e0 + 4), ba = *(const f32x4*)(b + e0), bb = *(const f32x4*)(b + e0 + 4);
        f32x4 ya, yb;
#pragma unroll
        for (int j = 0; j < 4; ++j) { ya[j] = (v[8 * i + j] - mu) * rstd * ga[j] + ba[j]; yb[j] = (v[8 * i + 4 + j] - mu) * rstd * gb[j] + bb[j]; }
        *(f32x4*)(dstf + e0) = ya; *(f32x4*)(dstf + e0 + 4) = yb;
        if (dstb) { u32x4 wv; wv.x = pk2(ya[0], ya[1]); wv.y = pk2(ya[2], ya[3]); wv.z = pk2(yb[0], yb[1]); wv.w = pk2(yb[2], yb[3]); *(u32x4*)(dstb + e0) = wv; }
    }
}
DI void phase_ln(const Ctx& c, const float* src, const float* g, const float* b, float* dstf, bf16_t* dstb) {
    for (int row = c.bid * 8 + c.wave; row < M_TOK; row += c.G * 8) {
        float v[32];
        const float* sp = src + (size_t)row * DM;
#pragma unroll
        for (int i = 0; i < 4; ++i) { const f32x4 a = *(const f32x4*)(sp + 512 * i + 8 * c.lane), bq = *(const f32x4*)(sp + 512 * i + 8 * c.lane + 4);
#pragma unroll
            for (int j = 0; j < 4; ++j) { v[8 * i + j] = a[j]; v[8 * i + 4 + j] = bq[j]; } }
        ln_row(v, g, b, dstf + (size_t)row * DM, dstb + (size_t)row * DM, c.lane);
    }
}

DI void sb_attn_task(const Ctx& c, int task) {
    unsigned char* ws = c.a->ws;
    const bf16_t* P = (const bf16_t*)(ws + WS_P); const bf16_t* VT = (const bf16_t*)(ws + WS_VT); bf16_t* MIX = (bf16_t*)(ws + WS_MIX);
    const int h = task & 7, t0 = (task >> 3) * 16, r = c.lane & 15, q = c.lane >> 4;
    const int tq = t0 + r;
    bf16x8 qf[4];
#pragma unroll
    for (int ks = 0; ks < 4; ++ks) qf[ks] = *(const bf16x8*)(P + (size_t)tq * LDP + SC_Q + h * 128 + 32 * ks + 8 * q);
    f32x4 ot[8];
#pragma unroll
    for (int dt = 0; dt < 8; ++dt) ot[dt] = (f32x4){0.f, 0.f, 0.f, 0.f};
    float R = 0.f;
    const float sc = 0.08838834764831845f * 1.44269504088896f;
#pragma unroll 1
    for (int kb = (t0 + 15) >> 5; kb >= 0; --kb) {
        const int k0 = kb * 32;
        f32x4 z[2];
#pragma unroll
        for (int tl = 0; tl < 2; ++tl) {
            f32x4 acc = {0.f, 0.f, 0.f, 0.f};
#pragma unroll
            for (int ks = 0; ks < 4; ++ks) { const bf16x8 kf = *(const bf16x8*)(P + (size_t)(k0 + 16 * tl + r) * LDP + SC_K + h * 128 + 32 * ks + 8 * q); acc = MFMA16(kf, qf[ks], acc); }
            z[tl] = acc;
        }
        float ln[2][4], zz[2][4]; bool vis[2][4];
#pragma unroll
        for (int tl = 0; tl < 2; ++tl)
#pragma unroll
            for (int e = 0; e < 4; ++e) {
                const int key = k0 + 16 * tl + 4 * q + e;
                vis[tl][e] = key < tq;
                const float x = z[tl][e] * sc;
                const float l = fminf(-x, 0.f) - __builtin_amdgcn_logf(1.0f + __builtin_amdgcn_exp2f(-fabsf(x)));
                zz[tl][e] = x; ln[tl][e] = vis[tl][e] ? l : 0.f;
            }
        float g1 = ln[1][0] + ln[1][1] + ln[1][2] + ln[1][3], g0 = ln[0][0] + ln[0][1] + ln[0][2] + ln[0][3];
        const float b1 = __shfl_xor(g1, 16), c1 = __shfl_xor(g1, 32), d1 = __shfl_xor(b1, 32);
        const float b0 = __shfl_xor(g0, 16), c0 = __shfl_xor(g0, 32), d0 = __shfl_xor(b0, 32);
        const float tot1 = g1 + b1 + c1 + d1, tot0 = g0 + b0 + c0 + d0;
        const float e1 = (q == 3) ? 0.f : (q == 2) ? b1 : (q == 1) ? (c1 + d1) : (b1 + c1 + d1);
        const float e0 = ((q == 3) ? 0.f : (q == 2) ? b0 : (q == 1) ? (c0 + d0) : (b0 + c0 + d0)) + tot1;
        float p[2][4];
        {   float run = R + e1;
#pragma unroll
            for (int e = 3; e >= 0; --e) { p[1][e] = vis[1][e] ? __builtin_amdgcn_exp2f(ln[1][e] + zz[1][e] + run) : 0.f; run += ln[1][e]; }
            run = R + e0;
#pragma unroll
            for (int e = 3; e >= 0; --e) { p[0][e] = vis[0][e] ? __builtin_amdgcn_exp2f(ln[0][e] + zz[0][e] + run) : 0.f; run += ln[0][e]; }
        }
        R += tot0 + tot1;
        const bf16x8 pb = pack8(p[0][0], p[0][1], p[0][2], p[0][3], p[1][0], p[1][1], p[1][2], p[1][3]);
#pragma unroll
        for (int dt = 0; dt < 8; ++dt) {
            const bf16_t* vp = VT + (size_t)(h * 128 + 16 * dt + r) * M_TOK + k0 + 4 * q;
            const s16x4 lo = *(const s16x4*)vp, hi = *(const s16x4*)(vp + 16);
            const bf16x8 vf = __builtin_shufflevector(lo, hi, 0, 1, 2, 3, 4, 5, 6, 7);
            ot[dt] = MFMA16(vf, pb, ot[dt]);
        }
        if (__all(R < -40.0f)) break;
    }
#pragma unroll
    for (int dt = 0; dt < 8; ++dt) {
        u32x2 wv; wv.x = pk2(ot[dt][0], ot[dt][1]); wv.y = pk2(ot[dt][2], ot[dt][3]);
        *(u32x2*)(MIX + (size_t)tq * MIXW + h * 128 + 16 * dt + 4 * q) = wv; }
}
DI void phase_sb_attn(const Ctx& c, int layer) {
    for (int task = c.bid * 8 + c.wave; task < (M_TOK / 16) * 8; task += c.G * 8) sb_attn_task(c, task);
    mem_attn_all(c, layer, SC_QM, c.bid, c.G);
}
template <int N> DI void topk_insert(float (&L)[N], float x) {
#pragma unroll
    for (int i = 0; i < N; ++i) { const float hi = fmaxf(L[i], x); x = fminf(L[i], x); L[i] = hi; }
}
DI float key_of(float v, int idx) { return __uint_as_float((__float_as_uint(v) & ~127u) | (unsigned)(127 - idx)); }
DI int idx_of(float k) { return 127 - (int)(__float_as_uint(k) & 127u); }
DI float val_of(float k) { return __uint_as_float(__float_as_uint(k) & ~127u); }
DI float gelu_erf(float x) {
    const float ax = fabsf(x) * 0.70710678118654752f;
    const float t = __builtin_amdgcn_rcpf(1.0f + 0.3275911f * ax);
    const float poly = ((((1.061405429f * t - 1.453152027f) * t + 1.421413741f) * t - 0.284496736f) * t + 0.254829592f) * t;
    const float er = 1.0f - poly * __expf(-ax * ax);
    return 0.5f * x * (1.0f + (x < 0.f ? -er : er));
}
constexpr int PK_EID = 0, PK_GATE = 8192;
DI void phase_peer(const Ctx& c, int layer, const float* lg, const float* lb, float* dstf) {
    unsigned char* ws = c.a->ws;
    const float* SC = (const float*)(ws + WS_SC);
    const float* X1 = (const float*)(ws + WS_F2);
    const bf16_t* UT = (const bf16_t*)(ws + WS_UT) + (size_t)layer * 16384 * DM;
    const bf16_t* VTB = (const bf16_t*)(ws + WS_VTAB) + (size_t)layer * 16384 * DM;
    bf16_t* XB = (bf16_t*)(ws + WS_XB);
    LAS int* eid = (LAS int*)(c.lds + PK_EID); LAS float* gat = (LAS float*)(c.lds + PK_GATE);
    const int lane = c.lane, w = c.wave;
    for (int tb = c.bid; tb < M_TOK / 64; tb += c.G) {
        const int tok0 = tb * 64;
        if (lane < 32) {
            const int pr = w * 32 + lane, tl = pr >> 2, hd = pr & 3;
            const float* sp = SC + (size_t)(tok0 + tl) * 1024 + hd * 256;
            float L1[16], L2[16];
#pragma unroll
            for (int i = 0; i < 16; ++i) { L1[i] = -3.0e38f; L2[i] = -3.0e38f; }
#pragma unroll 1
            for (int i = 0; i < 128; i += 4) {
                const f32x4 a = *(const f32x4*)(sp + i), b = *(const f32x4*)(sp + 128 + i);
#pragma unroll
                for (int j = 0; j < 4; ++j) { topk_insert<16>(L1, key_of(a[j], i + j)); topk_insert<16>(L2, key_of(b[j], i + j)); }
            }
            float cv[8], ce[8];
#pragma unroll
            for (int i = 0; i < 8; ++i) { cv[i] = -3.0e38f; ce[i] = 0.f; }
#pragma unroll
            for (int i = 0; i < 8; ++i)
#pragma unroll
                for (int j = 0; j < 8; ++j)
                    if ((i + 1) * (j + 1) <= 8) {
                        float v = val_of(L1[i]) + val_of(L2[j]);
                        float ex = __int_as_float(idx_of(L1[i]) * 128 + idx_of(L2[j]));
#pragma unroll
                        for (int k = 0; k < 8; ++k) { const bool gt = v > cv[k]; const float tv = gt ? cv[k] : v, te = gt ? ce[k] : ex; cv[k] = gt ? v : cv[k]; ce[k] = gt ? ex : ce[k]; v = tv; ex = te; }
                    }
            float sm = 0.f, pe[8];
#pragma unroll
            for (int k = 0; k < 8; ++k) { pe[k] = __expf(cv[k] - cv[0]); sm += pe[k]; }
            const float inv = 1.0f / sm;
#pragma unroll
            for (int k = 0; k < 8; ++k) { eid[tl * 32 + hd * 8 + k] = __float_as_int(ce[k]); gat[tl * 32 + hd * 8 + k] = pe[k] * inv; }
        }
        __syncthreads();
#pragma unroll 1
        for (int tt = 0; tt < 8; ++tt) {
            const int tl = w * 8 + tt, tok = tok0 + tl;
            float xv[32];
            const float* xp = X1 + (size_t)tok * DM;
#pragma unroll
            for (int i = 0; i < 4; ++i) { const f32x4 a = *(const f32x4*)(xp + 512 * i + 8 * lane), b = *(const f32x4*)(xp + 512 * i + 8 * lane + 4);
#pragma unroll
                for (int j = 0; j < 4; ++j) { xv[8 * i + j] = a[j]; xv[8 * i + 4 + j] = b[j]; } }
            const int my_e = eid[tl * 32 + (lane & 31)]; const float my_g = gat[tl * 32 + (lane & 31)];
            float hsum = 0.f;
#pragma unroll 1
            for (int e0 = 0; e0 < 32; e0 += 4) {
                u32x4 rw[4][4];
#pragma unroll
                for (int k = 0; k < 4; ++k) { const int ex = __builtin_amdgcn_readlane(my_e, e0 + k); const bf16_t* rp = UT + (size_t)ex * DM + 8 * lane;
#pragma unroll
                    for (int i = 0; i < 4; ++i) rw[k][i] = *(const u32x4*)(rp + 512 * i); }
#pragma unroll
                for (int k = 0; k < 4; ++k) {
                    float s = 0.f;
#pragma unroll
                    for (int i = 0; i < 4; ++i) {
                        s += xv[8 * i + 0] * bf_lo(rw[k][i].x) + xv[8 * i + 1] * bf_hi(rw[k][i].x) + xv[8 * i + 2] * bf_lo(rw[k][i].y) + xv[8 * i + 3] * bf_hi(rw[k][i].y)
                           + xv[8 * i + 4] * bf_lo(rw[k][i].z) + xv[8 * i + 5] * bf_hi(rw[k][i].z) + xv[8 * i + 6] * bf_lo(rw[k][i].w) + xv[8 * i + 7] * bf_hi(rw[k][i].w); }
                    s = wave_sum(s);
                    if (lane == e0 + k) hsum = s;
                }
            }
            const float act = gelu_erf(hsum) * my_g;
            float ov[32];
#pragma unroll
            for (int i = 0; i < 32; ++i) ov[i] = 0.f;
#pragma unroll 1
            for (int e0 = 0; e0 < 32; e0 += 4) {
                u32x4 rw[4][4];
#pragma unroll
                for (int k = 0; k < 4; ++k) { const int ex = __builtin_amdgcn_readlane(my_e, e0 + k); const bf16_t* rp = VTB + (size_t)ex * DM + 8 * lane;
#pragma unroll
                    for (int i = 0; i < 4; ++i) rw[k][i] = *(const u32x4*)(rp + 512 * i); }
#pragma unroll
                for (int k = 0; k < 4; ++k) {
                    const float ak = __int_as_float(__builtin_amdgcn_readlane(__float_as_int(act), e0 + k));
#pragma unroll
                    for (int i = 0; i < 4; ++i) {
                        ov[8 * i + 0] += ak * bf_lo(rw[k][i].x); ov[8 * i + 1] += ak * bf_hi(rw[k][i].x); ov[8 * i + 2] += ak * bf_lo(rw[k][i].y); ov[8 * i + 3] += ak * bf_hi(rw[k][i].y);
                        ov[8 * i + 4] += ak * bf_lo(rw[k][i].z); ov[8 * i + 5] += ak * bf_hi(rw[k][i].z); ov[8 * i + 6] += ak * bf_lo(rw[k][i].w); ov[8 * i + 7] += ak * bf_hi(rw[k][i].w); }
                }
            }
#pragma unroll
            for (int i = 0; i < 32; ++i) ov[i] += DN_ALPHA * xv[i];
            ln_row(ov, lg, lb, dstf + (size_t)tok * DM, XB + (size_t)tok * DM, lane);
        }
        __syncthreads();
    }
}
#ifndef EN_PRO
#define EN_PRO 1
#endif
#ifndef EN_GEMM0
#define EN_GEMM0 1
#endif
#ifndef EN_PREP
#define EN_PREP 1
#endif
#ifndef EN_SB
#define EN_SB 1
#endif
#ifndef EN_SCAN
#define EN_SCAN 1
#endif
#ifndef EN_GOUT
#define EN_GOUT 1
#endif
#ifndef EN_GEMM4
#define EN_GEMM4 1
#endif
#ifndef EN_LN
#define EN_LN 1
#endif
#ifndef EN_GEMM6
#define EN_GEMM6 1
#endif
#ifndef EN_PEER
#define EN_PEER 1
#endif
constexpr int NPH = 1 + 8 * DEPTH;
__host__ __device__ constexpr bool phase_exists(int ph) { return ph == 0 || !((((ph - 1) >> 3) & 1) && ((((ph - 1) & 7) == 2) || (((ph - 1) & 7) == 3))); }

__global__ void __launch_bounds__(NTHREADS, 2) hybrid_fwd(Args args) {
    extern __shared__ __attribute__((aligned(16))) unsigned char lds_raw[];
    Ctx c;
    c.a = (ArgsP)__builtin_amdgcn_kernarg_segment_ptr(); c.lds = (LAS unsigned char*)lds_raw; c.tid = threadIdx.x; c.lane = c.tid & 63; c.wave = __builtin_amdgcn_readfirstlane(c.tid >> 6); c.G = gridDim.x; c.bid = blockIdx.x;
    unsigned char* ws = c.a->ws;
    const int lo = c.a->ph_lo, hi = c.a->ph_hi;
    const bool fused = (hi - lo) > 1;
    volatile LAS unsigned* xbst = (volatile LAS unsigned*)(c.lds + LDS_CTL);
    if (c.tid < 4) xbst[c.tid] = 0u;
    __syncthreads();
    XcdBarrier bar; bar.bar = (unsigned*)(ws + WS_CTL); bar.x = 0; bar.st = xbst;
    if (fused) bar = xcd_barrier_post((unsigned*)(ws + WS_CTL), xbst);
#define IN(k) (lo <= (k) && (k) < hi)
#define FRESH() do { int t_ = threadIdx.x; asm volatile("" : "+v"(t_)); c.tid = t_; c.lane = t_ & 63; c.wave = __builtin_amdgcn_readfirstlane(t_ >> 6); ArgsP a_ = (ArgsP)__builtin_amdgcn_kernarg_segment_ptr(); asm volatile("" : "+s"(a_)); c.a = a_; ws = a_->ws; } while (0)
#define SEAM(k) do { if (fused && (k) + 1 < hi) xcd_barrier(bar); } while (0)
    LAS unsigned char* glds = (LAS unsigned char*)c.lds;

    if (IN(0)) {
#if EN_PRO
 FRESH(); phase_prologue(c);
#endif
 SEAM(0); }

#pragma unroll 1
    for (int L = 0; L < DEPTH; ++L) {
        const int base = 1 + 8 * L, li = L >> 1;
        const bool gdn = (L & 1) == 0;

        if (IN(base + 0)) {
#if EN_GEMM0
            FRESH();
            {   pg8::MultiOrder S; S.G = c.G; S.c = c.bid; S.nj = 0;
                bf16_t* const XBp = (bf16_t*)(ws + WS_XB); bf16_t* const Pp = (bf16_t*)(ws + WS_P);
                pg8::Job jz{XBp, XBp, Pp, 0, 0, 0};
                S.j[0] = jz; S.j[1] = jz; S.j[2] = jz; S.j[3] = jz;
                if (gdn) { S.j[0] = pg8::Job{XBp, (const bf16_t*)(ws + WS_WG) + (size_t)li * GDN_NP * DM, Pp, M_TOK, GDN_NP, LDP}; S.nj = 1; }
                else { S.j[0] = pg8::Job{XBp, (const bf16_t*)(ws + WS_WSB) + (size_t)li * SB_NP * DM, Pp, M_TOK, SB_NP, LDP};
                       S.j[1] = pg8::Job{(const bf16_t*)(ws + WS_WSBV) + (size_t)li * 1024 * DM, XBp, (bf16_t*)(ws + WS_VT), 1024, M_TOK, M_TOK}; S.nj = 2; }
                if (L == 0) {
                    S.j[1] = pg8::Job{(const bf16_t*)(ws + WS_MEMB), (const bf16_t*)(ws + WS_WK), (bf16_t*)(ws + WS_KM), NMEM, 2048, 2048};
                    S.j[2] = pg8::Job{(const bf16_t*)(ws + WS_WV), (const bf16_t*)(ws + WS_MEMB), (bf16_t*)(ws + WS_VMT), 2048, NMEM, NMEM}; S.nj = 3; }
                pg8::Gemm g{XBp, XBp, M_TOK, 256, DM};
                pg8::EpiBf16Multi E{S.j[0].O, S.j[1].O, S.j[2].O, S.j[3].O, S.j[0].ldc, S.j[1].ldc, S.j[2].ldc, S.j[3].ldc};
                pg8::gemm_phase<pg8::EpiBf16Multi, pg8::MultiOrder>(glds, g, S, E, nullptr); }
#endif
            SEAM(base + 0);
        }
        if (IN(base + 1)) {

#if EN_PREP
 FRESH(); if (gdn) phase_gdn_prep(c, li);
#endif
#if EN_SB
 FRESH(); if (!gdn) phase_sb_attn(c, L);
#endif

            SEAM(base + 1);
        }
        if (gdn && IN(base + 2)) {
#if EN_SCAN
FRESH();             if (c.G > 8) { if (c.bid < 8) phase_gdn_scan(c, L, c.bid); else mem_attn_all(c, L, GC_QM, c.bid - 8, c.G - 8); }
            else { for (int hd = c.bid; hd < 8; hd += c.G) { phase_gdn_scan(c, L, hd); __syncthreads(); } mem_attn_all(c, L, GC_QM, c.bid, c.G); }
#endif
            SEAM(base + 2);
        }
        if (gdn && IN(base + 3)) {
#if EN_GOUT
 FRESH(); phase_gdn_out(c, li);
#endif
 SEAM(base + 3); }
        if (IN(base + 4)) {
#if EN_GEMM4
            FRESH(); const float* xres = (L == 0) ? c.a->x : (const float*)(ws + WS_F0);
            pg8::Gemm g{(const bf16_t*)(ws + WS_MIX), (const bf16_t*)(ws + WS_WO) + (size_t)L * DM * MIXW, M_TOK, DM, MIXW};
            pg8::StaticOrder S; S.init(M_TOK, DM, c.G, c.bid);
            pg8::EpiResid E{xres, (float*)(ws + WS_F1), DM, DN_ALPHA};
            pg8::gemm_phase<pg8::EpiResid, pg8::StaticOrder>(glds, g, S, E, nullptr);
#endif
            SEAM(base + 4);
        }
        if (IN(base + 5)) {
#if EN_LN
FRESH();             phase_ln(c, (const float*)(ws + WS_F1), c.a->ln_mix_g + L * DM, c.a->ln_mix_b + L * DM, (float*)(ws + WS_F2), (bf16_t*)(ws + WS_XB));
#endif
            SEAM(base + 5);
        }
        if (IN(base + 6)) {
#if EN_GEMM6
            FRESH();
            pg8::Gemm g{(const bf16_t*)(ws + WS_XB), (const bf16_t*)(ws + WS_WP) + (size_t)L * 1024 * DM, M_TOK, 1024, DM};
            pg8::StaticOrder S; S.init(M_TOK, 1024, c.G, c.bid);
            pg8::EpiF32 E{(float*)(ws + WS_SC), 1024};
            pg8::gemm_phase<pg8::EpiF32, pg8::StaticOrder>(glds, g, S, E, nullptr);
#endif
            SEAM(base + 6);
        }
        if (IN(base + 7)) {
#if EN_PEER
FRESH();             phase_peer(c, L, c.a->ln_ffn_g + L * DM, c.a->ln_ffn_b + L * DM, (L == DEPTH - 1) ? c.a->out : (float*)(ws + WS_F0));
#endif
            SEAM(base + 7);
        }
    }
#undef IN
#undef SEAM
}

#ifndef MK_FUSED
#define MK_FUSED 0
#endif
extern "C" void kernel_launch(void* const* d_in, const int* in_sizes, int n_in, void* d_out, int out_size, void* d_ws, size_t ws_size, hipStream_t stream) {
    static int grid = 0;
    if (grid == 0) {
        if (n_in != 18 || out_size != M_TOK * DM || ws_size < WS_END) { fprintf(stderr, "kernel_launch: unexpected shapes (n_in %d out %d ws %zu need %zu)\n", n_in, out_size, ws_size, (size_t)WS_END); grid = -1; return; }
        int dev = 0, cus = 0, per_cu = 0;
        if (hipGetDevice(&dev) != hipSuccess || hipDeviceGetAttribute(&cus, hipDeviceAttributeMultiprocessorCount, dev) != hipSuccess) { grid = -1; return; }
        if (hipFuncSetAttribute((const void*)hybrid_fwd, hipFuncAttributeMaxDynamicSharedMemorySize, LDS_BYTES) != hipSuccess) { fprintf(stderr, "kernel_launch: hipFuncSetAttribute failed\n"); grid = -1; return; }
        if (hipOccupancyMaxActiveBlocksPerMultiprocessor(&per_cu, (const void*)hybrid_fwd, NTHREADS, LDS_BYTES) != hipSuccess || per_cu < 1) { fprintf(stderr, "kernel_launch: occupancy query says %d\n", per_cu); (void)hipGetLastError(); }
        grid = cus;
    }
    if (grid < 0) return;
    hipMemsetAsync((char*)d_ws + WS_CTL, 0, WS_CTL_BYTES, stream);
    Args a{};
    a.x = (const float*)d_in[0]; a.mem = (const float*)d_in[1]; a.gdn_w_in = (const float*)d_in[2]; a.gdn_conv = (const float*)d_in[3]; a.gdn_a_log = (const float*)d_in[4];
    a.gdn_dt_bias = (const float*)d_in[5]; a.gdn_onorm = (const float*)d_in[6]; a.sb_w_in = (const float*)d_in[7]; a.mem_w_kv = (const float*)d_in[8]; a.w_out = (const float*)d_in[9];
    a.ln_mix_g = (const float*)d_in[10]; a.ln_mix_b = (const float*)d_in[11]; a.peer_w_q = (const float*)d_in[12]; a.peer_keys = (const float*)d_in[13]; a.peer_u = (const float*)d_in[14];
    a.peer_v = (const float*)d_in[15]; a.ln_ffn_g = (const float*)d_in[16]; a.ln_ffn_b = (const float*)d_in[17];
    a.out = (float*)d_out; a.ws = (unsigned char*)d_ws;
#if MK_FUSED
    a.ph_lo = 0; a.ph_hi = NPH;
    hipLaunchKernelGGL(hybrid_fwd, dim3(grid), dim3(NTHREADS), LDS_BYTES, stream, a);
#else
    for (int ph = 0; ph < NPH; ++ph) {
        if (!phase_exists(ph)) continue;
        a.ph_lo = ph; a.ph_hi = ph + 1;
        hipLaunchKernelGGL(hybrid_fwd, dim3(grid), dim3(NTHREADS), LDS_BYTES, stream, a);
    }
#endif
}
```

```cpp
#include <hip/hip_runtime.h>
#include <stdio.h>
#include <stdint.h>

#define LAS __attribute__((address_space(3)))
typedef unsigned short bf16_t;
typedef short bf16x8 __attribute__((ext_vector_type(8)));
typedef short s16x4 __attribute__((ext_vector_type(4)));
typedef float f32x2 __attribute__((ext_vector_type(2)));
typedef float f32x4 __attribute__((ext_vector_type(4)));
typedef float f32x16 __attribute__((ext_vector_type(16)));
typedef unsigned u32x2 __attribute__((ext_vector_type(2)));
typedef unsigned u32x4 __attribute__((ext_vector_type(4)));
typedef __bf16 bfx2 __attribute__((ext_vector_type(2)));
typedef float f32x32 __attribute__((ext_vector_type(32)));
typedef unsigned u32x6 __attribute__((ext_vector_type(6)));
#define DI __device__ __forceinline__

DI unsigned pk2(float lo, float hi) { f32x2 v = {lo, hi}; return __builtin_bit_cast(unsigned, __builtin_convertvector(v, bfx2)); }
DI bf16_t f2bf(float f) { return (bf16_t)(pk2(f, 0.f) & 0xffffu); }
DI float bf_lo(unsigned w) { return __uint_as_float(w << 16); }
DI float bf_hi(unsigned w) { return __uint_as_float(w & 0xffff0000u); }
DI float bf2f(bf16_t b) { return __uint_as_float(((unsigned)b) << 16); }
DI float row_sum16(float v) {
    v += __int_as_float(__builtin_amdgcn_update_dpp(0, __float_as_int(v), 0xB1, 0xF, 0xF, true));
    v += __int_as_float(__builtin_amdgcn_update_dpp(0, __float_as_int(v), 0x4E, 0xF, 0xF, true));
    v += __int_as_float(__builtin_amdgcn_update_dpp(0, __float_as_int(v), 0x141, 0xF, 0xF, true));
    v += __int_as_float(__builtin_amdgcn_update_dpp(0, __float_as_int(v), 0x140, 0xF, 0xF, true));
    return v; }
DI float swap16_sum(float a, float b) { auto r = __builtin_amdgcn_permlane16_swap(__float_as_uint(a), __float_as_uint(b), false, false); return __uint_as_float(r[0]) + __uint_as_float(r[1]); }
DI float swap32_sum(float a, float b) { auto r = __builtin_amdgcn_permlane32_swap(__float_as_uint(a), __float_as_uint(b), false, false); return __uint_as_float(r[0]) + __uint_as_float(r[1]); }
DI float wave_sum(float v) { v = row_sum16(v); v = swap16_sum(v, v); return swap32_sum(v, v); }
DI float wave_max(float v) {
    v = fmaxf(v, __int_as_float(__builtin_amdgcn_update_dpp(0, __float_as_int(v), 0xB1, 0xF, 0xF, true)));
    v = fmaxf(v, __int_as_float(__builtin_amdgcn_update_dpp(0, __float_as_int(v), 0x4E, 0xF, 0xF, true)));
    v = fmaxf(v, __int_as_float(__builtin_amdgcn_update_dpp(0, __float_as_int(v), 0x141, 0xF, 0xF, true)));
    v = fmaxf(v, __int_as_float(__builtin_amdgcn_update_dpp(0, __float_as_int(v), 0x140, 0xF, 0xF, true)));
    { auto r = __builtin_amdgcn_permlane16_swap(__float_as_uint(v), __float_as_uint(v), false, false); v = fmaxf(__uint_as_float(r[0]), __uint_as_float(r[1])); }
    { auto r = __builtin_amdgcn_permlane32_swap(__float_as_uint(v), __float_as_uint(v), false, false); v = fmaxf(__uint_as_float(r[0]), __uint_as_float(r[1])); }
    return v; }
DI float wave_sum4(float s0, float s1, float s2, float s3) { return row_sum16(swap16_sum(swap32_sum(s0, s2), swap32_sum(s1, s3))); }
DI float fast_exp(float x) { return __builtin_amdgcn_exp2f(x * 1.44269504088896f); }
DI float sigmoidf_(float x) { return __builtin_amdgcn_rcpf(1.0f + fast_exp(-x)); }
DI float siluf_(float x) { return x * sigmoidf_(x); }
constexpr float F8_ACT = 16.0f, F8_WIN = 2048.0f, F8_WOUT = 4096.0f;
constexpr int E8_ACT = 123, E8_WIN = 116, E8_WOUT = 115;
DI float f8c(float v, float sc) { return fminf(fmaxf(v * sc, -448.0f), 448.0f); }
DI unsigned pk4_f8(float a, float b, float c2, float d, float sc) { int t = 0; t = __builtin_amdgcn_cvt_pk_fp8_f32(f8c(a, sc), f8c(b, sc), t, false); t = __builtin_amdgcn_cvt_pk_fp8_f32(f8c(c2, sc), f8c(d, sc), t, true); return (unsigned)t; }
DI bf16x8 pack8(float a0, float a1, float a2, float a3, float a4, float a5, float a6, float a7) {
    u32x4 p; p.x = pk2(a0, a1); p.y = pk2(a2, a3); p.z = pk2(a4, a5); p.w = pk2(a6, a7); return __builtin_bit_cast(bf16x8, p); }
#define MFMA32(a, b, c) __builtin_amdgcn_mfma_f32_32x32x16_bf16((a), (b), (c), 0, 0, 0)
#define MFMA16(a, b, c) __builtin_amdgcn_mfma_f32_16x16x32_bf16((a), (b), (c), 0, 0, 0)

constexpr int M_TOK = 16384, DM = 2048, DEPTH = 4, NMEM = 256, HD = 128;
constexpr int LDP = 3840;
constexpr int GDN_NP = 3840, SB_NP = 2560;
constexpr int MIXW = 1536;
constexpr float DN_ALPHA = 1.681792830507429f;
constexpr float LN_EPS = 1e-5f, RMS_EPS = 1e-6f;
constexpr int NTHREADS = 512;
constexpr int LDS_BYTES = 160 * 1024;
constexpr int LDS_CTL = LDS_BYTES - 256;

constexpr int GC_Q = 0, GC_K = 512, GC_V = 1024, GC_Z = 2048, GC_QM = 3072, GC_B = 3584, GC_A = 3592;
constexpr int SC_Q = 0, SC_K = 1024, SC_QM = 2048;

constexpr int REC_W = 0, REC_QG = 16384, REC_KDT = 32768, REC_AQK = 49152, REC_U = 57344, REC_BYTES = 73728;

constexpr size_t al256(size_t x) { return (x + 255) & ~(size_t)255; }
constexpr size_t WS_CTL = 0;
constexpr size_t WS_CTL_BYTES = 65536;
constexpr size_t WS_XB = WS_CTL + WS_CTL_BYTES;
constexpr size_t WS_F0 = WS_XB + (size_t)M_TOK * DM * 2;
constexpr size_t WS_F1 = WS_F0 + (size_t)M_TOK * DM * 4;
constexpr size_t WS_F2 = WS_F1 + (size_t)M_TOK * DM * 4;
constexpr size_t WS_P = WS_F2 + (size_t)M_TOK * DM * 4;
constexpr size_t WS_VT = WS_P + (size_t)M_TOK * LDP * 2;
constexpr size_t WS_REC = WS_VT + (size_t)1024 * M_TOK * 2;
constexpr size_t WS_GAM = WS_REC + (size_t)2048 * REC_BYTES;
constexpr size_t WS_OG = WS_GAM + 8192;
constexpr size_t WS_MIX = WS_OG + (size_t)M_TOK * 1024 * 4;
constexpr size_t WS_SC = WS_MIX + (size_t)M_TOK * MIXW * 2;
constexpr size_t WS_MEMB = WS_SC + (size_t)M_TOK * 1024 * 4;
constexpr size_t WS_KM = WS_MEMB + (size_t)NMEM * DM * 2;
constexpr size_t WS_VMT = WS_KM + (size_t)NMEM * 2048 * 2;
constexpr size_t WS_WG = WS_VMT + (size_t)2048 * NMEM * 2;
constexpr size_t WS_WSB = WS_WG + (size_t)2 * GDN_NP * DM * 2;
constexpr size_t WS_WSBV = WS_WSB + (size_t)2 * SB_NP * DM * 2;
constexpr size_t WS_WK = WS_WSBV + (size_t)2 * 1024 * DM * 2;
constexpr size_t WS_WV = WS_WK + (size_t)2048 * DM * 2;
constexpr size_t WS_WO = WS_WV + (size_t)2048 * DM * 2;
constexpr size_t WS_WP = WS_WO + (size_t)4 * DM * MIXW * 2;
#ifndef PEER_UBITS
#define PEER_UBITS 4
#endif
#ifndef PEER_VBITS
#define PEER_VBITS 4
#endif
constexpr int UROW = 256 * PEER_UBITS, VROW = 256 * PEER_VBITS;
constexpr size_t WS_UT = WS_WP + (size_t)4 * 1024 * DM * 2;
constexpr size_t WS_VTAB = WS_UT + (size_t)4 * 16384 * UROW;
constexpr size_t WS_USC = WS_VTAB + (size_t)4 * 16384 * VROW;
constexpr size_t WS_VSC = WS_USC + (size_t)4 * 16384 * 4;
constexpr size_t WS_PHI = WS_VSC + (size_t)4 * 16384 * 4;
constexpr size_t WS_SLOC = WS_PHI + (size_t)256 * 32768;
constexpr size_t WS_SIN = WS_SLOC + (size_t)256 * 32768;
constexpr size_t WS_X8 = WS_SIN + (size_t)256 * 32768;
constexpr size_t WS_CP1 = WS_X8 + (size_t)M_TOK * DM;
constexpr size_t WS_CP2 = WS_CP1 + (size_t)4 * 32 * 1024 * 4;
constexpr size_t WS_C12 = WS_CP2 + (size_t)4 * 32 * 1024 * 4;
constexpr size_t WS_END = WS_C12 + (size_t)4 * 2 * 1024 * 4;

struct Args {
    const float* x; const float* mem; const float* gdn_w_in; const float* gdn_conv; const float* gdn_a_log; const float* gdn_dt_bias; const float* gdn_onorm;
    const float* sb_w_in; const float* mem_w_kv; const float* w_out; const float* ln_mix_g; const float* ln_mix_b; const float* peer_w_q; const float* peer_keys;
    const float* peer_u; const float* peer_v; const float* ln_ffn_g; const float* ln_ffn_b;
    float* out; unsigned char* ws; int ph_lo, ph_hi;
};
namespace pg8 {
#define PG8_LAS __attribute__((address_space(3)))
typedef unsigned short bf16_t;
typedef short bf16x8 __attribute__((ext_vector_type(8)));
typedef float f32x4 __attribute__((ext_vector_type(4)));
typedef unsigned u32x4 __attribute__((ext_vector_type(4)));
constexpr int BM = 256, BK = 64, HALF = 128, HTB = HALF * BK * 2  , STAGE_BYTES = 8 * HTB, NXCD = 8, WGM = 8;

__host__ __device__ __forceinline__ int lds_byte(int r, int c) { const int st = (r >> 4) * 2 + (c >> 5), rr = r & 15, cc = c & 31, ob = rr * 64 + cc * 2; return st * 1024 + (ob ^ (((ob >> 9) & 1) << 5)); }
__host__ __device__ __forceinline__ void stage_rc(int b, int& R, int& C) { const int st = b / 1024, sb = b % 1024, swz = sb ^ (((sb >> 9) & 1) << 5); R = (st >> 1) * 16 + swz / 64; C = (st & 1) * 32 + (swz % 64) / 2; }
__host__ __device__ __forceinline__ int perm32(int rho) { const int n = rho >> 4, i = rho & 15; return 8 * (i >> 2) + 4 * n + (i & 3); }

struct Unit { int pm, pn, job; };
struct Gemm { const bf16_t* A; const bf16_t* Bt; int M, N, K; int sA, sB; };
typedef int i32x4v __attribute__((ext_vector_type(4)));
typedef int i32x8v __attribute__((ext_vector_type(8)));

struct StaticOrder {
    int nM, nN, nwg, G, c;
    __host__ __device__ void init(int M, int N, int G_, int c_) { nM = M / BM; nN = N / BM; nwg = nM * nN; G = G_; c = c_; }
    __host__ __device__ bool next(int i, Unit& u) const {
        const long L = (long)i * G + c; if (L >= nwg) return false;
        int wgid = (int)L; { const int q = nwg / NXCD, r = nwg % NXCD, xcd = wgid % NXCD, off = wgid / NXCD; wgid = (xcd < r ? xcd * (q + 1) : r * (q + 1) + (xcd - r) * q) + off; }
        const int nig = WGM * nN, gid = wgid / nig, fm = gid * WGM, gsz = (nM - fm) < WGM ? (nM - fm) : WGM;
        u.pm = fm + ((wgid % nig) % gsz); u.pn = (wgid % nig) / gsz; u.job = 0; return true;
    }
    __device__ __forceinline__ const char* ptrA(const Gemm& g, const Unit&) const { return (const char*)g.A; }
    __device__ __forceinline__ const char* ptrB(const Gemm& g, const Unit&) const { return (const char*)g.Bt; }
    __device__ __forceinline__ void a_ready(const Unit&) const {}
    __device__ __forceinline__ void done(const Unit&) const {}
};
struct EpiF32 {
    static constexpr bool PERM = false, AFTER_DRAIN = false;
    float* C; int ldc;
    __device__ __forceinline__ void operator()(const f32x4 (&acc)[2][2][4][2], const Unit& u, int wr, int wc, int fr, int fq) const {
        const int row0 = u.pm * BM + wr * 64 + fr, col0 = u.pn * BM + wc * 32 + 4 * fq;
#pragma unroll
        for (int ai = 0; ai < 2; ++ai)
#pragma unroll
            for (int m = 0; m < 4; ++m) { float* rowp = C + (size_t)(row0 + ai * HALF + m * 16) * ldc + col0;
#pragma unroll
                for (int bj = 0; bj < 2; ++bj)
#pragma unroll
                    for (int n = 0; n < 2; ++n) *(f32x4*)(rowp + bj * HALF + n * 16) = acc[ai][bj][m][n]; }
    }
};
struct EpiResid {
    static constexpr bool PERM = true, AFTER_DRAIN = false;
    const bf16_t* X; bf16_t* T; int ldc; float alpha;
    __device__ __forceinline__ void operator()(const f32x4 (&acc)[2][2][4][2], const Unit& u, int wr, int wc, int fr, int fq) const {
        const int row0 = u.pm * BM + wr * 64 + fr, col0 = u.pn * BM + wc * 32 + 8 * fq;
        u32x4 xv[2][4][2];
#pragma unroll
        for (int ai = 0; ai < 2; ++ai)
#pragma unroll
            for (int m = 0; m < 4; ++m)
#pragma unroll
                for (int bj = 0; bj < 2; ++bj) xv[ai][m][bj] = *(const u32x4*)(X + (size_t)(row0 + ai * HALF + m * 16) * ldc + col0 + bj * HALF);
#pragma unroll
        for (int ai = 0; ai < 2; ++ai)
#pragma unroll
            for (int m = 0; m < 4; ++m) { const size_t off = (size_t)(row0 + ai * HALF + m * 16) * ldc + col0;
#pragma unroll
                for (int bj = 0; bj < 2; ++bj) { const f32x4 v0 = acc[ai][bj][m][0], v1 = acc[ai][bj][m][1]; const u32x4 x = xv[ai][m][bj];
                    u32x4 w; w.x = ::pk2(::bf_lo(x.x) * alpha + v0[0], ::bf_hi(x.x) * alpha + v0[1]); w.y = ::pk2(::bf_lo(x.y) * alpha + v0[2], ::bf_hi(x.y) * alpha + v0[3]);
                    w.z = ::pk2(::bf_lo(x.z) * alpha + v1[0], ::bf_hi(x.z) * alpha + v1[1]); w.w = ::pk2(::bf_lo(x.w) * alpha + v1[2], ::bf_hi(x.w) * alpha + v1[3]);
                    *(u32x4*)(T + off + bj * HALF) = w; } }
    }
};
struct EpiBf16 {
    static constexpr bool PERM = true, AFTER_DRAIN = false;
    bf16_t* O; int ldc;
    __device__ __forceinline__ void operator()(const f32x4 (&acc)[2][2][4][2], const Unit& u, int wr, int wc, int fr, int fq) const {
        const int row0 = u.pm * BM + wr * 64 + fr, col0 = u.pn * BM + wc * 32 + 8 * fq;
#pragma unroll
        for (int ai = 0; ai < 2; ++ai)
#pragma unroll
            for (int m = 0; m < 4; ++m) { bf16_t* rowp = O + (size_t)(row0 + ai * HALF + m * 16) * ldc + col0;
#pragma unroll
                for (int bj = 0; bj < 2; ++bj) { const f32x4 v0 = acc[ai][bj][m][0], v1 = acc[ai][bj][m][1];
                    u32x4 w; w.x = ::pk2(v0[0], v0[1]); w.y = ::pk2(v0[2], v0[3]); w.z = ::pk2(v1[0], v1[1]); w.w = ::pk2(v1[2], v1[3]);
                    *(u32x4*)(rowp + bj * HALF) = w; } }
    }
};

struct Job { const bf16_t* A; const bf16_t* Bt; bf16_t* O; int M, N, ldc; };
struct MultiOrder {
    Job j[4]; int nj, G, c;
    __device__ __forceinline__ bool next(int i, Unit& u) const {
        long L = (long)i * G + c; int job = -1, M = 0, N = 0;
#pragma unroll
        for (int k = 0; k < 4; ++k) { if (job < 0 && k < nj) { const int n = (j[k].M / BM) * (j[k].N / BM); if (L < n) { job = k; M = j[k].M; N = j[k].N; } else L -= n; } }
        if (job < 0) return false;
        const int nM = M / BM, nN = N / BM, nwg = nM * nN;
        int wgid = (int)L; { const int q = nwg / NXCD, r = nwg % NXCD, xcd = wgid % NXCD, off = wgid / NXCD; wgid = (xcd < r ? xcd * (q + 1) : r * (q + 1) + (xcd - r) * q) + off; }
        const int nig = WGM * nN, gid = wgid / nig, fm = gid * WGM, gsz = (nM - fm) < WGM ? (nM - fm) : WGM;
        u.pm = fm + ((wgid % nig) % gsz); u.pn = (wgid % nig) / gsz; u.job = job; return true;
    }
    __device__ __forceinline__ const char* ptrA(const Gemm&, const Unit& u) const { return (const char*)(u.job == 0 ? j[0].A : u.job == 1 ? j[1].A : u.job == 2 ? j[2].A : j[3].A); }
    __device__ __forceinline__ const char* ptrB(const Gemm&, const Unit& u) const { return (const char*)(u.job == 0 ? j[0].Bt : u.job == 1 ? j[1].Bt : u.job == 2 ? j[2].Bt : j[3].Bt); }
    __device__ __forceinline__ void a_ready(const Unit&) const {}
    __device__ __forceinline__ void done(const Unit&) const {}
};
struct EpiBf16Multi {
    static constexpr bool PERM = true, AFTER_DRAIN = false;
    bf16_t* O0; bf16_t* O1; bf16_t* O2; bf16_t* O3; int l0, l1, l2, l3;
    __device__ __forceinline__ void operator()(const f32x4 (&acc)[2][2][4][2], const Unit& u, int wr, int wc, int fr, int fq) const {
        bf16_t* O = u.job == 0 ? O0 : u.job == 1 ? O1 : u.job == 2 ? O2 : O3; const int ldc = u.job == 0 ? l0 : u.job == 1 ? l1 : u.job == 2 ? l2 : l3;
        const int row0 = u.pm * BM + wr * 64 + fr, col0 = u.pn * BM + wc * 32 + 8 * fq;
#pragma unroll
        for (int ai = 0; ai < 2; ++ai)
#pragma unroll
            for (int m = 0; m < 4; ++m) { bf16_t* rowp = O + (size_t)(row0 + ai * HALF + m * 16) * ldc + col0;
#pragma unroll
                for (int bj = 0; bj < 2; ++bj) { const f32x4 v0 = acc[ai][bj][m][0], v1 = acc[ai][bj][m][1];
                    u32x4 w; w.x = ::pk2(v0[0], v0[1]); w.y = ::pk2(v0[2], v0[3]); w.z = ::pk2(v1[0], v1[1]); w.w = ::pk2(v1[2], v1[3]);
                    *(u32x4*)(rowp + bj * HALF) = w; } }
    }
};
template <class Epi, class Sched, bool STAMP = false, bool F8 = false, int SA = 127, int SB = 127>
__device__ __forceinline__ void gemm_phase(PG8_LAS unsigned char* lds, const Gemm g, const Sched& S, const Epi& E, unsigned long long* stamps) {
    int tid_ = threadIdx.x; asm volatile("" : "+v"(tid_));
    const int tid = tid_, wid = __builtin_amdgcn_readfirstlane(tid >> 6), lane = tid & 63, wr = wid >> 2, wc = wid & 3, fr = lane & 15, fq = lane >> 4;
    const int K = g.K, nt = K / BK;
    int ts_lo = 0, ts_hi = 0, nts = 0; const unsigned long long rt_entry = STAMP ? (unsigned long long)wall_clock64() : 0ull;
#define PG8_STAMP() do { if (STAMP && wid == 0 && nts < 64) { const unsigned long long _c = (unsigned long long)clock64(); \
        ts_lo = (lane == nts) ? (int)(unsigned)_c : ts_lo; ts_hi = (lane == nts) ? (int)(unsigned)(_c >> 32) : ts_hi; ++nts; } } while (0)
    PG8_STAMP();
    unsigned voffA[2], voffB[2];
#pragma unroll
    for (int i = 0; i < 2; ++i) { int R, C; stage_rc(tid * 16 + i * 8192, R, C); const int Rb = Epi::PERM ? ((R & ~31) + perm32(R & 31)) : R;
        voffA[i] = (unsigned)(R * K + C) * 2u; voffB[i] = (unsigned)(Rb * K + C) * 2u; }
    const size_t kstep = (size_t)(BK * 2);
    const size_t hstep = (size_t)HALF * K * 2;
    const size_t tstep = 2 * hstep;
    const unsigned ldsw = (unsigned)wid * 1024u;
    const int aoff = lds_byte(wr * 64 + fr, fq * 8), boff = lds_byte(wc * 32 + fr, fq * 8);
#define PG8_SA(b, h) (((b) * 2 + (h)) * HTB)
#define PG8_SB(b, h) ((4 + (b) * 2 + (h)) * HTB)
#define PG8_STAGE(bufoff, gbase, voff) do { _Pragma("unroll") for (int _i = 0; _i < 2; ++_i) \
        __builtin_amdgcn_global_load_lds((const unsigned*)((const char*)(gbase) + (voff)[_i]), (PG8_LAS unsigned*)(lds + (bufoff) + ldsw + _i * 8192), 16, 0, 0); } while (0)
#define PG8_LDA(dst, b, h) do { _Pragma("unroll") for (int m = 0; m < 4; ++m) _Pragma("unroll") for (int k = 0; k < 2; ++k) dst[m][k] = *(const PG8_LAS bf16x8*)(lds + PG8_SA(b, h) + aoff + m * 2048 + k * 1024); } while (0)
#define PG8_LDB(dst, b, h) do { _Pragma("unroll") for (int n = 0; n < 2; ++n) _Pragma("unroll") for (int k = 0; k < 2; ++k) dst[n][k] = *(const PG8_LAS bf16x8*)(lds + PG8_SB(b, h) + boff + n * 2048 + k * 1024); } while (0)
#define PG8_MMA_BF(ai, bj, At, Bt) do { __builtin_amdgcn_s_setprio(1); _Pragma("unroll") for (int m = 0; m < 4; ++m) _Pragma("unroll") for (int n = 0; n < 2; ++n) _Pragma("unroll") for (int k = 0; k < 2; ++k) \
        acc[ai][bj][m][n] = __builtin_amdgcn_mfma_f32_16x16x32_bf16(Bt[n][k], At[m][k], acc[ai][bj][m][n], 0, 0, 0); __builtin_amdgcn_s_setprio(0); } while (0)
#define PG8_MMA_F8(ai, bj, At, Bt) do { __builtin_amdgcn_s_setprio(1); _Pragma("unroll") for (int m = 0; m < 4; ++m) _Pragma("unroll") for (int n = 0; n < 2; ++n) { \
        const i32x8v bq_ = __builtin_shufflevector(__builtin_bit_cast(i32x4v, Bt[n][0]), __builtin_bit_cast(i32x4v, Bt[n][1]), 0, 1, 2, 3, 4, 5, 6, 7); \
        const i32x8v aq_ = __builtin_shufflevector(__builtin_bit_cast(i32x4v, At[m][0]), __builtin_bit_cast(i32x4v, At[m][1]), 0, 1, 2, 3, 4, 5, 6, 7); \
          \
        asm volatile("v_mfma_scale_f32_16x16x128_f8f6f4 %0, %1, %2, %0, %3, %4 op_sel_hi:[0,0,0]" : "+v"(acc[ai][bj][m][n]) : "v"(bq_), "v"(aq_), "v"(f8_sa), "v"(f8_sb)); } __builtin_amdgcn_s_setprio(0); } while (0)
#define PG8_MMA(ai, bj, At, Bt) do { if constexpr (F8) PG8_MMA_F8(ai, bj, At, Bt); else PG8_MMA_BF(ai, bj, At, Bt); } while (0)
#define PG8_WAIT_V(n) asm volatile("s_waitcnt vmcnt(" #n ")" ::: "memory")
#define PG8_WAIT_L(n) asm volatile("s_waitcnt lgkmcnt(" #n ")" ::: "memory")
#define PG8_BAR __builtin_amdgcn_s_barrier()
#define PG8_SCHED __builtin_amdgcn_sched_barrier(0)
    Unit cur, nxt; int ui = 0;
    if (!S.next(0, cur)) return;
    f32x4 acc[2][2][4][2];
#pragma unroll
    for (int a = 0; a < 2; ++a)
#pragma unroll
        for (int b = 0; b < 2; ++b)
#pragma unroll
            for (int m = 0; m < 4; ++m)
#pragma unroll
                for (int n = 0; n < 2; ++n) acc[a][b][m][n] = (f32x4){0.f, 0.f, 0.f, 0.f};
    bf16x8 At[4][2], B0[2][2], B1[2][2];
    int f8_sa = SA, f8_sb = SB; if constexpr (F8) asm volatile("" : "+v"(f8_sa), "+v"(f8_sb));
    const char* cA = S.ptrA(g, cur) + (size_t)cur.pm * tstep; const char* cB = S.ptrB(g, cur) + (size_t)cur.pn * tstep;
    S.a_ready(cur);
    PG8_STAGE(PG8_SB(0, 0), cB, voffB); PG8_STAGE(PG8_SA(0, 0), cA, voffA); PG8_STAGE(PG8_SB(0, 1), cB + hstep, voffB); PG8_STAGE(PG8_SA(0, 1), cA + hstep, voffA);
    if (wr == 1) PG8_BAR;
    PG8_WAIT_V(4); PG8_BAR;
    PG8_STAGE(PG8_SB(1, 0), cB + kstep, voffB); PG8_STAGE(PG8_SA(1, 0), cA + kstep, voffA); PG8_STAGE(PG8_SB(1, 1), cB + hstep + kstep, voffB);
    PG8_WAIT_V(6); PG8_BAR;
    PG8_STAMP();
    for (;;) {
        const bool has_next = S.next(ui + 1, nxt);
        const char* nA = has_next ? S.ptrA(g, nxt) + (size_t)nxt.pm * tstep : cA; const char* nB = has_next ? S.ptrB(g, nxt) + (size_t)nxt.pn * tstep : cB;
        for (int t = 0; t < nt; t += 2) {
            const bool last = (t == nt - 2);
            const char* a1 = cA + (size_t)(t + 1) * kstep;
            const char* a2 = last ? nA : cA + (size_t)(t + 2) * kstep; const char* b2 = last ? nB : cB + (size_t)(t + 2) * kstep;
            const char* a3 = a2 + kstep; const char* b3 = b2 + kstep;
            if (last && has_next) S.a_ready(nxt);
            PG8_LDB(B0, 0, 0); PG8_SCHED; PG8_LDA(At, 0, 0); PG8_STAGE(PG8_SA(1, 1), a1 + hstep, voffA);
            PG8_WAIT_L(8); PG8_BAR; PG8_WAIT_L(0); PG8_MMA(0, 0, At, B0); PG8_BAR; PG8_SCHED;
            PG8_LDB(B1, 0, 1); PG8_STAGE(PG8_SB(0, 0), b2, voffB);
            PG8_BAR; PG8_WAIT_L(0); PG8_MMA(0, 1, At, B1); PG8_BAR;
            PG8_LDA(At, 0, 1); PG8_STAGE(PG8_SA(0, 0), a2, voffA);
            PG8_BAR; PG8_WAIT_L(0); PG8_MMA(1, 0, At, B0); PG8_BAR; PG8_SCHED;
            PG8_STAGE(PG8_SB(0, 1), b2 + hstep, voffB);
            PG8_WAIT_V(6); PG8_BAR; PG8_MMA(1, 1, At, B1); PG8_BAR;
            PG8_LDB(B0, 1, 0); PG8_SCHED; PG8_LDA(At, 1, 0); PG8_STAGE(PG8_SA(0, 1), a2 + hstep, voffA);
            PG8_WAIT_L(8); PG8_BAR; PG8_WAIT_L(0); PG8_MMA(0, 0, At, B0); PG8_BAR; PG8_SCHED;
            PG8_LDB(B1, 1, 1); PG8_STAGE(PG8_SB(1, 0), b3, voffB);
            PG8_BAR; PG8_WAIT_L(0); PG8_MMA(0, 1, At, B1); PG8_BAR;
            PG8_LDA(At, 1, 1); PG8_STAGE(PG8_SA(1, 0), a3, voffA);
            PG8_BAR; PG8_WAIT_L(0); PG8_MMA(1, 0, At, B0); PG8_BAR; PG8_SCHED;
            PG8_STAGE(PG8_SB(1, 1), b3 + hstep, voffB);
            PG8_WAIT_V(6); PG8_BAR; PG8_MMA(1, 1, At, B1); PG8_BAR;
        }
        PG8_STAMP();
        if constexpr (F8) asm volatile("s_nop 15\n\ts_nop 15" ::: "memory");
        if constexpr (!Epi::AFTER_DRAIN) { E(acc, cur, wr, wc, fr, fq); S.done(cur); }
        PG8_STAMP();
        if (!has_next) break;
#pragma unroll
        for (int a = 0; a < 2; ++a)
#pragma unroll
            for (int b = 0; b < 2; ++b)
#pragma unroll
                for (int m = 0; m < 4; ++m)
#pragma unroll
                    for (int n = 0; n < 2; ++n) acc[a][b][m][n] = (f32x4){0.f, 0.f, 0.f, 0.f};
        cur = nxt; cA = nA; cB = nB; ++ui;
    }
    PG8_WAIT_V(0);
    if (wr == 0) PG8_BAR;
    PG8_BAR;
    if constexpr (Epi::AFTER_DRAIN) { E.fused(acc, cur, wr, wc, fr, fq, lds, wid, lane); S.done(cur); }
    PG8_STAMP();
    if (STAMP && wid == 0) { stamps[lane] = lane < nts ? (((unsigned long long)(unsigned)ts_hi << 32) | (unsigned)ts_lo) : 0ull;
        if (lane == 62) stamps[62] = rt_entry; if (lane == 63) stamps[63] = (unsigned long long)wall_clock64(); }
#undef PG8_STAMP
#undef PG8_SA
#undef PG8_SB
#undef PG8_STAGE
#undef PG8_LDA
#undef PG8_LDB
#undef PG8_MMA
#undef PG8_MMA_BF
#undef PG8_MMA_F8
#undef PG8_WAIT_V
#undef PG8_WAIT_L
#undef PG8_BAR
#undef PG8_SCHED
}
}
#define XB_TMO      128
#define XB_XCNT(j)  (256  + 64 * (j))
#define XB_XSUB(j)  (1280 + 64 * (j))
#define XB_XGEN(j)  (2304 + 64 * (j))
#define XB_TOP      3328
#define XB_TOPGEN   3392
#define XCD_BAR_WORDS 3456
#define XB_SPIN_CAP (1u << 18)

__device__ __forceinline__ unsigned xb_ld(unsigned* p)              { return __hip_atomic_load(p, __ATOMIC_RELAXED, __HIP_MEMORY_SCOPE_AGENT); }
__device__ __forceinline__ unsigned xb_add(unsigned* p, unsigned v) { return __hip_atomic_fetch_add(p, v, __ATOMIC_RELAXED, __HIP_MEMORY_SCOPE_AGENT); }
__device__ __forceinline__ unsigned xb_xcc_id() { return (unsigned)__builtin_amdgcn_s_getreg((3 << 11) | 20) & 0xFu; }
#define XB_SPIN(cond, bar) do { unsigned _sp = 0; while (cond) { __builtin_amdgcn_s_sleep(1); \
    if ((++_sp & 255u) == 0u) { if (xb_ld(&(bar)[XB_TMO])) break; if (_sp > XB_SPIN_CAP) { atomicAdd(&(bar)[XB_TMO], 1u); break; } } } } while (0)

struct XcdBarrier {
    unsigned* bar; unsigned x;
    volatile LAS unsigned* st;
};

__device__ __forceinline__ XcdBarrier xcd_barrier_post(unsigned* bar, volatile LAS unsigned* st) {
    XcdBarrier b; b.bar = bar; b.x = xb_xcc_id(); b.st = st;
    if (threadIdx.x == 0) (void)xb_add(&bar[XB_XCNT(b.x)], 1u);
    return b;
}
__device__ __forceinline__ void xcd_barrier_complete(unsigned* bar, unsigned x, unsigned& nloc, unsigned& nx) {
    const unsigned G = gridDim.x * gridDim.y * gridDim.z;
    unsigned sum, cnt, mine, sp = 0u;
    for (;;) {
        sum = 0u; cnt = 0u; mine = 0u;
#pragma unroll
        for (unsigned j = 0; j < 16; ++j) { const unsigned c = xb_ld(&bar[XB_XCNT(j)]); sum += c; cnt += (c > 0u) ? 1u : 0u; mine = (j == x) ? c : mine; }
        if (sum == G) break;
        __builtin_amdgcn_s_sleep(1);
        if ((++sp & 255u) == 0u) { if (xb_ld(&bar[XB_TMO])) break; if (sp > XB_SPIN_CAP) { atomicAdd(&bar[XB_TMO], 1u); break; } }
    }
    nloc = mine > 0u ? mine : 1u; nx = cnt > 0u ? cnt : 1u;
}

__device__ __forceinline__ void xcd_barrier(const XcdBarrier& b) {
    asm volatile("s_waitcnt vmcnt(0)" ::: "memory");
    __syncthreads();
    if (threadIdx.x == 0) {
        unsigned* bar = b.bar;
        __builtin_amdgcn_s_waitcnt(0);
        unsigned nloc = b.st[0], nx = b.st[1];
        if (nloc == 0u) { xcd_barrier_complete(bar, b.x, nloc, nx); b.st[0] = nloc; b.st[1] = nx; }
        const unsigned old = xb_add(&bar[XB_XSUB(b.x)], 1u);
        const unsigned gen = old / nloc;
        if (old + 1u == (gen + 1u) * nloc) {
            __builtin_amdgcn_fence(__ATOMIC_RELEASE, "agent");
            asm volatile("s_waitcnt vmcnt(0)" ::: "memory");
            const unsigned og = xb_add(&bar[XB_TOP], 1u);
            const unsigned tg = og / nx;
            if (og + 1u == (tg + 1u) * nx) xb_add(&bar[XB_TOPGEN], 1u);
            else XB_SPIN(xb_ld(&bar[XB_TOPGEN]) == tg, bar);
            __builtin_amdgcn_fence(__ATOMIC_ACQUIRE, "agent");
            xb_add(&bar[XB_XGEN(b.x)], 1u);
            asm volatile("s_waitcnt vmcnt(0)" ::: "memory");
        } else {
            XB_SPIN(xb_ld(&bar[XB_XGEN(b.x)]) == gen, bar);
            __builtin_amdgcn_fence(__ATOMIC_ACQUIRE, "agent");
            asm volatile("s_waitcnt vmcnt(0)" ::: "memory");
        }
    }
    __syncthreads();
}
typedef const __attribute__((address_space(4))) Args* ArgsP;
struct Ctx {
    ArgsP a; LAS unsigned char* lds; int tid, lane, wave, G, bid;
};

template <bool F8> DI void transpose_job(const Ctx& c, int& rr, const float* src, int ld, int col0, int nvalid, void* dstv, int K, int row0, int ncols, float sc) {
    LAS float* tile = (LAS float*)c.lds;
    const int tilesN = ncols / 256, nt = tilesN * (K / 64);
    int t = c.bid - rr % c.G; if (t < 0) t += c.G;
    rr += nt;
    for (; t < nt; t += c.G) {
        const int tn = t % tilesN, tk = t / tilesN;
        {   const int kk = c.tid >> 4, n4 = (c.tid & 15) * 4;
            f32x4 v[2][4];
#pragma unroll
            for (int i = 0; i < 2; ++i)
#pragma unroll
                for (int j = 0; j < 4; ++j) v[i][j] = *(const f32x4*)(src + (size_t)(tk * 64 + kk + 32 * i) * ld + col0 + tn * 256 + 64 * j + n4);
#pragma unroll
            for (int i = 0; i < 2; ++i)
#pragma unroll
                for (int j = 0; j < 4; ++j)
#pragma unroll
                    for (int e = 0; e < 4; ++e) tile[j * 4160 + (kk + 32 * i) * 65 + n4 + e] = (tn * 256 + 64 * j + n4 + e < nvalid) ? v[i][j][e] : 0.f;
        }
        __syncthreads();
        {   const int n = c.tid >> 3, k8 = (c.tid & 7) * 8;
#pragma unroll
            for (int j = 0; j < 4; ++j) {
                float v[8];
#pragma unroll
                for (int e = 0; e < 8; ++e) v[e] = tile[j * 4160 + (k8 + e) * 65 + n];
                if constexpr (F8) { u32x2 w; w.x = pk4_f8(v[0], v[1], v[2], v[3], sc); w.y = pk4_f8(v[4], v[5], v[6], v[7], sc);
                    *(u32x2*)((unsigned char*)dstv + (size_t)(row0 + tn * 256 + 64 * j + n) * K + tk * 64 + k8) = w; }
                else { u32x4 w; w.x = pk2(v[0], v[1]); w.y = pk2(v[2], v[3]); w.z = pk2(v[4], v[5]); w.w = pk2(v[6], v[7]);
                    *(u32x4*)((bf16_t*)dstv + (size_t)(row0 + tn * 256 + 64 * j + n) * K + tk * 64 + k8) = w; } } }
        __syncthreads();
    }
}
DI void convert_job(const Ctx& c, const float* src, bf16_t* dst, unsigned char* dst8, size_t n, bool nt) {
    const size_t stride = (size_t)c.G * NTHREADS * 8;
    for (size_t i = ((size_t)c.bid * NTHREADS + c.tid) * 8; i < n; i += stride) {
        f32x4 a, b;
        if (nt) { a = __builtin_nontemporal_load((const f32x4*)(src + i)); b = __builtin_nontemporal_load((const f32x4*)(src + i + 4)); }
        else { a = *(const f32x4*)(src + i); b = *(const f32x4*)(src + i + 4); }
        if (dst) { u32x4 w; w.x = pk2(a[0], a[1]); w.y = pk2(a[2], a[3]); w.z = pk2(b[0], b[1]); w.w = pk2(b[2], b[3]); *(u32x4*)(dst + i) = w; }
        u32x2 w8; w8.x = pk4_f8(a[0], a[1], a[2], a[3], F8_ACT); w8.y = pk4_f8(b[0], b[1], b[2], b[3], F8_ACT); *(u32x2*)(dst8 + i) = w8;
    }
}
DI bool fp6_interleaved() {
    f32x16 a, b;
#pragma unroll
    for (int i = 0; i < 16; ++i) { a[i] = 1.0f; b[i] = 2.0f; }
    const f32x32 d = __builtin_amdgcn_cvt_scalef32_pk32_f32_fp6(__builtin_amdgcn_cvt_scalef32_2xpk16_fp6_f32(a, b, 1.0f), 1.0f);
    return d[1] == 2.0f;
}
DI u32x6 fp6_pack32(const float (&e)[32], bool il) {
    f32x16 a, b;
    if (il) {
#pragma unroll
        for (int i = 0; i < 16; ++i) { a[i] = e[2 * i]; b[i] = e[2 * i + 1]; } }
    else {
#pragma unroll
        for (int i = 0; i < 16; ++i) { a[i] = e[i]; b[i] = e[16 + i]; } }
    return __builtin_amdgcn_cvt_scalef32_2xpk16_fp6_f32(a, b, 1.0f);
}
DI bool fp4_swapped() {
    const unsigned w = __builtin_amdgcn_cvt_scalef32_pk_fp4_f32(0u, 1.0f, 2.0f, 1.0f, 0);
    const f32x2 d = __builtin_amdgcn_cvt_scalef32_pk_f32_fp4(w, 1.0f, 0);
    return d.x == 2.0f;
}
DI u32x4 fp4_pack32(const float (&e)[32], bool sw) {
    u32x4 r;
#pragma unroll
    for (int dw = 0; dw < 4; ++dw) {
        unsigned w = 0u;
        const float e0 = sw ? e[8 * dw + 1] : e[8 * dw], e1 = sw ? e[8 * dw] : e[8 * dw + 1], e2 = sw ? e[8 * dw + 3] : e[8 * dw + 2], e3 = sw ? e[8 * dw + 2] : e[8 * dw + 3];
        const float e4 = sw ? e[8 * dw + 5] : e[8 * dw + 4], e5 = sw ? e[8 * dw + 4] : e[8 * dw + 5], e6 = sw ? e[8 * dw + 7] : e[8 * dw + 6], e7 = sw ? e[8 * dw + 6] : e[8 * dw + 7];
        w = __builtin_amdgcn_cvt_scalef32_pk_fp4_f32(w, e0, e1, 1.0f, 0); w = __builtin_amdgcn_cvt_scalef32_pk_fp4_f32(w, e2, e3, 1.0f, 1);
        w = __builtin_amdgcn_cvt_scalef32_pk_fp4_f32(w, e4, e5, 1.0f, 2); w = __builtin_amdgcn_cvt_scalef32_pk_fp4_f32(w, e6, e7, 1.0f, 3);
        r[dw] = w; }
    return r;
}
DI void fp4_unpack32(const u32x4 p, float (&d)[32]) {
#pragma unroll
    for (int dw = 0; dw < 4; ++dw) {
        const f32x2 a = __builtin_amdgcn_cvt_scalef32_pk_f32_fp4(p[dw], 1.0f, 0), b = __builtin_amdgcn_cvt_scalef32_pk_f32_fp4(p[dw], 1.0f, 1);
        const f32x2 cc = __builtin_amdgcn_cvt_scalef32_pk_f32_fp4(p[dw], 1.0f, 2), dd = __builtin_amdgcn_cvt_scalef32_pk_f32_fp4(p[dw], 1.0f, 3);
        d[8 * dw] = a.x; d[8 * dw + 1] = a.y; d[8 * dw + 2] = b.x; d[8 * dw + 3] = b.y; d[8 * dw + 4] = cc.x; d[8 * dw + 5] = cc.y; d[8 * dw + 6] = dd.x; d[8 * dw + 7] = dd.y; }
}
template <int BITS> DI void convert_table_lp(const Ctx& c, const float* src, unsigned char* dst, float* inv_scale, int row_lo, int row_hi, int brank, int nblk) {
    const bool il = (BITS == 6) ? fp6_interleaved() : fp4_swapped();
    constexpr float TOP = (BITS == 6) ? 7.4f : 6.0f;
    for (int row = row_lo + brank * 8 + c.wave; row < row_hi; row += nblk * 8) {
        const float* sp = src + (size_t)row * DM + 4 * c.lane;
        f32x4 v[8];
#pragma unroll
        for (int j = 0; j < 8; ++j) v[j] = __builtin_nontemporal_load((const f32x4*)(sp + 256 * j));
        float mx = 0.f;
#pragma unroll
        for (int j = 0; j < 8; ++j) mx = fmaxf(mx, fmaxf(fmaxf(fabsf(v[j][0]), fabsf(v[j][1])), fmaxf(fabsf(v[j][2]), fabsf(v[j][3]))));
        mx = wave_max(mx);
        const float sc = mx > 0.f ? TOP / mx : 1.0f;
        float e[32];
#pragma unroll
        for (int j = 0; j < 8; ++j)
#pragma unroll
            for (int q = 0; q < 4; ++q) e[4 * j + q] = v[j][q] * sc;
        if constexpr (BITS == 6) {
            const u32x6 pk = fp6_pack32(e, il);
            u32x2* dp = (u32x2*)(dst + (size_t)row * 1536 + 24 * c.lane);
            dp[0] = (u32x2){pk[0], pk[1]}; dp[1] = (u32x2){pk[2], pk[3]}; dp[2] = (u32x2){pk[4], pk[5]};
        } else {
            *(u32x4*)(dst + (size_t)row * 1024 + 16 * c.lane) = fp4_pack32(e, il);
        }
        if (c.lane == 0) inv_scale[row] = mx > 0.f ? mx * (1.0f / TOP) : 1.0f;
    }
}
DI void split_store(LAS unsigned char* hi, LAS unsigned char* lo, const f32x4 v) {
    u32x2 h, l; h.x = pk2(v[0], v[1]); h.y = pk2(v[2], v[3]);
    l.x = pk2(v[0] - bf_lo(h.x), v[1] - bf_hi(h.x)); l.y = pk2(v[2] - bf_lo(h.y), v[3] - bf_hi(h.y));
    *(LAS u32x2*)hi = h; *(LAS u32x2*)lo = l; }
DI void fold_peer(const Ctx& c) {
    constexpr int FP_KH = 0, FP_KL = 128 * 272, FP_WH = 2 * 128 * 272, FP_WL = FP_WH + 64 * 272;
    LAS unsigned char* L = c.lds;
    bf16_t* WP = (bf16_t*)(c.a->ws + WS_WP);
    const int ntile = 4 * 8 * 32, per = (ntile + c.G - 1) / c.G;
    int last = -1;
    for (int t = c.bid * per; t < ntile && t < (c.bid + 1) * per; ++t) {
        const int ihp = t >> 5, dt = t & 31, i = ihp >> 3, hp = ihp & 7, p = hp & 1;
        __syncthreads();
        if (ihp != last) { last = ihp;
            const float* ks = c.a->peer_keys + (size_t)(i * 2 + p) * 128 * 128;
            for (int e = c.tid * 4; e < 128 * 128; e += NTHREADS * 4) { const f32x4 v = *(const f32x4*)(ks + e); const int n = e >> 7, cc = e & 127;
                split_store(L + FP_KH + n * 272 + cc * 2, L + FP_KL + n * 272 + cc * 2, v); } }
        {   const float* wq = c.a->peer_w_q + (size_t)i * DM * 1024 + (size_t)(dt * 64) * 1024 + hp * 128;
            for (int e = c.tid * 4; e < 64 * 128; e += NTHREADS * 4) { const int d = e >> 7, cc = e & 127; const f32x4 v = *(const f32x4*)(wq + (size_t)d * 1024 + cc);
                split_store(L + FP_WH + d * 272 + cc * 2, L + FP_WL + d * 272 + cc * 2, v); } }
        __syncthreads();
        {
            const int r16 = c.lane & 15, q4 = c.lane >> 4;
            f32x4 acc[4];
#pragma unroll
            for (int t4 = 0; t4 < 4; ++t4) acc[t4] = (f32x4){0.f, 0.f, 0.f, 0.f};
#pragma unroll
            for (int ks = 0; ks < 4; ++ks) {
                const int ao = (16 * c.wave + r16) * 272 + (32 * ks + 8 * q4) * 2;
                const bf16x8 ah = *(const LAS bf16x8*)(L + FP_KH + ao), al = *(const LAS bf16x8*)(L + FP_KL + ao);
#pragma unroll
                for (int t4 = 0; t4 < 4; ++t4) {
                    const int bo = (16 * t4 + r16) * 272 + (32 * ks + 8 * q4) * 2;
                    const bf16x8 bh = *(const LAS bf16x8*)(L + FP_WH + bo), bl = *(const LAS bf16x8*)(L + FP_WL + bo);
                    acc[t4] = MFMA16(al, bh, acc[t4]); acc[t4] = MFMA16(ah, bl, acc[t4]); acc[t4] = MFMA16(ah, bh, acc[t4]);
                }
            }
            const float* g1p = c.a->ln_mix_g + i * DM + dt * 64; const float* b1p = c.a->ln_mix_b + i * DM + dt * 64;
            float p1[4] = {0.f, 0.f, 0.f, 0.f}, p2[4] = {0.f, 0.f, 0.f, 0.f};
#pragma unroll
            for (int t4 = 0; t4 < 4; ++t4) { const float gd = g1p[16 * t4 + r16], bd = b1p[16 * t4 + r16];
#pragma unroll
                for (int e = 0; e < 4; ++e) { const unsigned wgb = pk2(acc[t4][e] * gd, 0.f);
                    WP[((size_t)i * 1024 + hp * 128 + 16 * c.wave + 4 * q4 + e) * DM + dt * 64 + 16 * t4 + r16] = (bf16_t)(wgb & 0xffffu);
                    p1[e] += bf_lo(wgb); p2[e] += bd * acc[t4][e]; } }
#pragma unroll
            for (int e = 0; e < 4; ++e) {
                p1[e] = row_sum16(p1[e]); p2[e] = row_sum16(p2[e]);
                if (r16 == 0) { const size_t ix = (size_t)(i * 32 + dt) * 1024 + hp * 128 + 16 * c.wave + 4 * q4 + e;
                    ((float*)(c.a->ws + WS_CP1))[ix] = p1[e]; ((float*)(c.a->ws + WS_CP2))[ix] = p2[e]; } }
        }
    }
    __syncthreads();
}
#ifndef REP_PA
#define REP_PA 1
#define REP_PB 1
#define REP_PC 1
#endif
DI void phase_prologue(const Ctx& c) {
    unsigned char* ws = c.a->ws;
    convert_job(c, c.a->x, (bf16_t*)(ws + WS_XB), ws + WS_X8, (size_t)M_TOK * DM, false);
    convert_job(c, c.a->mem, (bf16_t*)nullptr, ws + WS_MEMB, (size_t)NMEM * DM, false);
    int rr = 0;
#pragma unroll 1
    for (int rpa = 0; rpa < REP_PA; ++rpa) {
    for (int li = 0; li < 2; ++li) {
        const float* src = c.a->gdn_w_in + (size_t)li * DM * 3600; unsigned char* dst = ws + WS_WG + (size_t)li * GDN_NP * DM;
        transpose_job<true>(c, rr, src, 3600, 0, 3072, dst, DM, 0, 3072, F8_WIN);
        transpose_job<true>(c, rr, src, 3600, 3088, 512, dst, DM, GC_QM, 512, F8_WIN);
        transpose_job<true>(c, rr, src, 3600, 3072, 16, dst, DM, GC_B, 256, F8_WIN);
        const float* s2 = c.a->sb_w_in + (size_t)li * DM * 3584; unsigned char* d2 = ws + WS_WSB + (size_t)li * SB_NP * DM;
        transpose_job<true>(c, rr, s2, 3584, 0, 2048, d2, DM, 0, 2048, F8_WIN);
        transpose_job<true>(c, rr, s2, 3584, 3072, 512, d2, DM, SC_QM, 512, F8_WIN);
        transpose_job<true>(c, rr, s2, 3584, 2048, 1024, ws + WS_WSBV + (size_t)li * 1024 * DM, DM, 0, 1024, F8_WIN);
    }
    for (int i = 0; i < DEPTH; ++i) {
        const float* kv = c.a->mem_w_kv + (size_t)i * DM * 1024;
        transpose_job<true>(c, rr, kv, 1024, 0, 512, ws + WS_WK, DM, i * 512, 512, F8_WIN);
        transpose_job<true>(c, rr, kv, 1024, 512, 512, ws + WS_WV, DM, i * 512, 512, F8_WIN);
        transpose_job<true>(c, rr, c.a->w_out + (size_t)i * MIXW * DM, DM, 0, DM, ws + WS_WO + (size_t)i * DM * MIXW, MIXW, 0, DM, F8_WOUT);
    }
    }
#pragma unroll 1
    for (int rpb = 0; rpb < REP_PB; ++rpb) fold_peer(c);
}

DI void convert_tables(const Ctx& c, int l0, int brank, int nblk) {
    if (nblk <= 0) return;
    unsigned char* ws = c.a->ws;
    convert_table_lp<PEER_UBITS>(c, c.a->peer_u, ws + WS_UT, (float*)(ws + WS_USC), l0 * 16384, (l0 + 2) * 16384, brank, nblk);
    convert_table_lp<PEER_VBITS>(c, c.a->peer_v, ws + WS_VTAB, (float*)(ws + WS_VSC), l0 * 16384, (l0 + 2) * 16384, brank, nblk);
}

DI void peer_c12_finalize(const Ctx& c, int i) {
    const float* cp1 = (const float*)(c.a->ws + WS_CP1) + (size_t)i * 32 * 1024; const float* cp2 = (const float*)(c.a->ws + WS_CP2) + (size_t)i * 32 * 1024;
    float* c12 = (float*)(c.a->ws + WS_C12) + (size_t)i * 2 * 1024;
    for (int n = c.tid; n < 1024; n += NTHREADS) { float s1 = 0.f, s2 = 0.f;
        for (int dt = 0; dt < 32; ++dt) { s1 += cp1[dt * 1024 + n]; s2 += cp2[dt * 1024 + n]; }
        c12[n] = s1; c12[1024 + n] = s2; }
}
DI int swap23(int x) { return (x & ~12) | ((x & 4) << 1) | ((x & 8) >> 1); }
constexpr int G2_KBF = 0, G2_QBF = 17408, G2_RHST = 34816, G2_KDT = 71680, G2_MM = 90112, G2_TM = 107520, G2_XS = 124928, G2_GATE = 131456;
DI void phase_gdn_prep(const Ctx& c, int li) {
    unsigned char* ws = c.a->ws;
    const bf16_t* P = (const bf16_t*)(ws + WS_P);
    const float* convw = c.a->gdn_conv + (size_t)li * 4 * 2048;
    LAS unsigned char* L = c.lds;
    LAS float* gate = (LAS float*)(L + G2_GATE);
    LAS float* Mm = (LAS float*)(L + G2_MM);
    LAS float* Tm = (LAS float*)(L + G2_TM);
    LAS float* Xs = (LAS float*)(L + G2_XS);
    const int tid = c.tid, lane = c.lane, w = c.wave;
    unsigned short gb_n = 0, ga_n = 0;
    if (w == 0 && c.bid < 2048) { const size_t row = (size_t)((c.bid >> 3) * 64 + lane) * LDP; gb_n = P[row + GC_B + (c.bid & 7)]; ga_n = P[row + GC_A + (c.bid & 7)]; }
    for (int u = c.bid; u < 2048; u += c.G) {
        const int h = u & 7, n = u >> 3, t0 = n * 64;
        unsigned char* rec = ws + WS_REC + (size_t)(h * 256 + n) * REC_BYTES;
        const unsigned short gb_c = gb_n, ga_c = ga_n;
        if (w == 0 && u + c.G < 2048) { const int un = u + c.G; const size_t row = (size_t)((un >> 3) * 64 + lane) * LDP; gb_n = P[row + GC_B + (un & 7)]; ga_n = P[row + GC_A + (un & 7)]; }
#ifndef RQ0
#define RQ0 1
#define RQ1 1
#define RQ2 1
#define RQ3 1
#define RQ4 1
#endif
#pragma unroll 1
        for (int rq0 = 0; rq0 < RQ0; ++rq0) {
        for (int e = tid; e < 64 * 68; e += NTHREADS) Tm[e] = 0.f;
        if (w == 0) {
            const float b = bf2f(gb_c), a = bf2f(ga_c);
            const float beta = sigmoidf_(b);
            const float xx = a + c.a->gdn_dt_bias[li * 8 + h];
            const float sp = fmaxf(xx, 0.f) + __logf(1.0f + __expf(-fabsf(xx)));
            float g = -__expf(c.a->gdn_a_log[li * 8 + h]) * sp;
#pragma unroll
            for (int o = 1; o < 64; o <<= 1) { const float v = __shfl_up(g, o); if (lane >= o) g += v; }
            const float gl = __shfl(g, 63);
            gate[lane] = beta; gate[64 + lane] = g; gate[128 + lane] = __expf(g); gate[192 + lane] = __expf(gl - g);
            if (lane == 0) ((float*)(ws + WS_GAM))[h * 256 + n] = __expf(gl);
        }
        __syncthreads();
        }
#pragma unroll 1
        for (int rq1 = 0; rq1 < RQ1; ++rq1)
#pragma unroll 1
        for (int sec = 0; sec < 3; ++sec) {
            int tid1 = tid; asm volatile("" : "+v"(tid1));
            const int cg = tid1 & 15, sA = tid1 >> 4;
            const int col = (sec == 0 ? GC_Q + (h >> 1) * 128 : sec == 1 ? GC_K + (h >> 1) * 128 : GC_V + h * 128) + cg * 8;
            u32x4 xr[2][4]; f32x4 cw[4][2];
#pragma unroll
            for (int it = 0; it < 2; ++it)
#pragma unroll
                for (int jj = 0; jj < 4; ++jj) { const int tt = t0 + sA + 32 * it - 3 + jj; const int tc = tt < 0 ? 0 : tt;
                    u32x4 xv = *(const u32x4*)(P + (size_t)tc * LDP + col); if (tt < 0) xv = (u32x4){0u, 0u, 0u, 0u}; xr[it][jj] = xv; }
#pragma unroll
            for (int jj = 0; jj < 4; ++jj) { cw[jj][0] = *(const f32x4*)(convw + jj * 2048 + col); cw[jj][1] = *(const f32x4*)(convw + jj * 2048 + col + 4); }
#pragma unroll
            for (int it = 0; it < 2; ++it) {
                const int s = sA + 32 * it;
                float acc[8];
#pragma unroll
                for (int e = 0; e < 8; ++e) acc[e] = 0.f;
#pragma unroll
                for (int jj = 0; jj < 4; ++jj) {
                    const u32x4 xv = xr[it][jj];
                    const f32x4 w0 = cw[jj][0], w1 = cw[jj][1];
                    acc[0] += w0[0] * bf_lo(xv.x); acc[1] += w0[1] * bf_hi(xv.x); acc[2] += w0[2] * bf_lo(xv.y); acc[3] += w0[3] * bf_hi(xv.y);
                    acc[4] += w1[0] * bf_lo(xv.z); acc[5] += w1[1] * bf_hi(xv.z); acc[6] += w1[2] * bf_lo(xv.w); acc[7] += w1[3] * bf_hi(xv.w);
                }
                float ss = 0.f;
#pragma unroll
                for (int e = 0; e < 8; ++e) { acc[e] = siluf_(acc[e]); ss += acc[e] * acc[e]; }
                const float beta = gate[s], eg = gate[128 + s], egl = gate[192 + s];
                if (sec < 2) {
                    ss += __shfl_xor(ss, 1); ss += __shfl_xor(ss, 2); ss += __shfl_xor(ss, 4); ss += __shfl_xor(ss, 8);
                    const float r = __builtin_amdgcn_rsqf(ss + RMS_EPS) * (sec == 0 ? 0.08838834764831845f : 1.0f);
#pragma unroll
                    for (int e = 0; e < 8; ++e) acc[e] *= r;
                    u32x4 wv; wv.x = pk2(acc[0], acc[1]); wv.y = pk2(acc[2], acc[3]); wv.z = pk2(acc[4], acc[5]); wv.w = pk2(acc[6], acc[7]);
                    *(LAS u32x4*)(L + (sec == 0 ? G2_QBF : G2_KBF) + s * 272 + cg * 16) = wv;
                    if (sec == 0) {
                        u32x2 lo, hi; lo.x = pk2(acc[0] * eg, acc[1] * eg); lo.y = pk2(acc[2] * eg, acc[3] * eg); hi.x = pk2(acc[4] * eg, acc[5] * eg); hi.y = pk2(acc[6] * eg, acc[7] * eg);
                        bf16_t* qg = (bf16_t*)(rec + REC_QG) + s * 128 + 16 * (cg >> 1) + 4 * (cg & 1);
                        *(u32x2*)qg = lo; *(u32x2*)(qg + 8) = hi;
                    } else {
                        const int ps = (s & ~15) | swap23(s & 15);
#pragma unroll
                        for (int e = 0; e < 8; ++e) {
                            *(LAS bf16_t*)(L + G2_RHST + (128 + cg * 8 + e) * 144 + (s ^ ((cg & 7) << 3)) * 2) = f2bf(acc[e] * beta * eg);
                            *(LAS bf16_t*)(L + G2_KDT + (cg * 8 + e) * 144 + (ps ^ ((cg & 7) << 3)) * 2) = f2bf(acc[e] * egl); }
                    }
                } else {
#pragma unroll
                    for (int e = 0; e < 8; ++e) *(LAS bf16_t*)(L + G2_RHST + (cg * 8 + e) * 144 + (s ^ ((cg & 7) << 3)) * 2) = f2bf(acc[e] * beta);
                }
            }
        }
        __syncthreads();
#pragma unroll 1
        for (int rq2 = 0; rq2 < RQ2; ++rq2)
        {   int lane2 = lane; asm volatile("" : "+v"(lane2));
            const int sel = w >> 2, i = w & 3, r = lane2 & 15, q = lane2 >> 4;
            bf16x8 af[4];
#pragma unroll
            for (int ks = 0; ks < 4; ++ks) af[ks] = *(const LAS bf16x8*)(L + (sel ? G2_QBF : G2_KBF) + (16 * i + r) * 272 + (32 * ks + 8 * q) * 2);
#pragma unroll
            for (int j = 0; j < 4; ++j) {
                f32x4 acc = {0.f, 0.f, 0.f, 0.f};
#pragma unroll
                for (int ks = 0; ks < 4; ++ks) { const bf16x8 bfr = *(const LAS bf16x8*)(L + G2_KBF + (16 * j + r) * 272 + (32 * ks + 8 * q) * 2); acc = MFMA16(af[ks], bfr, acc); }
                const int s = 16 * j + r; const float gs = gate[64 + s];
#pragma unroll
                for (int e = 0; e < 4; ++e) {
                    const int cc = 16 * i + 4 * q + e; const float dec = __expf(gate[64 + cc] - gs);
                    if (sel == 0) Mm[cc * 68 + s] = (s < cc) ? gate[cc] * acc[e] * dec : 0.f;
                    else { const int ps = (s & ~15) | swap23(s & 15); ((bf16_t*)(rec + REC_AQK))[cc * 64 + ps] = f2bf((s <= cc) ? acc[e] * dec : 0.f); }
                }
            }
        }
        __syncthreads();
#pragma unroll 1
        for (int rq3 = 0; rq3 < RQ3; ++rq3) { if (rq3) __syncthreads();
        if (w < 4 && lane < 16) {
            int lane3 = lane; asm volatile("" : "+v"(lane3));
            float mrow[16], tr[16];
#pragma unroll
            for (int i = 0; i < 16; ++i) mrow[i] = Mm[(16 * w + i) * 68 + 16 * w + lane3];
#pragma unroll
            for (int i = 0; i < 16; ++i) {
                float acc = (lane3 == i) ? 1.f : 0.f;
#pragma unroll
                for (int j = 0; j < i; ++j) acc -= __shfl(mrow[i], j, 16) * tr[j];
                tr[i] = acc;
            }
#pragma unroll
            for (int i = 0; i < 16; ++i) Tm[(16 * w + i) * 68 + 16 * w + lane3] = tr[i];
        }
        __syncthreads();
#pragma unroll 1
        for (int d = 1; d < 4; ++d) {
            if (w < 4 - d) {
                int l3 = lane; asm volatile("" : "+v"(l3));
                const int J = w, I = w + d, r16 = l3 & 15, q4 = l3 >> 4;
                f32x4 x = {0.f, 0.f, 0.f, 0.f};
                for (int K = J; K < I; ++K)
#pragma unroll
                    for (int ks = 0; ks < 4; ++ks) x = __builtin_amdgcn_mfma_f32_16x16x4f32(Mm[(16 * I + r16) * 68 + 16 * K + 4 * ks + q4], Tm[(16 * K + 4 * ks + q4) * 68 + 16 * J + r16], x, 0, 0, 0);
                LAS float* Xw = Xs + w * (16 * 17);
#pragma unroll
                for (int e = 0; e < 4; ++e) Xw[(4 * q4 + e) * 17 + r16] = x[e];
                f32x4 t = {0.f, 0.f, 0.f, 0.f};
#pragma unroll
                for (int ks = 0; ks < 4; ++ks) t = __builtin_amdgcn_mfma_f32_16x16x4f32(Tm[(16 * I + r16) * 68 + 16 * I + 4 * ks + q4], Xw[(4 * ks + q4) * 17 + r16], t, 0, 0, 0);
#pragma unroll
                for (int e = 0; e < 4; ++e) Tm[(16 * I + 4 * q4 + e) * 68 + 16 * J + r16] = -t[e];
            }
            __syncthreads();
        }
        }
#pragma unroll 1
        for (int rq4 = 0; rq4 < RQ4; ++rq4)
        {   int lane4 = lane, tid4 = tid; asm volatile("" : "+v"(lane4), "+v"(tid4));
            const int r = lane4 & 15, q = lane4 >> 4;
            f32x4 acc[4][2];
#pragma unroll
            for (int i = 0; i < 4; ++i) { acc[i][0] = (f32x4){0.f, 0.f, 0.f, 0.f}; acc[i][1] = (f32x4){0.f, 0.f, 0.f, 0.f}; }
#pragma unroll
            for (int ks = 0; ks < 2; ++ks) {
                bf16x8 bfr[2];
#pragma unroll
                for (int jt = 0; jt < 2; ++jt) { const int nrow = 32 * w + 16 * jt + r; bfr[jt] = *(const LAS bf16x8*)(L + G2_RHST + nrow * 144 + (((4 * ks + q) ^ ((nrow >> 3) & 7)) * 16)); }
#pragma unroll
                for (int i = 0; i < 4; ++i) {
                    const LAS float* tp = Tm + (16 * i + r) * 68 + 32 * ks + 8 * q;
                    const f32x4 t0v = *(const LAS f32x4*)tp, t1v = *(const LAS f32x4*)(tp + 4);
                    const bf16x8 af = pack8(t0v[0], t0v[1], t0v[2], t0v[3], t1v[0], t1v[1], t1v[2], t1v[3]);
                    acc[i][0] = MFMA16(af, bfr[0], acc[i][0]); acc[i][1] = MFMA16(af, bfr[1], acc[i][1]);
                }
            }
#pragma unroll
            for (int jt = 0; jt < 2; ++jt) {
                const int nn = 32 * w + 16 * jt + r;
                if (w < 4) {
#pragma unroll
                    for (int i = 0; i < 4; ++i) {
                        u32x2 wv; wv.x = pk2(acc[i][jt][0], acc[i][jt][1]); wv.y = pk2(acc[i][jt][2], acc[i][jt][3]);
                        *(u32x2*)(rec + REC_U + (size_t)((((nn >> 5) * 2 + (i >> 1)) * 64 + (nn & 31) + 32 * (q & 1)) * 32 + (8 * (i & 1) + 4 * (q >> 1)) * 2)) = wv; }
                } else {
                    const int dk = nn - 128, pd = (dk & ~15) | swap23(dk & 15);
#pragma unroll
                    for (int i = 0; i < 4; ++i)
#pragma unroll
                        for (int e = 0; e < 4; ++e) ((bf16_t*)(rec + REC_W))[(16 * i + 4 * q + e) * 128 + pd] = f2bf(acc[i][jt][e]);
                }
            }
#pragma unroll
            for (int pz = 0; pz < 2; ++pz) { const int piece = tid4 + NTHREADS * pz, row = piece >> 3, seg = piece & 7;
                *(u32x4*)(rec + REC_KDT + row * 128 + seg * 16) = *(const LAS u32x4*)(L + G2_KDT + row * 144 + ((seg ^ ((row >> 3) & 7)) * 16)); }
        }
        __syncthreads();
    }
}
constexpr int MA_K = 0, MA_V = 65536;
DI void mem_attn_all(const Ctx& c, int layer, int qcol, int brank, int nblk) {
    if (nblk < 4) return;
    unsigned char* ws = c.a->ws;
    LAS unsigned char* L = c.lds;
    const bf16_t* P = (const bf16_t*)(ws + WS_P);
    unsigned char* MIX = ws + WS_MIX;
    const int lane = c.lane, w = c.wave, r = lane & 15, q = lane >> 4;
    const int hm = brank & 3, rank4 = brank >> 2, n4 = (nblk - hm + 3) >> 2;
    {
        const unsigned char* kg = (const unsigned char*)((const bf16_t*)(ws + WS_KM) + layer * 512 + hm * 128);
        const unsigned char* vg = (const unsigned char*)((const bf16_t*)(ws + WS_VMT) + (size_t)(layer * 512 + hm * 128) * NMEM);
#pragma unroll
        for (int i = 0; i < 8; ++i) {
            const int pc = w * 8 + i;
            {   const int row = pc * 4 + (lane >> 4), slot = lane & 15, gs = slot ^ (row & 15);
                __builtin_amdgcn_global_load_lds((const unsigned*)(kg + (size_t)row * 4096 + gs * 16), (LAS unsigned*)(L + MA_K + pc * 1024), 16, 0, 0); }
            {   const int row = pc * 2 + (lane >> 5), slot = lane & 31, gs = slot ^ (row & 15);
                __builtin_amdgcn_global_load_lds((const unsigned*)(vg + (size_t)row * 512 + gs * 16), (LAS unsigned*)(L + MA_V + pc * 1024), 16, 0, 0); }
        }
        asm volatile("s_waitcnt vmcnt(0)" ::: "memory");
        __syncthreads();
    }
    const float sc = 0.08838834764831845f * 1.44269504088896f;
    const int tile0 = rank4 * 8 + w;
    bf16x8 qn[4];
    if (tile0 < M_TOK / 16) {
#pragma unroll
        for (int ks = 0; ks < 4; ++ks) qn[ks] = *(const bf16x8*)(P + (size_t)(tile0 * 16 + r) * LDP + qcol + hm * 128 + 32 * ks + 8 * q); }
#define MA_LDK(F, KT) do { _Pragma("unroll") for (int ks = 0; ks < 4; ++ks) F[ks] = *(const LAS bf16x8*)(kbase + ((64 * ks) ^ xm) + 4096 * (KT)); } while (0)
#define MA_QK(F, KT) do { f32x4 acc_ = {0.f, 0.f, 0.f, 0.f}; _Pragma("unroll") for (int ks = 0; ks < 4; ++ks) acc_ = MFMA16(F[ks], qf[ks], acc_); st[KT] = acc_; } while (0)
#define MA_LDV(F, KK) do { const LAS unsigned char* v0_ = vbase0 + ((64 * (KK)) ^ xm); const LAS unsigned char* v1_ = vbase1 + ((64 * (KK)) ^ xm); \
            _Pragma("unroll") for (int dt = 0; dt < 8; ++dt) { const s16x4 lo_ = *(const LAS s16x4*)(v0_ + 8192 * dt), hi_ = *(const LAS s16x4*)(v1_ + 8192 * dt); \
            F[dt] = __builtin_shufflevector(lo_, hi_, 0, 1, 2, 3, 4, 5, 6, 7); } } while (0)
#define MA_PV(F, KK) do { const bf16x8 pb_ = pack8(st[2 * (KK)][0], st[2 * (KK)][1], st[2 * (KK)][2], st[2 * (KK)][3], st[2 * (KK) + 1][0], st[2 * (KK) + 1][1], st[2 * (KK) + 1][2], st[2 * (KK) + 1][3]); \
            _Pragma("unroll") for (int dt = 0; dt < 8; ++dt) ot[dt] = MFMA16(F[dt], pb_, ot[dt]); } while (0)
#pragma unroll 1
    for (int tile = tile0; tile < M_TOK / 16; tile += n4 * 8) {
        const int t0 = tile * 16;
        int lane_ = lane; asm volatile("" : "+v"(lane_));
        const int r_ = lane_ & 15, q_ = lane_ >> 4, xm = 64 * (r_ >> 2);
        const LAS unsigned char* kbase = L + MA_K + r_ * 256 + ((q_ ^ (r_ & 3)) * 16);
        const LAS unsigned char* vbase0 = L + MA_V + r_ * 512 + (q_ & 1) * 8 + (((q_ >> 1) ^ (r_ & 3)) * 16);
        const LAS unsigned char* vbase1 = L + MA_V + r_ * 512 + (q_ & 1) * 8 + (((2 + (q_ >> 1)) ^ (r_ & 3)) * 16);
        bf16x8 qf[4];
#pragma unroll
        for (int ks = 0; ks < 4; ++ks) qf[ks] = qn[ks];
        if (tile + n4 * 8 < M_TOK / 16) {
#pragma unroll
            for (int ks = 0; ks < 4; ++ks) qn[ks] = *(const bf16x8*)(P + (size_t)((tile + n4 * 8) * 16 + r) * LDP + qcol + hm * 128 + 32 * ks + 8 * q); }
        f32x4 st[16];
        {   bf16x8 ka[4], kb[4];
            MA_LDK(ka, 0);
#pragma unroll
            for (int kt = 0; kt < 16; kt += 2) {
                MA_LDK(kb, kt + 1); asm volatile("" ::: "memory");
                MA_QK(ka, kt);
                if (kt + 2 < 16) MA_LDK(ka, kt + 2);
                asm volatile("" ::: "memory");
                MA_QK(kb, kt + 1);
            } }
        float mx = -3.0e38f;
#pragma unroll
        for (int kt = 0; kt < 16; ++kt)
#pragma unroll
            for (int e = 0; e < 4; ++e) mx = fmaxf(mx, st[kt][e]);
        { auto r_ = __builtin_amdgcn_permlane16_swap(__float_as_uint(mx), __float_as_uint(mx), false, false); mx = fmaxf(__uint_as_float(r_[0]), __uint_as_float(r_[1])); }
        { auto r_ = __builtin_amdgcn_permlane32_swap(__float_as_uint(mx), __float_as_uint(mx), false, false); mx = fmaxf(__uint_as_float(r_[0]), __uint_as_float(r_[1])); }
        float sum = 0.f;
#pragma unroll
        for (int kt = 0; kt < 16; ++kt)
#pragma unroll
            for (int e = 0; e < 4; ++e) { const float p = __builtin_amdgcn_exp2f((st[kt][e] - mx) * sc); st[kt][e] = p; sum += p; }
        sum = swap32_sum(swap16_sum(sum, sum), swap16_sum(sum, sum));
        const float inv = __builtin_amdgcn_rcpf(sum);
        f32x4 ot[8];
#pragma unroll
        for (int dt = 0; dt < 8; ++dt) ot[dt] = (f32x4){0.f, 0.f, 0.f, 0.f};
        {   bf16x8 va[8], vb[8];
            MA_LDV(va, 0);
#pragma unroll
            for (int kk = 0; kk < 8; kk += 2) {
                MA_LDV(vb, kk + 1); asm volatile("" ::: "memory");
                MA_PV(va, kk);
                if (kk + 2 < 8) MA_LDV(va, kk + 2);
                asm volatile("" ::: "memory");
                MA_PV(vb, kk + 1);
            } }
#pragma unroll
        for (int dt = 0; dt < 8; ++dt) {
            *(unsigned*)(MIX + (size_t)(t0 + r) * MIXW + 1024 + hm * 128 + 16 * dt + 4 * q) = pk4_f8(ot[dt][0] * inv, ot[dt][1] * inv, ot[dt][2] * inv, ot[dt][3] * inv, F8_ACT); }
    }
    __syncthreads();
}

DI bf16x8 packS(const f32x16& x, int s) { return pack8(x[8 * s], x[8 * s + 1], x[8 * s + 2], x[8 * s + 3], x[8 * s + 4], x[8 * s + 5], x[8 * s + 6], x[8 * s + 7]); }
DI void scan_dma(LAS unsigned char* buf, const unsigned char* rec, int w8, int lane, bool full) {
    asm volatile("" : "+s"(rec));
    const unsigned vA = (unsigned)((lane >> 4) * 256 + (((lane & 15) ^ (((w8 & 3) * 4 + (lane >> 4)) & 15)) * 16));
    const unsigned vB = (unsigned)((lane >> 3) * 128 + (((lane & 7) ^ (((lane >> 4) + 4 * (w8 & 1)) & 7)) * 16));
    const unsigned vC = (unsigned)(lane * 16);
#pragma unroll
    for (int i = 0; i < 9; ++i) {
        const int qq = w8 + 8 * i;
        if (!full && (i == 2 || i == 3 || i == 6)) continue;
        const unsigned char* gp = rec + qq * 1024;
        const unsigned vo = (i < 4) ? vA : (i < 7) ? vB : vC;
        __builtin_amdgcn_global_load_lds((const unsigned*)(gp + vo), (LAS unsigned*)(buf + qq * 1024), 16, 0, 0);
    }
}
template <int G_> DI void scan_ld(const LAS unsigned char* buf, int r, int hh, bf16x8 (&f)[4]) {
    asm volatile("" : "+v"(r), "+v"(hh));
    if constexpr (G_ < 4) {
#pragma unroll
        for (int rho = 0; rho < 2; ++rho)
#pragma unroll
            for (int s = 0; s < 2; ++s) { const int cr = 32 * rho + r, p = (4 * G_ + 2 * s + hh) ^ (cr & 15); f[rho * 2 + s] = *(const LAS bf16x8*)(buf + REC_W + cr * 256 + p * 16); } }
    else if constexpr (G_ < 10 && ((G_ - 4) % 3) < 2) { constexpr int rho = (G_ - 4) / 3, i0 = 2 * ((G_ - 4) % 3); const int cr = 32 * rho + r;
#pragma unroll
        for (int ii = 0; ii < 2; ++ii)
#pragma unroll
            for (int s = 0; s < 2; ++s) { const int p = (4 * (i0 + ii) + 2 * s + hh) ^ (cr & 15); f[ii * 2 + s] = *(const LAS bf16x8*)(buf + REC_QG + cr * 256 + p * 16); } }
    else { constexpr int row0 = (G_ < 10) ? 32 * ((G_ - 4) / 3) : 32 * (G_ - 10); constexpr int base = (G_ < 10) ? REC_AQK : REC_KDT; const int rr = row0 + r;
#pragma unroll
        for (int ts = 0; ts < 4; ++ts) { const int p = (2 * ts + hh) ^ ((rr >> 1) & 7); f[ts] = *(const LAS bf16x8*)(buf + base + rr * 128 + p * 16); } }
}
#define SCAN_END() asm volatile("" ::: "memory")
#define SCAN_VNEW(Y, uu, HAVE_U) do { _Pragma("unroll") for (int rho = 0; rho < 2; ++rho) { const u32x4 u0 = uu[rho][0], u1 = uu[rho][1]; \
        if (HAVE_U) { \
            Y[rho][0] = bf_lo(u0.x) - Y[rho][0]; Y[rho][1] = bf_hi(u0.x) - Y[rho][1]; Y[rho][2] = bf_lo(u0.y) - Y[rho][2]; Y[rho][3] = bf_hi(u0.y) - Y[rho][3]; \
            Y[rho][4] = bf_lo(u0.z) - Y[rho][4]; Y[rho][5] = bf_hi(u0.z) - Y[rho][5]; Y[rho][6] = bf_lo(u0.w) - Y[rho][6]; Y[rho][7] = bf_hi(u0.w) - Y[rho][7]; \
            Y[rho][8] = bf_lo(u1.x) - Y[rho][8]; Y[rho][9] = bf_hi(u1.x) - Y[rho][9]; Y[rho][10] = bf_lo(u1.y) - Y[rho][10]; Y[rho][11] = bf_hi(u1.y) - Y[rho][11]; \
            Y[rho][12] = bf_lo(u1.z) - Y[rho][12]; Y[rho][13] = bf_hi(u1.z) - Y[rho][13]; Y[rho][14] = bf_lo(u1.w) - Y[rho][14]; Y[rho][15] = bf_hi(u1.w) - Y[rho][15]; \
        } else { _Pragma("unroll") for (int e = 0; e < 16; ++e) Y[rho][e] = -Y[rho][e]; } \
        Vb[rho][0] = packS(Y[rho], 0); Vb[rho][1] = packS(Y[rho], 1); } } while (0)
#define SCAN_Y(g, gn) do { scan_ld<gn>(buf, r, hh, fr[((g) + 1) & 1]); const bf16x8 sb0 = packS(S[g], 0), sb1 = packS(S[g], 1); \
        Y[0] = MFMA32(fr[(g) & 1][0], sb0, Y[0]); Y[1] = MFMA32(fr[(g) & 1][2], sb0, Y[1]); Y[0] = MFMA32(fr[(g) & 1][1], sb1, Y[0]); Y[1] = MFMA32(fr[(g) & 1][3], sb1, Y[1]); SCAN_END(); } while (0)

constexpr int SCAN_G = 8, SCAN_NG = 256 / SCAN_G;
DI void scan_pass_a(const Ctx& c, int unit) {
    unsigned char* ws = c.a->ws;
    LAS unsigned char* L = c.lds;
    const int lane = c.lane, w = c.wave, r = lane & 31, hh = lane >> 5;
    const int head = unit / SCAN_NG, g = unit % SCAN_NG, n0 = g * SCAN_G;
    const unsigned char* recs = ws + WS_REC + (size_t)(head * 256 + n0) * REC_BYTES;
    const float* gam = (const float*)(ws + WS_GAM) + head * 256 + n0;
    const bool phi = w < 4; const int usl = w & 3;
    f32x16 S[4];
#pragma unroll
    for (int i = 0; i < 4; ++i)
#pragma unroll
        for (int e = 0; e < 16; ++e) S[i][e] = (phi && w == i && ((e & 3) + 8 * (e >> 2) + 4 * hh) == r) ? 1.f : 0.f;
    scan_dma(L, recs, w, lane, false);
    asm volatile("s_waitcnt vmcnt(0)" ::: "memory");
    __syncthreads();
#pragma unroll 1
    for (int n = 0; n < SCAN_G; ++n) {
        LAS unsigned char* buf = L + (n & 1) * REC_BYTES;
        if (n + 1 < SCAN_G) scan_dma(L + ((n + 1) & 1) * REC_BYTES, recs + (size_t)(n + 1) * REC_BYTES, w, lane, false);
        const float gamma = gam[n];
        bf16x8 fr[2][4];
        scan_ld<0>(buf, r, hh, fr[0]);
        bf16x8 Vb[2][2];
        {   f32x16 Y[2];
#pragma unroll
            for (int e = 0; e < 16; ++e) { Y[0][e] = 0.f; Y[1][e] = 0.f; }
            SCAN_Y(0, 1); SCAN_Y(1, 2); SCAN_Y(2, 3); SCAN_Y(3, 10);
            u32x4 uu[2][2];
#pragma unroll
            for (int rho = 0; rho < 2; ++rho) { const LAS u32x4* up = (const LAS u32x4*)(buf + REC_U + ((usl * 2 + rho) * 64 + lane) * 32); uu[rho][0] = up[0]; uu[rho][1] = up[1]; }
            if (phi) SCAN_VNEW(Y, uu, false); else SCAN_VNEW(Y, uu, true);
        }
#define SCAN_S(g, gn, i, HAS_NEXT) do { if (HAS_NEXT) scan_ld<gn>(buf, r, hh, fr[((g) + 1) & 1]); _Pragma("unroll") for (int e = 0; e < 16; ++e) S[i][e] *= gamma; \
            S[i] = MFMA32(fr[(g) & 1][0], Vb[0][0], S[i]); S[i] = MFMA32(fr[(g) & 1][1], Vb[0][1], S[i]); S[i] = MFMA32(fr[(g) & 1][2], Vb[1][0], S[i]); S[i] = MFMA32(fr[(g) & 1][3], Vb[1][1], S[i]); SCAN_END(); } while (0)
        SCAN_S(4, 11, 0, true); SCAN_S(5, 12, 1, true); SCAN_S(6, 13, 2, true); SCAN_S(7, 13, 3, false);
#undef SCAN_S
        asm volatile("s_waitcnt vmcnt(0)" ::: "memory");
        __syncthreads();
    }
    if (phi) {
        const int cin = 32 * w + r, pc = (cin & ~15) | swap23(cin & 15);
        bf16_t* ph = (bf16_t*)(ws + WS_PHI) + (size_t)unit * 128 * 128 + (4 * hh) * 128 + pc;
#pragma unroll
        for (int i = 0; i < 4; ++i) {
#pragma unroll
            for (int e = 0; e < 16; ++e) ph[((e & 3) + 8 * (e >> 2)) * 128] = f2bf(S[i][e]);
            ph += 32 * 128; asm volatile("" : "+v"(ph)); }
    } else {
        bf16_t* sl = (bf16_t*)(ws + WS_SLOC) + ((size_t)(unit * 4 + usl) * 4 * 64 + lane) * 16;
#pragma unroll
        for (int i = 0; i < 4; ++i) { u32x4* op = (u32x4*)(sl + (size_t)i * 64 * 16);
            u32x4 a, b; a.x = pk2(S[i][0], S[i][1]); a.y = pk2(S[i][2], S[i][3]); a.z = pk2(S[i][4], S[i][5]); a.w = pk2(S[i][6], S[i][7]);
            b.x = pk2(S[i][8], S[i][9]); b.y = pk2(S[i][10], S[i][11]); b.z = pk2(S[i][12], S[i][13]); b.w = pk2(S[i][14], S[i][15]);
            op[0] = a; op[1] = b; }
    }
}

constexpr int PB_XCH = 98304;
DI void scan_pass_b(const Ctx& c, int head) {
    unsigned char* ws = c.a->ws;
    LAS unsigned char* L = c.lds;
    const int lane = c.lane, w = c.wave, r = lane & 31, hh = lane >> 5, j = w & 3, rh = w >> 2;
    const unsigned char* phis = ws + WS_PHI + (size_t)head * SCAN_NG * 32768;
    const unsigned vA = (unsigned)((lane >> 4) * 256 + (((lane & 15) ^ (((w & 3) * 4 + (lane >> 4)) & 15)) * 16));
#define PB_DMA(gg) do { const unsigned char* pp_ = phis + (size_t)(gg) * 32768; asm volatile("" : "+s"(pp_)); LAS unsigned char* sl_ = L + ((gg) % 3) * 32768; \
        _Pragma("unroll") for (int i = 0; i < 4; ++i) { const int qq = w + 8 * i; __builtin_amdgcn_global_load_lds((const unsigned*)(pp_ + qq * 1024 + vA), (LAS unsigned*)(sl_ + qq * 1024), 16, 0, 0); } } while (0)
    constexpr size_t GSTR = (size_t)4 * 4 * 64 * 16;
    const size_t tb = ((size_t)((head * SCAN_NG) * 4 + j) * 4 + 2 * rh) * 64 * 16 + (size_t)lane * 16;
    const bf16_t* slb = (const bf16_t*)(ws + WS_SLOC) + tb;
    bf16_t* sib = (bf16_t*)(ws + WS_SIN) + tb;
    LAS bf16x8* xch = (LAS bf16x8*)(L + PB_XCH);
    u32x4 N[2][2];
#pragma unroll
    for (int t = 0; t < 2; ++t) { const u32x4* ip = (const u32x4*)(slb + (size_t)t * 1024); N[t][0] = ip[0]; N[t][1] = ip[1]; }
    {   bf16x8 z;
#pragma unroll
        for (int e = 0; e < 8; ++e) z[e] = 0;
#pragma unroll
        for (int t = 0; t < 2; ++t) { xch[((j * 4 + 2 * rh + t) * 2 + 0) * 64 + lane] = z; xch[((j * 4 + 2 * rh + t) * 2 + 1) * 64 + lane] = z;
            bf16x8* op = (bf16x8*)(sib + (size_t)t * 1024); op[0] = z; op[1] = z; } }
    asm volatile("" ::: "memory");
    PB_DMA(0); PB_DMA(1);
#pragma unroll 1
    for (int g = 0; g < SCAN_NG; ++g) {
        asm volatile("s_waitcnt vmcnt(4)" ::: "memory");
        __syncthreads();
        bf16x8 Sb[4][2];
#pragma unroll
        for (int i = 0; i < 4; ++i) { Sb[i][0] = xch[((j * 4 + i) * 2 + 0) * 64 + lane]; Sb[i][1] = xch[((j * 4 + i) * 2 + 1) * 64 + lane]; }
        asm volatile("s_waitcnt lgkmcnt(0)" ::: "memory");
        __syncthreads();
        const LAS unsigned char* slot = L + (g % 3) * 32768;
        f32x16 A2[2];
#pragma unroll
        for (int t = 0; t < 2; ++t) {
            const u32x4 n0 = N[t][0], n1 = N[t][1];
            A2[t][0] = bf_lo(n0.x); A2[t][1] = bf_hi(n0.x); A2[t][2] = bf_lo(n0.y); A2[t][3] = bf_hi(n0.y); A2[t][4] = bf_lo(n0.z); A2[t][5] = bf_hi(n0.z); A2[t][6] = bf_lo(n0.w); A2[t][7] = bf_hi(n0.w);
            A2[t][8] = bf_lo(n1.x); A2[t][9] = bf_hi(n1.x); A2[t][10] = bf_lo(n1.y); A2[t][11] = bf_hi(n1.y); A2[t][12] = bf_lo(n1.z); A2[t][13] = bf_hi(n1.z); A2[t][14] = bf_lo(n1.w); A2[t][15] = bf_hi(n1.w);
            const u32x4* ip = (const u32x4*)(slb + (size_t)(g + 1) * GSTR + (size_t)t * 1024); N[t][0] = ip[0]; N[t][1] = ip[1]; }
#pragma unroll
        for (int t = 0; t < 2; ++t) {
            const int row = 32 * (2 * rh + t) + r;
#pragma unroll
            for (int half = 0; half < 2; ++half) {
                bf16x8 fr[4]; int row_ = row, hh_ = hh; asm volatile("" : "+v"(row_), "+v"(hh_));
#pragma unroll
                for (int q4 = 0; q4 < 4; ++q4) { const int p = (4 * (2 * half + (q4 >> 1)) + 2 * (q4 & 1) + hh_) ^ (row_ & 15); fr[q4] = *(const LAS bf16x8*)(slot + row_ * 256 + p * 16); }
                A2[t] = MFMA32(fr[0], Sb[2 * half][0], A2[t]); A2[t] = MFMA32(fr[1], Sb[2 * half][1], A2[t]); A2[t] = MFMA32(fr[2], Sb[2 * half + 1][0], A2[t]); A2[t] = MFMA32(fr[3], Sb[2 * half + 1][1], A2[t]);
            }
            const bf16x8 p0 = packS(A2[t], 0), p1 = packS(A2[t], 1);
            xch[((j * 4 + 2 * rh + t) * 2 + 0) * 64 + lane] = p0; xch[((j * 4 + 2 * rh + t) * 2 + 1) * 64 + lane] = p1;
            if (g + 1 < SCAN_NG) { bf16x8* op = (bf16x8*)(sib + (size_t)(g + 1) * GSTR + (size_t)t * 1024); op[0] = p0; op[1] = p1; }
        }
        asm volatile("" ::: "memory");
        if (g + 2 < SCAN_NG) PB_DMA(g + 2);
    }
#undef PB_DMA
    asm volatile("s_waitcnt vmcnt(0)" ::: "memory");
    __syncthreads();
}

DI void scan_pass_c(const Ctx& c, int unit) {
    unsigned char* ws = c.a->ws;
    LAS unsigned char* L = c.lds;
    const int lane = c.lane, w = c.wave, r = lane & 31, hh = lane >> 5;
    const int head = unit / SCAN_NG, g = unit % SCAN_NG, n0 = g * SCAN_G;
    const unsigned char* recs = ws + WS_REC + (size_t)(head * 256 + n0) * REC_BYTES;
    const float* gam = (const float*)(ws + WS_GAM) + head * 256 + n0;
    bf16_t* OB = (bf16_t*)(ws + WS_OG);
    f32x16 S[4];
    if (w < 4) {
        const bf16_t* sib = (const bf16_t*)(ws + WS_SIN) + ((size_t)(unit * 4 + w) * 4 * 64 + lane) * 16;
#pragma unroll
        for (int i = 0; i < 4; ++i) { const u32x4* ip = (const u32x4*)(sib + (size_t)i * 1024); const u32x4 n0 = ip[0], n1 = ip[1];
            S[i][0] = bf_lo(n0.x); S[i][1] = bf_hi(n0.x); S[i][2] = bf_lo(n0.y); S[i][3] = bf_hi(n0.y); S[i][4] = bf_lo(n0.z); S[i][5] = bf_hi(n0.z); S[i][6] = bf_lo(n0.w); S[i][7] = bf_hi(n0.w);
            S[i][8] = bf_lo(n1.x); S[i][9] = bf_hi(n1.x); S[i][10] = bf_lo(n1.y); S[i][11] = bf_hi(n1.y); S[i][12] = bf_lo(n1.z); S[i][13] = bf_hi(n1.z); S[i][14] = bf_lo(n1.w); S[i][15] = bf_hi(n1.w); }
    }
    scan_dma(L, recs, w, lane, true);
    asm volatile("s_waitcnt vmcnt(0)" ::: "memory");
    __syncthreads();
#pragma unroll 1
    for (int n = 0; n < SCAN_G; ++n) {
        LAS unsigned char* buf = L + (n & 1) * REC_BYTES;
        if (n + 1 < SCAN_G) scan_dma(L + ((n + 1) & 1) * REC_BYTES, recs + (size_t)(n + 1) * REC_BYTES, w, lane, true);
        if (w < 4) {
            const float gamma = gam[n];
            u32x4 uu[2][2];
#pragma unroll
            for (int rho = 0; rho < 2; ++rho) { const LAS u32x4* up = (const LAS u32x4*)(buf + REC_U + ((w * 2 + rho) * 64 + lane) * 32); uu[rho][0] = up[0]; uu[rho][1] = up[1]; }
            bf16x8 fr[2][4];
            scan_ld<0>(buf, r, hh, fr[0]);
#define SCAN_NEXT(g) do { if ((g) + 1 < 14) scan_ld<(g) + 1>(buf, r, hh, fr[((g) + 1) & 1]); } while (0)
            bf16x8 Vb[2][2];
            {   f32x16 Y[2];
#pragma unroll
                for (int e = 0; e < 16; ++e) { Y[0][e] = 0.f; Y[1][e] = 0.f; }
                SCAN_Y(0, 1); SCAN_Y(1, 2); SCAN_Y(2, 3); SCAN_Y(3, 4);
                SCAN_VNEW(Y, uu, true);
            }
#define SCAN_Z(g0, rho) do { f32x16 Z; _Pragma("unroll") for (int e = 0; e < 16; ++e) Z[e] = 0.f; \
                SCAN_NEXT(g0); { const bf16x8 a0 = packS(S[0], 0), a1 = packS(S[0], 1), a2 = packS(S[1], 0), a3 = packS(S[1], 1); \
                    Z = MFMA32(fr[(g0) & 1][0], a0, Z); Z = MFMA32(fr[(g0) & 1][1], a1, Z); Z = MFMA32(fr[(g0) & 1][2], a2, Z); Z = MFMA32(fr[(g0) & 1][3], a3, Z); } SCAN_END(); \
                SCAN_NEXT((g0) + 1); { const bf16x8 a0 = packS(S[2], 0), a1 = packS(S[2], 1), a2 = packS(S[3], 0), a3 = packS(S[3], 1); \
                    Z = MFMA32(fr[((g0) + 1) & 1][0], a0, Z); Z = MFMA32(fr[((g0) + 1) & 1][1], a1, Z); Z = MFMA32(fr[((g0) + 1) & 1][2], a2, Z); Z = MFMA32(fr[((g0) + 1) & 1][3], a3, Z); } SCAN_END(); \
                SCAN_NEXT((g0) + 2); Z = MFMA32(fr[((g0) + 2) & 1][0], Vb[0][0], Z); Z = MFMA32(fr[((g0) + 2) & 1][1], Vb[0][1], Z); Z = MFMA32(fr[((g0) + 2) & 1][2], Vb[1][0], Z); Z = MFMA32(fr[((g0) + 2) & 1][3], Vb[1][1], Z); \
                { bf16_t* op = OB + (size_t)((n0 + n) * 64 + 32 * (rho) + 4 * hh) * 1024 + head * 128 + 32 * w + r; \
                  _Pragma("unroll") for (int e = 0; e < 16; ++e) op[((e & 3) + 8 * (e >> 2)) * 1024] = f2bf(Z[e]); } SCAN_END(); } while (0)
            SCAN_Z(4, 0); SCAN_Z(7, 1);
#undef SCAN_Z
#define SCAN_S(g, i) do { SCAN_NEXT(g); _Pragma("unroll") for (int e = 0; e < 16; ++e) S[i][e] *= gamma; \
                S[i] = MFMA32(fr[(g) & 1][0], Vb[0][0], S[i]); S[i] = MFMA32(fr[(g) & 1][1], Vb[0][1], S[i]); S[i] = MFMA32(fr[(g) & 1][2], Vb[1][0], S[i]); S[i] = MFMA32(fr[(g) & 1][3], Vb[1][1], S[i]); SCAN_END(); } while (0)
            SCAN_S(10, 0); SCAN_S(11, 1); SCAN_S(12, 2); SCAN_S(13, 3);
#undef SCAN_S
#undef SCAN_NEXT
        }
        asm volatile("s_waitcnt vmcnt(0)" ::: "memory");
        __syncthreads();
    }
}
#undef SCAN_Y
#undef SCAN_VNEW
#undef SCAN_END
DI void phase_gdn_out(const Ctx& c, int li) {
    unsigned char* ws = c.a->ws;
    const bf16_t* OB = (const bf16_t*)(ws + WS_OG); const bf16_t* P = (const bf16_t*)(ws + WS_P); unsigned char* MIX = ws + WS_MIX;
    const float* gn = c.a->gdn_onorm + li * 128;
    const int cg = c.tid & 15;
    const f32x4 g0 = *(const f32x4*)(gn + cg * 8), g1 = *(const f32x4*)(gn + cg * 8 + 4);
    for (int it0 = c.bid * 32 + (c.tid >> 4); it0 < M_TOK * 8; it0 += c.G * 32 * 4) {
        u32x4 ov4[4], zv4[4];
#pragma unroll
        for (int u = 0; u < 4; ++u) { const int it = it0 + u * c.G * 32; if (it < M_TOK * 8) { const int t = it >> 3, h = it & 7;
            ov4[u] = *(const u32x4*)(OB + (size_t)t * 1024 + h * 128 + cg * 8); zv4[u] = *(const u32x4*)(P + (size_t)t * LDP + GC_Z + h * 128 + cg * 8); } }
        asm volatile("" ::: "memory");
#pragma unroll
        for (int u = 0; u < 4; ++u) { const int it = it0 + u * c.G * 32; if (it < M_TOK * 8) { const int t = it >> 3, h = it & 7;
            const u32x4 ov = ov4[u], zv = zv4[u];
            const float o[8] = {bf_lo(ov.x), bf_hi(ov.x), bf_lo(ov.y), bf_hi(ov.y), bf_lo(ov.z), bf_hi(ov.z), bf_lo(ov.w), bf_hi(ov.w)};
            float ss = 0.f;
#pragma unroll
            for (int e = 0; e < 8; ++e) ss += o[e] * o[e];
            ss = row_sum16(ss);
            const float rr = __builtin_amdgcn_rsqf(ss * (1.0f / 128.0f) + RMS_EPS);
            u32x2 wv;
            wv.x = pk4_f8(o[0] * rr * g0[0] * siluf_(bf_lo(zv.x)), o[1] * rr * g0[1] * siluf_(bf_hi(zv.x)), o[2] * rr * g0[2] * siluf_(bf_lo(zv.y)), o[3] * rr * g0[3] * siluf_(bf_hi(zv.y)), F8_ACT);
            wv.y = pk4_f8(o[4] * rr * g1[0] * siluf_(bf_lo(zv.z)), o[5] * rr * g1[1] * siluf_(bf_hi(zv.z)), o[6] * rr * g1[2] * siluf_(bf_lo(zv.w)), o[7] * rr * g1[3] * siluf_(bf_hi(zv.w)), F8_ACT);
            *(u32x2*)(MIX + (size_t)t * MIXW + h * 128 + cg * 8) = wv; } }
    }
}

DI void ln_row(const float (&v)[32], const float* g, const float* b, float* dstf, bf16_t* dstb, int lane) {
    float s = 0.f;
#pragma unroll
    for (int i = 0; i < 32; ++i) s += v[i];
    const float mu = wave_sum(s) * (1.0f / 2048.0f);
    float qv = 0.f;
#pragma unroll
    for (int i = 0; i < 32; ++i) { const float d = v[i] - mu; qv += d * d; }
    const float rstd = __builtin_amdgcn_rsqf(wave_sum(qv) * (1.0f / 2048.0f) + LN_EPS);
#pragma unroll
    for (int i = 0; i < 4; ++i) {
        const int e0 = 512 * i + 8 * lane;
        const f32x4 ga = *(const f32x4*)(g + e0), gb = *(const f32x4*)(g + e0 + 4), ba = *(const f32x4*)(b + e0), bb = *(const f32x4*)(b + e0 + 4);
        f32x4 ya, yb;
#pragma unroll
        for (int j = 0; j < 4; ++j) { ya[j] = (v[8 * i + j] - mu) * rstd * ga[j] + ba[j]; yb[j] = (v[8 * i + 4 + j] - mu) * rstd * gb[j] + bb[j]; }
        *(f32x4*)(dstf + e0) = ya; *(f32x4*)(dstf + e0 + 4) = yb;
        if (dstb) { u32x4 wv; wv.x = pk2(ya[0], ya[1]); wv.y = pk2(ya[2], ya[3]); wv.z = pk2(yb[0], yb[1]); wv.w = pk2(yb[2], yb[3]); *(u32x4*)(dstb + e0) = wv; }
    }
}
template <class GP> DI void ln_row16(const float (&v)[32], GP g, GP b, float* dstf, bf16_t* dstb, unsigned char* dst8, int lane) {
    float s = 0.f;
#pragma unroll
    for (int i = 0; i < 32; ++i) s += v[i];
    const float mu = wave_sum(s) * (1.0f / 2048.0f);
    float qv = 0.f;
#pragma unroll
    for (int i = 0; i < 32; ++i) { const float d = v[i] - mu; qv += d * d; }
    const float rstd = __builtin_amdgcn_rsqf(wave_sum(qv) * (1.0f / 2048.0f) + LN_EPS);
#pragma unroll
    for (int j = 0; j < 8; ++j) {
        const int e0 = 256 * j + 4 * lane;
        const f32x4 ga = *(const f32x4 __attribute__((address_space(3)))*)(g + e0), ba = *(const f32x4 __attribute__((address_space(3)))*)(b + e0);
        f32x4 ya;
#pragma unroll
        for (int e = 0; e < 4; ++e) ya[e] = (v[4 * j + e] - mu) * rstd * ga[e] + ba[e];
        if (dstf) *(f32x4*)(dstf + e0) = ya;
        u32x2 wv; wv.x = pk2(ya[0], ya[1]); wv.y = pk2(ya[2], ya[3]); *(u32x2*)(dstb + e0) = wv;
        *(unsigned*)(dst8 + e0) = pk4_f8(ya[0], ya[1], ya[2], ya[3], F8_ACT);
    }
}
DI void phase_ln(const Ctx& c, const bf16_t* src, const float* g, const float* b, float* stats, bf16_t* dstb) {
    LAS float* pg = (LAS float*)c.lds; LAS float* pb = pg + DM;
    for (int e = c.tid * 4; e < DM; e += NTHREADS * 4) { *(LAS f32x4*)(pg + e) = *(const f32x4*)(g + e); *(LAS f32x4*)(pb + e) = *(const f32x4*)(b + e); }
    __syncthreads();
    for (int row = c.bid * 8 + c.wave; row < M_TOK; row += c.G * 8) {
        float v[32];
        const bf16_t* sp = src + (size_t)row * DM;
#pragma unroll
        for (int i = 0; i < 4; ++i) { const u32x4 a = *(const u32x4*)(sp + 512 * i + 8 * c.lane);
            v[8 * i] = bf_lo(a.x); v[8 * i + 1] = bf_hi(a.x); v[8 * i + 2] = bf_lo(a.y); v[8 * i + 3] = bf_hi(a.y); v[8 * i + 4] = bf_lo(a.z); v[8 * i + 5] = bf_hi(a.z); v[8 * i + 6] = bf_lo(a.w); v[8 * i + 7] = bf_hi(a.w); }
        float s = 0.f;
#pragma unroll
        for (int i = 0; i < 32; ++i) s += v[i];
        const float mu = wave_sum(s) * (1.0f / 2048.0f);
        float qv = 0.f;
#pragma unroll
        for (int i = 0; i < 32; ++i) { const float d = v[i] - mu; qv += d * d; }
        const float rstd = __builtin_amdgcn_rsqf(wave_sum(qv) * (1.0f / 2048.0f) + LN_EPS);
        if (c.lane == 0) { f32x2 st = {mu, rstd}; *(f32x2*)(stats + 2 * (size_t)row) = st; }
        bf16_t* db = dstb + (size_t)row * DM;
#pragma unroll
        for (int i = 0; i < 4; ++i) {
            const int e0 = 512 * i + 8 * c.lane;
            const f32x4 ga = *(const LAS f32x4*)(pg + e0), gb = *(const LAS f32x4*)(pg + e0 + 4), ba = *(const LAS f32x4*)(pb + e0), bb = *(const LAS f32x4*)(pb + e0 + 4);
            float y[8];
#pragma unroll
            for (int j = 0; j < 4; ++j) { y[j] = (v[8 * i + j] - mu) * rstd * ga[j] + ba[j]; y[4 + j] = (v[8 * i + 4 + j] - mu) * rstd * gb[j] + bb[j]; }
            u32x4 wv; wv.x = pk2(y[0], y[1]); wv.y = pk2(y[2], y[3]); wv.z = pk2(y[4], y[5]); wv.w = pk2(y[6], y[7]); *(u32x4*)(db + e0) = wv;
        }
    }
}

constexpr int SBA_K = 0, SBA_V = 65536;
DI void sb_attn_block(const Ctx& c, int task) {
    unsigned char* ws = c.a->ws;
    LAS unsigned char* L = c.lds;
    const bf16_t* P = (const bf16_t*)(ws + WS_P); const bf16_t* VT = (const bf16_t*)(ws + WS_VT); unsigned char* MIX = ws + WS_MIX;
    const int lane = c.lane, w = c.wave, r = lane & 15, q = lane >> 4;
    const int h = task & 7, q0 = (task >> 3) * 128, win_lo = q0 >= 128 ? q0 - 128 : 0;
    {
        const unsigned char* kg = (const unsigned char*)(P + (size_t)win_lo * LDP + SC_K + h * 128);
        const unsigned char* vg = (const unsigned char*)(VT + (size_t)(h * 128) * M_TOK + win_lo);
#pragma unroll
        for (int i = 0; i < 8; ++i) {
            const int pc = w * 8 + i;
            {   const int row = pc * 4 + (lane >> 4), slot = lane & 15, gs = slot ^ (row & 15);
                __builtin_amdgcn_global_load_lds((const unsigned*)(kg + (size_t)row * (LDP * 2) + gs * 16), (LAS unsigned*)(L + SBA_K + pc * 1024), 16, 0, 0); }
            {   const int row = pc * 2 + (lane >> 5), slot = lane & 31, gs = slot ^ (row & 15);
                __builtin_amdgcn_global_load_lds((const unsigned*)(vg + (size_t)row * (M_TOK * 2) + gs * 16), (LAS unsigned*)(L + SBA_V + pc * 1024), 16, 0, 0); }
        }
        asm volatile("s_waitcnt vmcnt(0)" ::: "memory");
        __syncthreads();
    }
    const int t0 = q0 + 16 * w, tq = t0 + r;
    bf16x8 qf[4];
#pragma unroll
    for (int ks = 0; ks < 4; ++ks) qf[ks] = *(const bf16x8*)(P + (size_t)tq * LDP + SC_Q + h * 128 + 32 * ks + 8 * q);
    f32x4 ot[8];
#pragma unroll
    for (int dt = 0; dt < 8; ++dt) ot[dt] = (f32x4){0.f, 0.f, 0.f, 0.f};
    float R = 0.f;
    const float sc = 0.08838834764831845f * 1.44269504088896f;
#pragma unroll 1
    for (int kb = (t0 + 15) >> 5; kb >= 0; --kb) {
        const int k0 = kb * 32;
        bf16x8 kf[2][4], vf[8];
        if (k0 >= win_lo) {
            const int kr = k0 - win_lo;
#pragma unroll
            for (int tl = 0; tl < 2; ++tl) { const int row = kr + 16 * tl + r;
#pragma unroll
                for (int ks = 0; ks < 4; ++ks) kf[tl][ks] = *(const LAS bf16x8*)(L + SBA_K + row * 256 + (((4 * ks + q) ^ (row & 15)) * 16)); }
#pragma unroll
            for (int dt = 0; dt < 8; ++dt) { const int row = 16 * dt + r; const int g = (kr >> 3) + (q >> 1);
                const LAS unsigned char* vp = L + SBA_V + row * 512 + (q & 1) * 8;
                const s16x4 lo = *(const LAS s16x4*)(vp + ((g ^ (row & 15)) * 16)), hi = *(const LAS s16x4*)(vp + (((g + 2) ^ (row & 15)) * 16));
                vf[dt] = __builtin_shufflevector(lo, hi, 0, 1, 2, 3, 4, 5, 6, 7); }
        } else {
#pragma unroll
            for (int tl = 0; tl < 2; ++tl)
#pragma unroll
                for (int ks = 0; ks < 4; ++ks) kf[tl][ks] = *(const bf16x8*)(P + (size_t)(k0 + 16 * tl + r) * LDP + SC_K + h * 128 + 32 * ks + 8 * q);
#pragma unroll
            for (int dt = 0; dt < 8; ++dt) { const bf16_t* vp = VT + (size_t)(h * 128 + 16 * dt + r) * M_TOK + k0 + 4 * q;
                const s16x4 lo = *(const s16x4*)vp, hi = *(const s16x4*)(vp + 16);
                vf[dt] = __builtin_shufflevector(lo, hi, 0, 1, 2, 3, 4, 5, 6, 7); }
        }
        f32x4 z[2];
#pragma unroll
        for (int tl = 0; tl < 2; ++tl) {
            f32x4 acc = {0.f, 0.f, 0.f, 0.f};
#pragma unroll
            for (int ks = 0; ks < 4; ++ks) acc = MFMA16(kf[tl][ks], qf[ks], acc);
            z[tl] = acc;
        }
        float ln[2][4], zz[2][4]; bool vis[2][4];
#pragma unroll
        for (int tl = 0; tl < 2; ++tl)
#pragma unroll
            for (int e = 0; e < 4; ++e) {
                const int key = k0 + 16 * tl + 4 * q + e;
                vis[tl][e] = key < tq;
                const float x = z[tl][e] * sc;
                const float l = fminf(-x, 0.f) - __builtin_amdgcn_logf(1.0f + __builtin_amdgcn_exp2f(-fabsf(x)));
                zz[tl][e] = x; ln[tl][e] = vis[tl][e] ? l : 0.f;
            }
        float g1 = ln[1][0] + ln[1][1] + ln[1][2] + ln[1][3], g0 = ln[0][0] + ln[0][1] + ln[0][2] + ln[0][3];
        const float b1 = __shfl_xor(g1, 16), c1 = __shfl_xor(g1, 32), d1 = __shfl_xor(b1, 32);
        const float b0 = __shfl_xor(g0, 16), c0 = __shfl_xor(g0, 32), d0 = __shfl_xor(b0, 32);
        const float tot1 = g1 + b1 + c1 + d1, tot0 = g0 + b0 + c0 + d0;
        const float e1 = (q == 3) ? 0.f : (q == 2) ? b1 : (q == 1) ? (c1 + d1) : (b1 + c1 + d1);
        const float e0 = ((q == 3) ? 0.f : (q == 2) ? b0 : (q == 1) ? (c0 + d0) : (b0 + c0 + d0)) + tot1;
        float p[2][4];
        {   float run = R + e1;
#pragma unroll
            for (int e = 3; e >= 0; --e) { p[1][e] = vis[1][e] ? __builtin_amdgcn_exp2f(ln[1][e] + zz[1][e] + run) : 0.f; run += ln[1][e]; }
            run = R + e0;
#pragma unroll
            for (int e = 3; e >= 0; --e) { p[0][e] = vis[0][e] ? __builtin_amdgcn_exp2f(ln[0][e] + zz[0][e] + run) : 0.f; run += ln[0][e]; }
        }
        R += tot0 + tot1;
        const bf16x8 pb = pack8(p[0][0], p[0][1], p[0][2], p[0][3], p[1][0], p[1][1], p[1][2], p[1][3]);
#pragma unroll
        for (int dt = 0; dt < 8; ++dt) ot[dt] = MFMA16(vf[dt], pb, ot[dt]);
        if (__all(R < -40.0f)) break;
    }
#pragma unroll
    for (int dt = 0; dt < 8; ++dt)
        *(unsigned*)(MIX + (size_t)tq * MIXW + h * 128 + 16 * dt + 4 * q) = pk4_f8(ot[dt][0], ot[dt][1], ot[dt][2], ot[dt][3], F8_ACT);
    __syncthreads();
}
DI void phase_sb_attn(const Ctx& c, int layer) {
    for (int task = c.bid; task < (M_TOK / 128) * 8; task += c.G) sb_attn_block(c, task);
#ifndef REP_MEMATT
#define REP_MEMATT 1
#endif
#pragma unroll 1
    for (int rm_ = 0; rm_ < REP_MEMATT; ++rm_) mem_attn_all(c, layer, SC_QM, c.bid, c.G);
}
template <int N> DI void topk_insert(float (&L)[N], float x) {
#pragma unroll
    for (int i = 0; i < N; ++i) { const float hi = fmaxf(L[i], x); x = fminf(L[i], x); L[i] = hi; }
}
DI float key_of(float v, int idx) { return __uint_as_float((__float_as_uint(v) & ~127u) | (unsigned)(127 - idx)); }
DI int idx_of(float k) { return 127 - (int)(__float_as_uint(k) & 127u); }
DI float val_of(float k) { return __uint_as_float(__float_as_uint(k) & ~127u); }
DI float gelu_erf(float x) {
    const float ax = fabsf(x) * 0.70710678118654752f;
    const float t = __builtin_amdgcn_rcpf(1.0f + 0.3275911f * ax);
    const float poly = ((((1.061405429f * t - 1.453152027f) * t + 1.421413741f) * t - 0.284496736f) * t + 0.254829592f) * t;
    const float er = 1.0f - poly * __expf(-ax * ax);
    return 0.5f * x * (1.0f + (x < 0.f ? -er : er));
}
template <int BITS> struct RowBits;
template <> struct RowBits<6> { u32x2 a, b, cc;
    DI void load(const unsigned char* tab, int ex, int lane) { const u32x2* rp = (const u32x2*)(tab + (size_t)ex * 1536 + 24 * lane); a = rp[0]; b = rp[1]; cc = rp[2]; }
    DI void decode(float (&d)[32]) const { const u32x6 pk = {a.x, a.y, b.x, b.y, cc.x, cc.y}; const f32x32 t = __builtin_amdgcn_cvt_scalef32_pk32_f32_fp6(pk, 1.0f);
        _Pragma("unroll") for (int i = 0; i < 32; ++i) d[i] = t[i]; } };
template <> struct RowBits<4> { u32x4 a;
    DI void load(const unsigned char* tab, int ex, int lane) { a = *(const u32x4*)(tab + (size_t)ex * 1024 + 16 * lane); }
    DI void decode(float (&d)[32]) const { fp4_unpack32(a, d); } };
constexpr int PK_EID = 0, PK_GATE = 8192;
DI void phase_peer(const Ctx& c, int layer, const float* g1, const float* b1, const float* lg, const float* lb, float* dstf) {
    unsigned char* ws = c.a->ws;
    const float* SC = (const float*)(ws + WS_SC);
    const bf16_t* T1 = (const bf16_t*)(ws + WS_F1);
    const unsigned char* UT = ws + WS_UT + (size_t)layer * 16384 * UROW;
    const unsigned char* VTB = ws + WS_VTAB + (size_t)layer * 16384 * VROW;
    const float* USC = (const float*)(ws + WS_USC) + layer * 16384; const float* VSC = (const float*)(ws + WS_VSC) + layer * 16384;
    bf16_t* XB = (bf16_t*)(ws + WS_XB);
    LAS int* eid = (LAS int*)(c.lds + PK_EID); LAS float* gat = (LAS float*)(c.lds + PK_GATE);
    const int lane = c.lane, w = c.wave;
    LAS float* pg1 = (LAS float*)(c.lds + 16384); LAS float* pb1 = pg1 + DM; LAS float* pg2 = pb1 + DM; LAS float* pb2 = pg2 + DM;
    LAS float* pc1 = pb2 + DM; LAS float* pc2 = pc1 + 1024; LAS float* stl = pc2 + 1024;
    const float* c12 = (const float*)(ws + WS_C12) + (size_t)layer * 2 * 1024;
    for (int e = c.tid * 4; e < 2048; e += NTHREADS * 4) *(LAS f32x4*)(pc1 + e) = *(const f32x4*)(c12 + e);
    for (int e = c.tid * 4; e < DM; e += NTHREADS * 4) { *(LAS f32x4*)(pg1 + e) = *(const f32x4*)(g1 + e); *(LAS f32x4*)(pb1 + e) = *(const f32x4*)(b1 + e); *(LAS f32x4*)(pg2 + e) = *(const f32x4*)(lg + e); *(LAS f32x4*)(pb2 + e) = *(const f32x4*)(lb + e); }
    __syncthreads();
    for (int tb = c.bid; tb < M_TOK / 64; tb += c.G) {
        const int tok0 = tb * 64;
#pragma unroll 1
        for (int t4 = 0; t4 < 8; t4 += 4) {
            u32x2 raw[4][8];
#pragma unroll
            for (int q = 0; q < 4; ++q) { const bf16_t* xp = T1 + (size_t)(tok0 + w * 8 + t4 + q) * DM + 4 * lane;
#pragma unroll
                for (int j = 0; j < 8; ++j) raw[q][j] = *(const u32x2*)(xp + 256 * j); }
            asm volatile("" ::: "memory");
#pragma unroll
            for (int q = 0; q < 4; ++q) {
                float tv[32];
#pragma unroll
                for (int j = 0; j < 8; ++j) { const u32x2 ta = raw[q][j]; tv[4 * j] = bf_lo(ta.x); tv[4 * j + 1] = bf_hi(ta.x); tv[4 * j + 2] = bf_lo(ta.y); tv[4 * j + 3] = bf_hi(ta.y); }
                float s = 0.f;
#pragma unroll
                for (int i = 0; i < 32; ++i) s += tv[i];
                const float mu = wave_sum(s) * (1.0f / 2048.0f);
                float qv = 0.f;
#pragma unroll
                for (int i = 0; i < 32; ++i) { const float d = tv[i] - mu; qv += d * d; }
                const float rstd = __builtin_amdgcn_rsqf(wave_sum(qv) * (1.0f / 2048.0f) + LN_EPS);
                if (lane == 0) { stl[2 * (w * 8 + t4 + q)] = mu; stl[2 * (w * 8 + t4 + q) + 1] = rstd; }
            }
        }
        __syncthreads();
#ifndef REP_TOPK
#define REP_TOPK 1
#endif
#pragma unroll 1
        for (int rtk_ = 0; rtk_ < REP_TOPK; ++rtk_)
        {
            const int pr = w * 32 + (lane & 31), tl = pr >> 2, hd = pr & 3, hf = lane >> 5;
            const float* sp = SC + (size_t)(tok0 + tl) * 1024 + hd * 256 + hf * 128;
            LAS float* q1 = pc1 + hd * 256 + hf * 128; LAS float* q2 = pc2 + hd * 256 + hf * 128;
            const float tmu = stl[2 * tl], trs = stl[2 * tl + 1];
            float L[8];
#pragma unroll
            for (int i = 0; i < 8; ++i) L[i] = -3.0e38f;
#pragma unroll 1
            for (int i0 = 0; i0 < 128; i0 += 32) {
                f32x4 a8[8];
#pragma unroll
                for (int q = 0; q < 8; ++q) a8[q] = *(const f32x4*)(sp + i0 + 4 * q);
                asm volatile("" ::: "memory");
#pragma unroll
                for (int q = 0; q < 8; ++q) {
                    const int i = i0 + 4 * q;
                    const f32x4 ca = *(const LAS f32x4*)(q1 + i), da = *(const LAS f32x4*)(q2 + i);
#pragma unroll
                    for (int j = 0; j < 4; ++j) topk_insert<8>(L, key_of((a8[q][j] - tmu * ca[j]) * trs + da[j], i + j));
                }
            }
            float L1[8], L2[8];
#pragma unroll
            for (int i = 0; i < 8; ++i) { auto r = __builtin_amdgcn_permlane32_swap(__float_as_uint(L[i]), __float_as_uint(L[i]), false, false); L1[i] = __uint_as_float(r[0]); L2[i] = __uint_as_float(r[1]); }
            float cv[8], ce[8];
#pragma unroll
            for (int i = 0; i < 8; ++i) { cv[i] = -3.0e38f; ce[i] = 0.f; }
#pragma unroll
            for (int i = 0; i < 8; ++i)
#pragma unroll
                for (int j = 0; j < 8; ++j)
                    if ((i + 1) * (j + 1) <= 8) {
                        float v = val_of(L1[i]) + val_of(L2[j]);
                        float ex = __int_as_float(idx_of(L1[i]) * 128 + idx_of(L2[j]));
#pragma unroll
                        for (int k = 0; k < 8; ++k) { const bool gt = v > cv[k]; const float tv = gt ? cv[k] : v, te = gt ? ce[k] : ex; cv[k] = gt ? v : cv[k]; ce[k] = gt ? ex : ce[k]; v = tv; ex = te; }
                    }
            float sm = 0.f, pe[8];
#pragma unroll
            for (int k = 0; k < 8; ++k) { pe[k] = __expf(cv[k] - cv[0]); sm += pe[k]; }
            const float inv = 1.0f / sm;
            if (lane < 32)
#pragma unroll
            for (int k = 0; k < 8; ++k) { eid[tl * 32 + hd * 8 + k] = __float_as_int(ce[k]); gat[tl * 32 + hd * 8 + k] = pe[k] * inv; }
        }
        __syncthreads();
#define PEER_LD4(R, TAB, B0) _Pragma("unroll") for (int k = 0; k < 4; ++k) R[k].load(TAB, __builtin_amdgcn_readlane(my_e, (B0) + k), lane); asm volatile("" ::: "memory")
#define PEER_U4(R, B0) do { float s4[4]; \
                _Pragma("unroll") for (int k = 0; k < 4; ++k) { float d[32]; R[k].decode(d); f32x2 a0 = {0.f, 0.f}, a1 = {0.f, 0.f}; \
                    _Pragma("unroll") for (int i = 0; i < 32; i += 4) { a0 = __builtin_elementwise_fma(f32x2{xv[i], xv[i + 1]}, f32x2{d[i], d[i + 1]}, a0); a1 = __builtin_elementwise_fma(f32x2{xv[i + 2], xv[i + 3]}, f32x2{d[i + 2], d[i + 3]}, a1); } \
                    s4[k] = (a0.x + a0.y) + (a1.x + a1.y); } \
                const float r4 = wave_sum4(s4[0], s4[1], s4[2], s4[3]); \
                _Pragma("unroll") for (int k = 0; k < 4; ++k) { const float sk = __int_as_float(__builtin_amdgcn_readlane(__float_as_int(r4), 16 * k)); if (lane == (B0) + k) hsum = sk; } } while (0)
#define PEER_V4(R, B0) do { _Pragma("unroll") for (int k = 0; k < 4; ++k) { const float ak = __int_as_float(__builtin_amdgcn_readlane(__float_as_int(act), (B0) + k)); float d[32]; R[k].decode(d); \
                    _Pragma("unroll") for (int i = 0; i < 32; i += 2) { const f32x2 o = __builtin_elementwise_fma(f32x2{ak, ak}, f32x2{d[i], d[i + 1]}, f32x2{ov[i], ov[i + 1]}); ov[i] = o.x; ov[i + 1] = o.y; } } } while (0)
        u32x2 traw[8];
        {   const bf16_t* xp = T1 + (size_t)(tok0 + w * 8) * DM + 4 * lane;
#pragma unroll
            for (int j = 0; j < 8; ++j) traw[j] = *(const u32x2*)(xp + 256 * j); }
        int my_e = eid[(w * 8) * 32 + (lane & 31)];
        RowBits<PEER_UBITS> ra[4], rb[4];
        PEER_LD4(ra, UT, 0);
#pragma unroll 1
        for (int tt = 0; tt < 8; ++tt) {
            const int tl = w * 8 + tt, tok = tok0 + tl, tln = w * 8 + (tt < 7 ? tt + 1 : 7);
            float xv[32];
            const f32x2 st = {stl[2 * tl], stl[2 * tl + 1]};
            {   int l4 = 4 * lane; asm volatile("" : "+v"(l4));
#pragma unroll
                for (int j = 0; j < 8; ++j) {
                    const u32x2 ta = traw[j];
                    const f32x4 gg = *(const LAS f32x4*)(pg1 + l4 + 256 * j), bb = *(const LAS f32x4*)(pb1 + l4 + 256 * j);
                    xv[4 * j] = (bf_lo(ta.x) - st.x) * st.y * gg[0] + bb[0]; xv[4 * j + 1] = (bf_hi(ta.x) - st.x) * st.y * gg[1] + bb[1];
                    xv[4 * j + 2] = (bf_lo(ta.y) - st.x) * st.y * gg[2] + bb[2]; xv[4 * j + 3] = (bf_hi(ta.y) - st.x) * st.y * gg[3] + bb[3]; } }
            {   const bf16_t* xp = T1 + (size_t)(tok0 + tln) * DM + 4 * lane;
#pragma unroll
                for (int j = 0; j < 8; ++j) traw[j] = *(const u32x2*)(xp + 256 * j); }
            const float my_g = gat[tl * 32 + (lane & 31)];
            const float my_us = USC[my_e], my_vs = VSC[my_e];
            float hsum = 0.f;
            RowBits<PEER_VBITS> va[4], vb[4];
#pragma unroll 1
            for (int e0 = 0; e0 < 24; e0 += 8) { PEER_LD4(rb, UT, e0 + 4); PEER_U4(ra, e0); PEER_LD4(ra, UT, e0 + 8); PEER_U4(rb, e0 + 4); }
            PEER_LD4(rb, UT, 28); PEER_U4(ra, 24);
            PEER_LD4(va, VTB, 0);
            PEER_U4(rb, 28);
            const float act = gelu_erf(hsum * my_us) * my_g * my_vs;
            float ov[32];
#pragma unroll
            for (int i = 0; i < 32; ++i) ov[i] = 0.f;
#pragma unroll 1
            for (int e0 = 0; e0 < 24; e0 += 8) { PEER_LD4(vb, VTB, e0 + 4); PEER_V4(va, e0); PEER_LD4(va, VTB, e0 + 8); PEER_V4(vb, e0 + 4); }
            PEER_LD4(vb, VTB, 28); PEER_V4(va, 24);
            {   const int e_cur = my_e; my_e = eid[tln * 32 + (lane & 31)]; PEER_LD4(ra, UT, 0); (void)e_cur; }
            PEER_V4(vb, 28);
#pragma unroll
            for (int i = 0; i < 32; ++i) ov[i] += DN_ALPHA * xv[i];
            {   LAS float* g2_ = pg2; LAS float* b2_ = pb2; asm volatile("" : "+v"(g2_), "+v"(b2_));
                ln_row16<LAS float*>(ov, g2_, b2_, dstf ? dstf + (size_t)tok * DM : nullptr, XB + (size_t)tok * DM, ws + WS_X8 + (size_t)tok * DM, lane); }
        }
        __syncthreads();
    }
}
#ifndef REP_PRO
#define REP_PRO 1
#endif
#ifndef REP_GEMM0
#define REP_GEMM0 1
#endif
#ifndef REP_PREP
#define REP_PREP 1
#endif
#ifndef REP_SB
#define REP_SB 1
#endif
#ifndef REP_SCAN
#define REP_SCAN 1
#endif
#ifndef REP_SCANB
#define REP_SCANB 1
#endif
#ifndef REP_SCANC
#define REP_SCANC 1
#endif
#ifndef REP_GOUT
#define REP_GOUT 1
#endif
#ifndef REP_GEMM4
#define REP_GEMM4 1
#endif
#ifndef REP_LN
#define REP_LN 1
#endif
#ifndef REP_GEMM6
#define REP_GEMM6 1
#endif
#ifndef REP_PEER
#define REP_PEER 1
#endif
#ifndef REP_PRO
#define REP_PRO 1
#endif
#ifndef REP_GEMM0
#define REP_GEMM0 1
#endif
#ifndef REP_PREP
#define REP_PREP 1
#endif
#ifndef REP_SB
#define REP_SB 1
#endif
#ifndef REP_SCAN
#define REP_SCAN 1
#endif
#ifndef REP_SCANB
#define REP_SCANB 1
#endif
#ifndef REP_SCANC
#define REP_SCANC 1
#endif
#ifndef REP_GOUT
#define REP_GOUT 1
#endif
#ifndef REP_GEMM4
#define REP_GEMM4 1
#endif
#ifndef REP_LN
#define REP_LN 1
#endif
#ifndef REP_GEMM6
#define REP_GEMM6 1
#endif
#ifndef REP_PEER
#define REP_PEER 1
#endif
#ifndef REP_PBS
#define REP_PBS 1
#endif
#ifndef REP_OTH
#define REP_OTH 1
#endif
#ifndef REP_CT
#define REP_CT 1
#endif
#ifndef EN_PRO
#define EN_PRO 1
#endif
#ifndef EN_GEMM0
#define EN_GEMM0 1
#endif
#ifndef EN_PREP
#define EN_PREP 1
#endif
#ifndef EN_SB
#define EN_SB 1
#endif
#ifndef EN_SCAN
#define EN_SCAN 1
#endif
#ifndef EN_GOUT
#define EN_GOUT 1
#endif
#ifndef EN_GEMM4
#define EN_GEMM4 1
#endif
#ifndef EN_LN
#define EN_LN 1
#endif
#ifndef EN_GEMM6
#define EN_GEMM6 1
#endif
#ifndef EN_PEER
#define EN_PEER 1
#endif
constexpr int NPL = 10, NPH = 1 + NPL * DEPTH;
__host__ __device__ constexpr bool phase_exists(int ph) { return ph == 0 || !(((((ph - 1) / NPL) & 1) != 0) && (((ph - 1) % NPL) >= 2) && (((ph - 1) % NPL) <= 5)) && (((ph - 1) % NPL) != 7); }

__global__ void __launch_bounds__(NTHREADS, 2) hybrid_fwd(Args args) {
    extern __shared__ __attribute__((aligned(16))) unsigned char lds_raw[];
    Ctx c;
    c.a = (ArgsP)__builtin_amdgcn_kernarg_segment_ptr(); c.lds = (LAS unsigned char*)lds_raw; c.tid = threadIdx.x; c.lane = c.tid & 63; c.wave = __builtin_amdgcn_readfirstlane(c.tid >> 6); c.G = gridDim.x; c.bid = blockIdx.x;
    unsigned char* ws = c.a->ws;
    const int lo = c.a->ph_lo, hi = c.a->ph_hi;
    const bool fused = (hi - lo) > 1;
    volatile LAS unsigned* xbst = (volatile LAS unsigned*)(c.lds + LDS_CTL);
    if (c.tid < 4) xbst[c.tid] = 0u;
    __syncthreads();
    XcdBarrier bar; bar.bar = (unsigned*)(ws + WS_CTL); bar.x = 0; bar.st = xbst;
    if (fused) bar = xcd_barrier_post((unsigned*)(ws + WS_CTL), xbst);
#define IN(k) (lo <= (k) && (k) < hi)
#define FRESH() do { int t_ = threadIdx.x; asm volatile("" : "+v"(t_)); c.tid = t_; c.lane = t_ & 63; c.wave = __builtin_amdgcn_readfirstlane(t_ >> 6); ArgsP a_ = (ArgsP)__builtin_amdgcn_kernarg_segment_ptr(); asm volatile("" : "+s"(a_)); c.a = a_; ws = a_->ws; } while (0)
#ifndef SEAM_REP
#define SEAM_REP 1
#endif
#define SEAM(k) do { if (fused && (k) + 1 < hi) { for (int sr_ = 0; sr_ < SEAM_REP; ++sr_) xcd_barrier(bar); } } while (0)
    LAS unsigned char* glds = (LAS unsigned char*)c.lds;

    if (IN(0)) {
#if EN_PRO
#pragma unroll 1
 for (int rep_ = 0; rep_ < REP_PRO; ++rep_) { if (rep_) __syncthreads();
 FRESH(); phase_prologue(c);
 }
#endif
 SEAM(0); }

#pragma unroll 1
    for (int L = 0; L < DEPTH; ++L) {
        const int base = 1 + NPL * L, li = L >> 1;
        const bool gdn = (L & 1) == 0;

        if (IN(base + 0)) {
#if EN_GEMM0
#pragma unroll 1
 for (int rep_ = 0; rep_ < REP_GEMM0; ++rep_) { if (rep_) __syncthreads();
            FRESH();
            {   pg8::MultiOrder S; S.G = c.G; S.c = c.bid; S.nj = 0;
                const bf16_t* const X8p = (const bf16_t*)(ws + WS_X8); bf16_t* const Pp = (bf16_t*)(ws + WS_P);
                pg8::Job jz{X8p, X8p, Pp, 0, 0, 0};
                S.j[0] = jz; S.j[1] = jz; S.j[2] = jz; S.j[3] = jz;
                if (gdn) { S.j[0] = pg8::Job{X8p, (const bf16_t*)(ws + WS_WG + (size_t)li * GDN_NP * DM), Pp, M_TOK, GDN_NP, LDP}; S.nj = 1; }
                else { S.j[0] = pg8::Job{X8p, (const bf16_t*)(ws + WS_WSB + (size_t)li * SB_NP * DM), Pp, M_TOK, SB_NP, LDP};
                       S.j[1] = pg8::Job{(const bf16_t*)(ws + WS_WSBV + (size_t)li * 1024 * DM), X8p, (bf16_t*)(ws + WS_VT), 1024, M_TOK, M_TOK}; S.nj = 2; }
                if (L == 0) {
                    S.j[1] = pg8::Job{(const bf16_t*)(ws + WS_MEMB), (const bf16_t*)(ws + WS_WK), (bf16_t*)(ws + WS_KM), NMEM, 2048, 2048};
                    S.j[2] = pg8::Job{(const bf16_t*)(ws + WS_WV), (const bf16_t*)(ws + WS_MEMB), (bf16_t*)(ws + WS_VMT), 2048, NMEM, NMEM}; S.nj = 3; }
                pg8::Gemm g{X8p, X8p, M_TOK, 256, DM / 2, E8_WIN, E8_ACT};
                pg8::EpiBf16Multi E{S.j[0].O, S.j[1].O, S.j[2].O, S.j[3].O, S.j[0].ldc, S.j[1].ldc, S.j[2].ldc, S.j[3].ldc};
                pg8::gemm_phase<pg8::EpiBf16Multi, pg8::MultiOrder, false, true, E8_WIN, E8_ACT>(glds, g, S, E, nullptr); }
            if (c.bid == c.G - 1) peer_c12_finalize(c, L);
 }
#endif
            SEAM(base + 0);
        }
        if (IN(base + 1)) {

#if EN_PREP
#pragma unroll 1
 for (int rep_ = 0; rep_ < REP_PREP; ++rep_) { if (rep_) __syncthreads();
 FRESH(); if (gdn) phase_gdn_prep(c, li);
 }
#endif
#if EN_SB
#pragma unroll 1
 for (int rep_ = 0; rep_ < REP_SB; ++rep_) { if (rep_) __syncthreads();
 FRESH(); if (!gdn) phase_sb_attn(c, L);
 }
#endif

            SEAM(base + 1);
        }
        if (gdn && IN(base + 2)) {
#if EN_SCAN
#pragma unroll 1
            for (int rep_ = 0; rep_ < REP_SCAN; ++rep_) { if (rep_) __syncthreads();
            FRESH();
            for (int u = c.bid; u < 8 * SCAN_NG; u += c.G) { scan_pass_a(c, u); __syncthreads(); } }
#endif
            SEAM(base + 2);
        }
        if (gdn && IN(base + 3)) {
#if EN_SCAN
#pragma unroll 1
            for (int rep_ = 0; rep_ < REP_SCANB; ++rep_) { if (rep_) __syncthreads();
            FRESH();
            if (c.G > 8) { if (c.bid < 8) { for (int rb_ = 0; rb_ < REP_PBS; ++rb_) { if (rb_) __syncthreads(); scan_pass_b(c, c.bid); } } else { mem_attn_all(c, L, GC_QM, c.bid - 8, c.G - 8); if (REP_OTH > 1) { __syncthreads(); mem_attn_all(c, L, GC_QM, c.bid - 8, c.G - 8); } if (REP_OTH > 2) { __syncthreads(); mem_attn_all(c, L, GC_QM, c.bid - 8, c.G - 8); } for (int rb_ = 0; rb_ < REP_CT; ++rb_) { if (rb_) __syncthreads(); convert_tables(c, L, c.bid - 8, c.G - 8); } } }
            else { for (int hd = c.bid; hd < 8; hd += c.G) scan_pass_b(c, hd); mem_attn_all(c, L, GC_QM, c.bid, c.G); convert_tables(c, L, c.bid, c.G); } }
#endif
            SEAM(base + 3);
        }
        if (gdn && IN(base + 4)) {
#if EN_SCAN
#pragma unroll 1
            for (int rep_ = 0; rep_ < REP_SCANC; ++rep_) { if (rep_) __syncthreads();
            FRESH();
            for (int u = c.bid; u < 8 * SCAN_NG; u += c.G) { scan_pass_c(c, u); __syncthreads(); } }
#endif
            SEAM(base + 4);
        }
        if (gdn && IN(base + 5)) {
#if EN_GOUT
#pragma unroll 1
 for (int rep_ = 0; rep_ < REP_GOUT; ++rep_) { if (rep_) __syncthreads();
 FRESH(); phase_gdn_out(c, li);
 }
#endif
 SEAM(base + 5); }
        if (IN(base + 6)) {
#if EN_GEMM4
#pragma unroll 1
 for (int rep_ = 0; rep_ < REP_GEMM4; ++rep_) { if (rep_) __syncthreads();
            FRESH();
            pg8::Gemm g{(const bf16_t*)(ws + WS_MIX), (const bf16_t*)(ws + WS_WO + (size_t)L * DM * MIXW), M_TOK, DM, MIXW / 2, E8_WOUT, E8_ACT};
            pg8::StaticOrder S; S.init(M_TOK, DM, c.G, c.bid);
            pg8::EpiResid E{(const bf16_t*)(ws + WS_XB), (bf16_t*)(ws + WS_F1), DM, DN_ALPHA};
            pg8::gemm_phase<pg8::EpiResid, pg8::StaticOrder, false, true, E8_WOUT, E8_ACT>(glds, g, S, E, nullptr);
 }
#endif
            SEAM(base + 6);
        }
        if (IN(base + 8)) {
#if EN_GEMM6
#pragma unroll 1
 for (int rep_ = 0; rep_ < REP_GEMM6; ++rep_) { if (rep_) __syncthreads();
            FRESH();
            pg8::Gemm g{(const bf16_t*)(ws + WS_F1), (const bf16_t*)(ws + WS_WP) + (size_t)L * 1024 * DM, M_TOK, 1024, DM};
            pg8::StaticOrder S; S.init(M_TOK, 1024, c.G, c.bid);
            pg8::EpiF32 E{(float*)(ws + WS_SC), 1024};
            pg8::gemm_phase<pg8::EpiF32, pg8::StaticOrder>(glds, g, S, E, nullptr);
 }
#endif
            SEAM(base + 8);
        }
        if (IN(base + 9)) {
#if EN_PEER
#pragma unroll 1
 for (int rep_ = 0; rep_ < REP_PEER; ++rep_) { if (rep_) __syncthreads();
FRESH();             phase_peer(c, L, c.a->ln_mix_g + L * DM, c.a->ln_mix_b + L * DM, c.a->ln_ffn_g + L * DM, c.a->ln_ffn_b + L * DM, (L == DEPTH - 1) ? c.a->out : (float*)nullptr);
 }
#endif
            SEAM(base + 9);
        }
    }
#undef IN
#undef SEAM
}

#ifndef MK_FUSED
#define MK_FUSED 1
#endif
extern "C" void kernel_launch(void* const* d_in, const int* in_sizes, int n_in, void* d_out, int out_size, void* d_ws, size_t ws_size, hipStream_t stream) {
    static int grid = 0;
    if (grid == 0) {
        if (n_in != 18 || out_size != M_TOK * DM || ws_size < WS_END) { fprintf(stderr, "kernel_launch: unexpected shapes (n_in %d out %d ws %zu need %zu)\n", n_in, out_size, ws_size, (size_t)WS_END); grid = -1; return; }
        int dev = 0, cus = 0, per_cu = 0;
        if (hipGetDevice(&dev) != hipSuccess || hipDeviceGetAttribute(&cus, hipDeviceAttributeMultiprocessorCount, dev) != hipSuccess) { grid = -1; return; }
        if (hipFuncSetAttribute((const void*)hybrid_fwd, hipFuncAttributeMaxDynamicSharedMemorySize, LDS_BYTES) != hipSuccess) { fprintf(stderr, "kernel_launch: hipFuncSetAttribute failed\n"); grid = -1; return; }
        if (hipOccupancyMaxActiveBlocksPerMultiprocessor(&per_cu, (const void*)hybrid_fwd, NTHREADS, LDS_BYTES) != hipSuccess || per_cu < 1) { fprintf(stderr, "kernel_launch: occupancy query says %d\n", per_cu); (void)hipGetLastError(); }
        grid = cus;
    }
    if (grid < 0) return;
    hipMemsetAsync((char*)d_ws + WS_CTL, 0, WS_CTL_BYTES, stream);
    Args a{};
    a.x = (const float*)d_in[0]; a.mem = (const float*)d_in[1]; a.gdn_w_in = (const float*)d_in[2]; a.gdn_conv = (const float*)d_in[3]; a.gdn_a_log = (const float*)d_in[4];
    a.gdn_dt_bias = (const float*)d_in[5]; a.gdn_onorm = (const float*)d_in[6]; a.sb_w_in = (const float*)d_in[7]; a.mem_w_kv = (const float*)d_in[8]; a.w_out = (const float*)d_in[9];
    a.ln_mix_g = (const float*)d_in[10]; a.ln_mix_b = (const float*)d_in[11]; a.peer_w_q = (const float*)d_in[12]; a.peer_keys = (const float*)d_in[13]; a.peer_u = (const float*)d_in[14];
    a.peer_v = (const float*)d_in[15]; a.ln_ffn_g = (const float*)d_in[16]; a.ln_ffn_b = (const float*)d_in[17];
    a.out = (float*)d_out; a.ws = (unsigned char*)d_ws;
#if MK_FUSED
    a.ph_lo = 0; a.ph_hi = NPH;
    hipLaunchKernelGGL(hybrid_fwd, dim3(grid), dim3(NTHREADS), LDS_BYTES, stream, a);
#else
    for (int ph = 0; ph < NPH; ++ph) {
        if (!phase_exists(ph)) continue;
        a.ph_lo = ph; a.ph_hi = ph + 1;
        hipLaunchKernelGGL(hybrid_fwd, dim3(grid), dim3(NTHREADS), LDS_BYTES, stream, a);
    }
#endif
}
```

```cpp
#include <hip/hip_runtime.h>
#include <stdio.h>
#include <stdint.h>

#define LAS __attribute__((address_space(3)))
typedef unsigned short bf16_t;
typedef short bf16x8 __attribute__((ext_vector_type(8)));
typedef short s16x4 __attribute__((ext_vector_type(4)));
typedef float f32x2 __attribute__((ext_vector_type(2)));
typedef float f32x4 __attribute__((ext_vector_type(4)));
typedef float f32x16 __attribute__((ext_vector_type(16)));
typedef unsigned u32x2 __attribute__((ext_vector_type(2)));
typedef unsigned u32x4 __attribute__((ext_vector_type(4)));
typedef __bf16 bfx2 __attribute__((ext_vector_type(2)));
typedef float f32x32 __attribute__((ext_vector_type(32)));
typedef unsigned u32x6 __attribute__((ext_vector_type(6)));
#define DI __device__ __forceinline__

DI unsigned pk2(float lo, float hi) { f32x2 v = {lo, hi}; return __builtin_bit_cast(unsigned, __builtin_convertvector(v, bfx2)); }
DI bf16_t f2bf(float f) { return (bf16_t)(pk2(f, 0.f) & 0xffffu); }
DI float bf_lo(unsigned w) { return __uint_as_float(w << 16); }
DI float bf_hi(unsigned w) { return __uint_as_float(w & 0xffff0000u); }
DI float bf2f(bf16_t b) { return __uint_as_float(((unsigned)b) << 16); }
DI float row_sum16(float v) {
    v += __int_as_float(__builtin_amdgcn_update_dpp(0, __float_as_int(v), 0xB1, 0xF, 0xF, true));
    v += __int_as_float(__builtin_amdgcn_update_dpp(0, __float_as_int(v), 0x4E, 0xF, 0xF, true));
    v += __int_as_float(__builtin_amdgcn_update_dpp(0, __float_as_int(v), 0x141, 0xF, 0xF, true));
    v += __int_as_float(__builtin_amdgcn_update_dpp(0, __float_as_int(v), 0x140, 0xF, 0xF, true));
    return v; }
DI float swap16_sum(float a, float b) { auto r = __builtin_amdgcn_permlane16_swap(__float_as_uint(a), __float_as_uint(b), false, false); return __uint_as_float(r[0]) + __uint_as_float(r[1]); }
DI float swap32_sum(float a, float b) { auto r = __builtin_amdgcn_permlane32_swap(__float_as_uint(a), __float_as_uint(b), false, false); return __uint_as_float(r[0]) + __uint_as_float(r[1]); }
DI float wave_sum(float v) { v = row_sum16(v); v = swap16_sum(v, v); return swap32_sum(v, v); }
DI float wave_max(float v) {
    v = fmaxf(v, __int_as_float(__builtin_amdgcn_update_dpp(0, __float_as_int(v), 0xB1, 0xF, 0xF, true)));
    v = fmaxf(v, __int_as_float(__builtin_amdgcn_update_dpp(0, __float_as_int(v), 0x4E, 0xF, 0xF, true)));
    v = fmaxf(v, __int_as_float(__builtin_amdgcn_update_dpp(0, __float_as_int(v), 0x141, 0xF, 0xF, true)));
    v = fmaxf(v, __int_as_float(__builtin_amdgcn_update_dpp(0, __float_as_int(v), 0x140, 0xF, 0xF, true)));
    { auto r = __builtin_amdgcn_permlane16_swap(__float_as_uint(v), __float_as_uint(v), false, false); v = fmaxf(__uint_as_float(r[0]), __uint_as_float(r[1])); }
    { auto r = __builtin_amdgcn_permlane32_swap(__float_as_uint(v), __float_as_uint(v), false, false); v = fmaxf(__uint_as_float(r[0]), __uint_as_float(r[1])); }
    return v; }
DI float wave_sum4(float s0, float s1, float s2, float s3) { return row_sum16(swap16_sum(swap32_sum(s0, s2), swap32_sum(s1, s3))); }
DI float fast_exp(float x) { return __builtin_amdgcn_exp2f(x * 1.44269504088896f); }
DI float sigmoidf_(float x) { return __builtin_amdgcn_rcpf(1.0f + fast_exp(-x)); }
DI float siluf_(float x) { return x * sigmoidf_(x); }
constexpr float F8_ACT = 16.0f, F8_WIN = 2048.0f, F8_WOUT = 4096.0f;
constexpr int E8_ACT = 123, E8_WIN = 116, E8_WOUT = 115;
DI float f8c(float v, float sc) { return fminf(fmaxf(v * sc, -448.0f), 448.0f); }
DI unsigned pk4_f8(float a, float b, float c2, float d, float sc) { int t = 0; t = __builtin_amdgcn_cvt_pk_fp8_f32(f8c(a, sc), f8c(b, sc), t, false); t = __builtin_amdgcn_cvt_pk_fp8_f32(f8c(c2, sc), f8c(d, sc), t, true); return (unsigned)t; }
DI bf16x8 pack8(float a0, float a1, float a2, float a3, float a4, float a5, float a6, float a7) {
    u32x4 p; p.x = pk2(a0, a1); p.y = pk2(a2, a3); p.z = pk2(a4, a5); p.w = pk2(a6, a7); return __builtin_bit_cast(bf16x8, p); }
#define MFMA32(a, b, c) __builtin_amdgcn_mfma_f32_32x32x16_bf16((a), (b), (c), 0, 0, 0)
#define MFMA16(a, b, c) __builtin_amdgcn_mfma_f32_16x16x32_bf16((a), (b), (c), 0, 0, 0)

constexpr int M_TOK = 16384, DM = 2048, DEPTH = 4, NMEM = 256, HD = 128;
constexpr int LDP = 3840;
constexpr int GDN_NP = 3840, SB_NP = 2560;
constexpr int MIXW = 1536;
constexpr float DN_ALPHA = 1.681792830507429f;
constexpr float LN_EPS = 1e-5f, RMS_EPS = 1e-6f;
constexpr int NTHREADS = 512;
constexpr int LDS_BYTES = 160 * 1024;
constexpr int LDS_CTL = LDS_BYTES - 256;

constexpr int GC_Q = 0, GC_K = 512, GC_V = 1024, GC_Z = 2048, GC_QM = 3072, GC_B = 3584, GC_A = 3592;
constexpr int SC_Q = 0, SC_K = 1024, SC_QM = 2048;

constexpr int REC_W = 0, REC_QG = 16384, REC_KDT = 32768, REC_AQK = 49152, REC_U = 57344, REC_BYTES = 73728;

constexpr size_t al256(size_t x) { return (x + 255) & ~(size_t)255; }
constexpr size_t WS_CTL = 0;
constexpr size_t WS_CTL_BYTES = 65536;
constexpr size_t WS_XB = WS_CTL + WS_CTL_BYTES;
constexpr size_t WS_F0 = WS_XB + (size_t)M_TOK * DM * 2;
constexpr size_t WS_F1 = WS_F0 + (size_t)M_TOK * DM * 4;
constexpr size_t WS_F2 = WS_F1 + (size_t)M_TOK * DM * 4;
constexpr size_t WS_P = WS_F2 + (size_t)M_TOK * DM * 4;
constexpr size_t WS_VT = WS_P + (size_t)M_TOK * LDP * 2;
constexpr size_t WS_REC = WS_VT + (size_t)1024 * M_TOK * 2;
constexpr size_t WS_GAM = WS_REC + (size_t)2048 * REC_BYTES;
constexpr size_t WS_OG = WS_GAM + 8192;
constexpr size_t WS_MIX = WS_OG + (size_t)M_TOK * 1024 * 4;
constexpr size_t WS_SC = WS_MIX + (size_t)M_TOK * MIXW * 2;
constexpr size_t WS_MEMB = WS_SC + (size_t)M_TOK * 1024 * 4;
constexpr size_t WS_KM = WS_MEMB + (size_t)NMEM * DM * 2;
constexpr size_t WS_VMT = WS_KM + (size_t)NMEM * 2048 * 2;
constexpr size_t WS_WG = WS_VMT + (size_t)2048 * NMEM * 2;
constexpr size_t WS_WSB = WS_WG + (size_t)2 * GDN_NP * DM * 2;
constexpr size_t WS_WSBV = WS_WSB + (size_t)2 * SB_NP * DM * 2;
constexpr size_t WS_WK = WS_WSBV + (size_t)2 * 1024 * DM * 2;
constexpr size_t WS_WV = WS_WK + (size_t)2048 * DM * 2;
constexpr size_t WS_WO = WS_WV + (size_t)2048 * DM * 2;
constexpr size_t WS_WP = WS_WO + (size_t)4 * DM * MIXW * 2;
#ifndef PEER_UBITS
#define PEER_UBITS 4
#endif
#ifndef PEER_VBITS
#define PEER_VBITS 4
#endif
constexpr int UROW = 256 * PEER_UBITS, VROW = 256 * PEER_VBITS;
constexpr size_t WS_UT = WS_WP + (size_t)4 * 1024 * DM * 2;
constexpr size_t WS_VTAB = WS_UT + (size_t)4 * 16384 * UROW;
constexpr size_t WS_USC = WS_VTAB + (size_t)4 * 16384 * VROW;
constexpr size_t WS_VSC = WS_USC + (size_t)4 * 16384 * 4;
constexpr size_t WS_PHI = WS_VSC + (size_t)4 * 16384 * 4;
constexpr size_t WS_SLOC = WS_PHI + (size_t)256 * 32768;
constexpr size_t WS_SIN = WS_SLOC + (size_t)256 * 32768;
constexpr size_t WS_X8 = WS_SIN + (size_t)256 * 32768;
constexpr size_t WS_CP1 = WS_X8 + (size_t)M_TOK * DM;
constexpr size_t WS_CP2 = WS_CP1 + (size_t)4 * 32 * 1024 * 4;
constexpr size_t WS_C12 = WS_CP2 + (size_t)4 * 32 * 1024 * 4;
constexpr size_t WS_END = WS_C12 + (size_t)4 * 2 * 1024 * 4;

struct Args {
    const float* x; const float* mem; const float* gdn_w_in; const float* gdn_conv; const float* gdn_a_log; const float* gdn_dt_bias; const float* gdn_onorm;
    const float* sb_w_in; const float* mem_w_kv; const float* w_out; const float* ln_mix_g; const float* ln_mix_b; const float* peer_w_q; const float* peer_keys;
    const float* peer_u; const float* peer_v; const float* ln_ffn_g; const float* ln_ffn_b;
    float* out; unsigned char* ws; int ph_lo, ph_hi;
};
namespace pg8 {
#define PG8_LAS __attribute__((address_space(3)))
typedef unsigned short bf16_t;
typedef short bf16x8 __attribute__((ext_vector_type(8)));
typedef float f32x4 __attribute__((ext_vector_type(4)));
typedef unsigned u32x4 __attribute__((ext_vector_type(4)));
constexpr int BM = 256, BK = 64, HALF = 128, HTB = HALF * BK * 2  , STAGE_BYTES = 8 * HTB, NXCD = 8, WGM = 8;

__host__ __device__ __forceinline__ int lds_byte(int r, int c) { const int st = (r >> 4) * 2 + (c >> 5), rr = r & 15, cc = c & 31, ob = rr * 64 + cc * 2; return st * 1024 + (ob ^ (((ob >> 9) & 1) << 5)); }
__host__ __device__ __forceinline__ void stage_rc(int b, int& R, int& C) { const int st = b / 1024, sb = b % 1024, swz = sb ^ (((sb >> 9) & 1) << 5); R = (st >> 1) * 16 + swz / 64; C = (st & 1) * 32 + (swz % 64) / 2; }
__host__ __device__ __forceinline__ int perm32(int rho) { const int n = rho >> 4, i = rho & 15; return 8 * (i >> 2) + 4 * n + (i & 3); }

struct Unit { int pm, pn, job; };
struct Gemm { const bf16_t* A; const bf16_t* Bt; int M, N, K; int sA, sB; };
typedef int i32x4v __attribute__((ext_vector_type(4)));
typedef int i32x8v __attribute__((ext_vector_type(8)));

struct StaticOrder {
    int nM, nN, nwg, G, c;
    __host__ __device__ void init(int M, int N, int G_, int c_) { nM = M / BM; nN = N / BM; nwg = nM * nN; G = G_; c = c_; }
    __host__ __device__ bool next(int i, Unit& u) const {
        const long L = (long)i * G + c; if (L >= nwg) return false;
        int wgid = (int)L; { const int q = nwg / NXCD, r = nwg % NXCD, xcd = wgid % NXCD, off = wgid / NXCD; wgid = (xcd < r ? xcd * (q + 1) : r * (q + 1) + (xcd - r) * q) + off; }
        const int nig = WGM * nN, gid = wgid / nig, fm = gid * WGM, gsz = (nM - fm) < WGM ? (nM - fm) : WGM;
        u.pm = fm + ((wgid % nig) % gsz); u.pn = (wgid % nig) / gsz; u.job = 0; return true;
    }
    __device__ __forceinline__ const char* ptrA(const Gemm& g, const Unit&) const { return (const char*)g.A; }
    __device__ __forceinline__ const char* ptrB(const Gemm& g, const Unit&) const { return (const char*)g.Bt; }
    __device__ __forceinline__ void a_ready(const Unit&) const {}
    __device__ __forceinline__ void done(const Unit&) const {}
};
struct EpiF32 {
    static constexpr bool PERM = false, AFTER_DRAIN = false;
    float* C; int ldc;
    __device__ __forceinline__ void operator()(const f32x4 (&acc)[2][2][4][2], const Unit& u, int wr, int wc, int fr, int fq) const {
        const int row0 = u.pm * BM + wr * 64 + fr, col0 = u.pn * BM + wc * 32 + 4 * fq;
#pragma unroll
        for (int ai = 0; ai < 2; ++ai)
#pragma unroll
            for (int m = 0; m < 4; ++m) { float* rowp = C + (size_t)(row0 + ai * HALF + m * 16) * ldc + col0;
#pragma unroll
                for (int bj = 0; bj < 2; ++bj)
#pragma unroll
                    for (int n = 0; n < 2; ++n) *(f32x4*)(rowp + bj * HALF + n * 16) = acc[ai][bj][m][n]; }
    }
};
struct EpiResid {
    static constexpr bool PERM = true, AFTER_DRAIN = false;
    const bf16_t* X; bf16_t* T; int ldc; float alpha;
    __device__ __forceinline__ void operator()(const f32x4 (&acc)[2][2][4][2], const Unit& u, int wr, int wc, int fr, int fq) const {
        const int row0 = u.pm * BM + wr * 64 + fr, col0 = u.pn * BM + wc * 32 + 8 * fq;
        u32x4 xv[2][4][2];
#pragma unroll
        for (int ai = 0; ai < 2; ++ai)
#pragma unroll
            for (int m = 0; m < 4; ++m)
#pragma unroll
                for (int bj = 0; bj < 2; ++bj) xv[ai][m][bj] = *(const u32x4*)(X + (size_t)(row0 + ai * HALF + m * 16) * ldc + col0 + bj * HALF);
#pragma unroll
        for (int ai = 0; ai < 2; ++ai)
#pragma unroll
            for (int m = 0; m < 4; ++m) { const size_t off = (size_t)(row0 + ai * HALF + m * 16) * ldc + col0;
#pragma unroll
                for (int bj = 0; bj < 2; ++bj) { const f32x4 v0 = acc[ai][bj][m][0], v1 = acc[ai][bj][m][1]; const u32x4 x = xv[ai][m][bj];
                    u32x4 w; w.x = ::pk2(::bf_lo(x.x) * alpha + v0[0], ::bf_hi(x.x) * alpha + v0[1]); w.y = ::pk2(::bf_lo(x.y) * alpha + v0[2], ::bf_hi(x.y) * alpha + v0[3]);
                    w.z = ::pk2(::bf_lo(x.z) * alpha + v1[0], ::bf_hi(x.z) * alpha + v1[1]); w.w = ::pk2(::bf_lo(x.w) * alpha + v1[2], ::bf_hi(x.w) * alpha + v1[3]);
                    *(u32x4*)(T + off + bj * HALF) = w; } }
    }
};
struct EpiBf16 {
    static constexpr bool PERM = true, AFTER_DRAIN = false;
    bf16_t* O; int ldc;
    __device__ __forceinline__ void operator()(const f32x4 (&acc)[2][2][4][2], const Unit& u, int wr, int wc, int fr, int fq) const {
        const int row0 = u.pm * BM + wr * 64 + fr, col0 = u.pn * BM + wc * 32 + 8 * fq;
#pragma unroll
        for (int ai = 0; ai < 2; ++ai)
#pragma unroll
            for (int m = 0; m < 4; ++m) { bf16_t* rowp = O + (size_t)(row0 + ai * HALF + m * 16) * ldc + col0;
#pragma unroll
                for (int bj = 0; bj < 2; ++bj) { const f32x4 v0 = acc[ai][bj][m][0], v1 = acc[ai][bj][m][1];
                    u32x4 w; w.x = ::pk2(v0[0], v0[1]); w.y = ::pk2(v0[2], v0[3]); w.z = ::pk2(v1[0], v1[1]); w.w = ::pk2(v1[2], v1[3]);
                    *(u32x4*)(rowp + bj * HALF) = w; } }
    }
};

struct Job { const bf16_t* A; const bf16_t* Bt; bf16_t* O; int M, N, ldc; };
struct MultiOrder {
    Job j[4]; int nj, G, c;
    __device__ __forceinline__ bool next(int i, Unit& u) const {
        long L = (long)i * G + c; int job = -1, M = 0, N = 0;
#pragma unroll
        for (int k = 0; k < 4; ++k) { if (job < 0 && k < nj) { const int n = (j[k].M / BM) * (j[k].N / BM); if (L < n) { job = k; M = j[k].M; N = j[k].N; } else L -= n; } }
        if (job < 0) return false;
        const int nM = M / BM, nN = N / BM, nwg = nM * nN;
        int wgid = (int)L; { const int q = nwg / NXCD, r = nwg % NXCD, xcd = wgid % NXCD, off = wgid / NXCD; wgid = (xcd < r ? xcd * (q + 1) : r * (q + 1) + (xcd - r) * q) + off; }
        const int nig = WGM * nN, gid = wgid / nig, fm = gid * WGM, gsz = (nM - fm) < WGM ? (nM - fm) : WGM;
        u.pm = fm + ((wgid % nig) % gsz); u.pn = (wgid % nig) / gsz; u.job = job; return true;
    }
    __device__ __forceinline__ const char* ptrA(const Gemm&, const Unit& u) const { return (const char*)(u.job == 0 ? j[0].A : u.job == 1 ? j[1].A : u.job == 2 ? j[2].A : j[3].A); }
    __device__ __forceinline__ const char* ptrB(const Gemm&, const Unit& u) const { return (const char*)(u.job == 0 ? j[0].Bt : u.job == 1 ? j[1].Bt : u.job == 2 ? j[2].Bt : j[3].Bt); }
    __device__ __forceinline__ void a_ready(const Unit&) const {}
    __device__ __forceinline__ void done(const Unit&) const {}
};
struct EpiBf16Multi {
    static constexpr bool PERM = true, AFTER_DRAIN = false;
    bf16_t* O0; bf16_t* O1; bf16_t* O2; bf16_t* O3; int l0, l1, l2, l3;
    __device__ __forceinline__ void operator()(const f32x4 (&acc)[2][2][4][2], const Unit& u, int wr, int wc, int fr, int fq) const {
        bf16_t* O = u.job == 0 ? O0 : u.job == 1 ? O1 : u.job == 2 ? O2 : O3; const int ldc = u.job == 0 ? l0 : u.job == 1 ? l1 : u.job == 2 ? l2 : l3;
        const int row0 = u.pm * BM + wr * 64 + fr, col0 = u.pn * BM + wc * 32 + 8 * fq;
#pragma unroll
        for (int ai = 0; ai < 2; ++ai)
#pragma unroll
            for (int m = 0; m < 4; ++m) { bf16_t* rowp = O + (size_t)(row0 + ai * HALF + m * 16) * ldc + col0;
#pragma unroll
                for (int bj = 0; bj < 2; ++bj) { const f32x4 v0 = acc[ai][bj][m][0], v1 = acc[ai][bj][m][1];
                    u32x4 w; w.x = ::pk2(v0[0], v0[1]); w.y = ::pk2(v0[2], v0[3]); w.z = ::pk2(v1[0], v1[1]); w.w = ::pk2(v1[2], v1[3]);
                    *(u32x4*)(rowp + bj * HALF) = w; } }
    }
};
template <class Epi, class Sched, bool STAMP = false, bool F8 = false, int SA = 127, int SB = 127>
__device__ __forceinline__ void gemm_phase(PG8_LAS unsigned char* lds, const Gemm g, const Sched& S, const Epi& E, unsigned long long* stamps) {
    int tid_ = threadIdx.x; asm volatile("" : "+v"(tid_));
    const int tid = tid_, wid = __builtin_amdgcn_readfirstlane(tid >> 6), lane = tid & 63, wr = wid >> 2, wc = wid & 3, fr = lane & 15, fq = lane >> 4;
    const int K = g.K, nt = K / BK;
    int ts_lo = 0, ts_hi = 0, nts = 0; const unsigned long long rt_entry = STAMP ? (unsigned long long)wall_clock64() : 0ull;
#define PG8_STAMP() do { if (STAMP && wid == 0 && nts < 64) { const unsigned long long _c = (unsigned long long)clock64(); \
        ts_lo = (lane == nts) ? (int)(unsigned)_c : ts_lo; ts_hi = (lane == nts) ? (int)(unsigned)(_c >> 32) : ts_hi; ++nts; } } while (0)
    PG8_STAMP();
    unsigned voffA[2], voffB[2];
#pragma unroll
    for (int i = 0; i < 2; ++i) { int R, C; stage_rc(tid * 16 + i * 8192, R, C); const int Rb = Epi::PERM ? ((R & ~31) + perm32(R & 31)) : R;
        voffA[i] = (unsigned)(R * K + C) * 2u; voffB[i] = (unsigned)(Rb * K + C) * 2u; }
    const size_t kstep = (size_t)(BK * 2);
    const size_t hstep = (size_t)HALF * K * 2;
    const size_t tstep = 2 * hstep;
    const unsigned ldsw = (unsigned)wid * 1024u;
    const int aoff = lds_byte(wr * 64 + fr, fq * 8), boff = lds_byte(wc * 32 + fr, fq * 8);
#define PG8_SA(b, h) (((b) * 2 + (h)) * HTB)
#define PG8_SB(b, h) ((4 + (b) * 2 + (h)) * HTB)
#define PG8_STAGE(bufoff, gbase, voff) do { _Pragma("unroll") for (int _i = 0; _i < 2; ++_i) \
        __builtin_amdgcn_global_load_lds((const unsigned*)((const char*)(gbase) + (voff)[_i]), (PG8_LAS unsigned*)(lds + (bufoff) + ldsw + _i * 8192), 16, 0, 0); } while (0)
#define PG8_LDA(dst, b, h) do { _Pragma("unroll") for (int m = 0; m < 4; ++m) _Pragma("unroll") for (int k = 0; k < 2; ++k) dst[m][k] = *(const PG8_LAS bf16x8*)(lds + PG8_SA(b, h) + aoff + m * 2048 + k * 1024); } while (0)
#define PG8_LDB(dst, b, h) do { _Pragma("unroll") for (int n = 0; n < 2; ++n) _Pragma("unroll") for (int k = 0; k < 2; ++k) dst[n][k] = *(const PG8_LAS bf16x8*)(lds + PG8_SB(b, h) + boff + n * 2048 + k * 1024); } while (0)
#define PG8_MMA_BF(ai, bj, At, Bt) do { __builtin_amdgcn_s_setprio(1); _Pragma("unroll") for (int m = 0; m < 4; ++m) _Pragma("unroll") for (int n = 0; n < 2; ++n) _Pragma("unroll") for (int k = 0; k < 2; ++k) \
        acc[ai][bj][m][n] = __builtin_amdgcn_mfma_f32_16x16x32_bf16(Bt[n][k], At[m][k], acc[ai][bj][m][n], 0, 0, 0); __builtin_amdgcn_s_setprio(0); } while (0)
#define PG8_MMA_F8(ai, bj, At, Bt) do { __builtin_amdgcn_s_setprio(1); _Pragma("unroll") for (int m = 0; m < 4; ++m) _Pragma("unroll") for (int n = 0; n < 2; ++n) { \
        const i32x8v bq_ = __builtin_shufflevector(__builtin_bit_cast(i32x4v, Bt[n][0]), __builtin_bit_cast(i32x4v, Bt[n][1]), 0, 1, 2, 3, 4, 5, 6, 7); \
        const i32x8v aq_ = __builtin_shufflevector(__builtin_bit_cast(i32x4v, At[m][0]), __builtin_bit_cast(i32x4v, At[m][1]), 0, 1, 2, 3, 4, 5, 6, 7); \
          \
        asm volatile("v_mfma_scale_f32_16x16x128_f8f6f4 %0, %1, %2, %0, %3, %4 op_sel_hi:[0,0,0]" : "+v"(acc[ai][bj][m][n]) : "v"(bq_), "v"(aq_), "v"(f8_sa), "v"(f8_sb)); } __builtin_amdgcn_s_setprio(0); } while (0)
#define PG8_MMA(ai, bj, At, Bt) do { if constexpr (F8) PG8_MMA_F8(ai, bj, At, Bt); else PG8_MMA_BF(ai, bj, At, Bt); } while (0)
#define PG8_WAIT_V(n) asm volatile("s_waitcnt vmcnt(" #n ")" ::: "memory")
#define PG8_WAIT_L(n) asm volatile("s_waitcnt lgkmcnt(" #n ")" ::: "memory")
#define PG8_BAR __builtin_amdgcn_s_barrier()
#define PG8_SCHED __builtin_amdgcn_sched_barrier(0)
    Unit cur, nxt; int ui = 0;
    if (!S.next(0, cur)) return;
    f32x4 acc[2][2][4][2];
#pragma unroll
    for (int a = 0; a < 2; ++a)
#pragma unroll
        for (int b = 0; b < 2; ++b)
#pragma unroll
            for (int m = 0; m < 4; ++m)
#pragma unroll
                for (int n = 0; n < 2; ++n) acc[a][b][m][n] = (f32x4){0.f, 0.f, 0.f, 0.f};
    bf16x8 At[4][2], B0[2][2], B1[2][2];
    int f8_sa = SA, f8_sb = SB; if constexpr (F8) asm volatile("" : "+v"(f8_sa), "+v"(f8_sb));
    const char* cA = S.ptrA(g, cur) + (size_t)cur.pm * tstep; const char* cB = S.ptrB(g, cur) + (size_t)cur.pn * tstep;
    S.a_ready(cur);
    PG8_STAGE(PG8_SB(0, 0), cB, voffB); PG8_STAGE(PG8_SA(0, 0), cA, voffA); PG8_STAGE(PG8_SB(0, 1), cB + hstep, voffB); PG8_STAGE(PG8_SA(0, 1), cA + hstep, voffA);
    if (wr == 1) PG8_BAR;
    PG8_WAIT_V(4); PG8_BAR;
    PG8_STAGE(PG8_SB(1, 0), cB + kstep, voffB); PG8_STAGE(PG8_SA(1, 0), cA + kstep, voffA); PG8_STAGE(PG8_SB(1, 1), cB + hstep + kstep, voffB);
    PG8_WAIT_V(6); PG8_BAR;
    PG8_STAMP();
    for (;;) {
        const bool has_next = S.next(ui + 1, nxt);
        const char* nA = has_next ? S.ptrA(g, nxt) + (size_t)nxt.pm * tstep : cA; const char* nB = has_next ? S.ptrB(g, nxt) + (size_t)nxt.pn * tstep : cB;
        for (int t = 0; t < nt; t += 2) {
            const bool last = (t == nt - 2);
            const char* a1 = cA + (size_t)(t + 1) * kstep;
            const char* a2 = last ? nA : cA + (size_t)(t + 2) * kstep; const char* b2 = last ? nB : cB + (size_t)(t + 2) * kstep;
            const char* a3 = a2 + kstep; const char* b3 = b2 + kstep;
            if (last && has_next) S.a_ready(nxt);
            PG8_LDB(B0, 0, 0); PG8_SCHED; PG8_LDA(At, 0, 0); PG8_STAGE(PG8_SA(1, 1), a1 + hstep, voffA);
            PG8_WAIT_L(8); PG8_BAR; PG8_WAIT_L(0); PG8_MMA(0, 0, At, B0); PG8_BAR; PG8_SCHED;
            PG8_LDB(B1, 0, 1); PG8_STAGE(PG8_SB(0, 0), b2, voffB);
            PG8_BAR; PG8_WAIT_L(0); PG8_MMA(0, 1, At, B1); PG8_BAR;
            PG8_LDA(At, 0, 1); PG8_STAGE(PG8_SA(0, 0), a2, voffA);
            PG8_BAR; PG8_WAIT_L(0); PG8_MMA(1, 0, At, B0); PG8_BAR; PG8_SCHED;
            PG8_STAGE(PG8_SB(0, 1), b2 + hstep, voffB);
            PG8_WAIT_V(6); PG8_BAR; PG8_MMA(1, 1, At, B1); PG8_BAR;
            PG8_LDB(B0, 1, 0); PG8_SCHED; PG8_LDA(At, 1, 0); PG8_STAGE(PG8_SA(0, 1), a2 + hstep, voffA);
            PG8_WAIT_L(8); PG8_BAR; PG8_WAIT_L(0); PG8_MMA(0, 0, At, B0); PG8_BAR; PG8_SCHED;
            PG8_LDB(B1, 1, 1); PG8_STAGE(PG8_SB(1, 0), b3, voffB);
            PG8_BAR; PG8_WAIT_L(0); PG8_MMA(0, 1, At, B1); PG8_BAR;
            PG8_LDA(At, 1, 1); PG8_STAGE(PG8_SA(1, 0), a3, voffA);
            PG8_BAR; PG8_WAIT_L(0); PG8_MMA(1, 0, At, B0); PG8_BAR; PG8_SCHED;
            PG8_STAGE(PG8_SB(1, 1), b3 + hstep, voffB);
            PG8_WAIT_V(6); PG8_BAR; PG8_MMA(1, 1, At, B1); PG8_BAR;
        }
        PG8_STAMP();
        if constexpr (F8) asm volatile("s_nop 15\n\ts_nop 15" ::: "memory");
        if constexpr (!Epi::AFTER_DRAIN) { E(acc, cur, wr, wc, fr, fq); S.done(cur); }
        PG8_STAMP();
        if (!has_next) break;
#pragma unroll
        for (int a = 0; a < 2; ++a)
#pragma unroll
            for (int b = 0; b < 2; ++b)
#pragma unroll
                for (int m = 0; m < 4; ++m)
#pragma unroll
                    for (int n = 0; n < 2; ++n) acc[a][b][m][n] = (f32x4){0.f, 0.f, 0.f, 0.f};
        cur = nxt; cA = nA; cB = nB; ++ui;
    }
    PG8_WAIT_V(0);
    if (wr == 0) PG8_BAR;
    PG8_BAR;
    if constexpr (Epi::AFTER_DRAIN) { E.fused(acc, cur, wr, wc, fr, fq, lds, wid, lane); S.done(cur); }
    PG8_STAMP();
    if (STAMP && wid == 0) { stamps[lane] = lane < nts ? (((unsigned long long)(unsigned)ts_hi << 32) | (unsigned)ts_lo) : 0ull;
        if (lane == 62) stamps[62] = rt_entry; if (lane == 63) stamps[63] = (unsigned long long)wall_clock64(); }
#undef PG8_STAMP
#undef PG8_SA
#undef PG8_SB
#undef PG8_STAGE
#undef PG8_LDA
#undef PG8_LDB
#undef PG8_MMA
#undef PG8_MMA_BF
#undef PG8_MMA_F8
#undef PG8_WAIT_V
#undef PG8_WAIT_L
#undef PG8_BAR
#undef PG8_SCHED
}
}
#define XB_TMO      128
#define XB_XCNT(j)  (256  + 64 * (j))
#define XB_XSUB(j)  (1280 + 64 * (j))
#define XB_XGEN(j)  (2304 + 64 * (j))
#define XB_TOP      3328
#define XB_TOPGEN   3392
#define XCD_BAR_WORDS 3456
#define XB_SPIN_CAP (1u << 18)

__device__ __forceinline__ unsigned xb_ld(unsigned* p)              { return __hip_atomic_load(p, __ATOMIC_RELAXED, __HIP_MEMORY_SCOPE_AGENT); }
__device__ __forceinline__ unsigned xb_add(unsigned* p, unsigned v) { return __hip_atomic_fetch_add(p, v, __ATOMIC_RELAXED, __HIP_MEMORY_SCOPE_AGENT); }
__device__ __forceinline__ unsigned xb_xcc_id() { return (unsigned)__builtin_amdgcn_s_getreg((3 << 11) | 20) & 0xFu; }
#define XB_SPIN(cond, bar) do { unsigned _sp = 0; while (cond) { __builtin_amdgcn_s_sleep(1); \
    if ((++_sp & 255u) == 0u) { if (xb_ld(&(bar)[XB_TMO])) break; if (_sp > XB_SPIN_CAP) { atomicAdd(&(bar)[XB_TMO], 1u); break; } } } } while (0)

struct XcdBarrier {
    unsigned* bar; unsigned x;
    volatile LAS unsigned* st;
};

__device__ __forceinline__ XcdBarrier xcd_barrier_post(unsigned* bar, volatile LAS unsigned* st) {
    XcdBarrier b; b.bar = bar; b.x = xb_xcc_id(); b.st = st;
    if (threadIdx.x == 0) (void)xb_add(&bar[XB_XCNT(b.x)], 1u);
    return b;
}
__device__ __forceinline__ void xcd_barrier_complete(unsigned* bar, unsigned x, unsigned& nloc, unsigned& nx) {
    const unsigned G = gridDim.x * gridDim.y * gridDim.z;
    unsigned sum, cnt, mine, sp = 0u;
    for (;;) {
        sum = 0u; cnt = 0u; mine = 0u;
#pragma unroll
        for (unsigned j = 0; j < 16; ++j) { const unsigned c = xb_ld(&bar[XB_XCNT(j)]); sum += c; cnt += (c > 0u) ? 1u : 0u; mine = (j == x) ? c : mine; }
        if (sum == G) break;
        __builtin_amdgcn_s_sleep(1);
        if ((++sp & 255u) == 0u) { if (xb_ld(&bar[XB_TMO])) break; if (sp > XB_SPIN_CAP) { atomicAdd(&bar[XB_TMO], 1u); break; } }
    }
    nloc = mine > 0u ? mine : 1u; nx = cnt > 0u ? cnt : 1u;
}

__device__ __forceinline__ void xcd_barrier(const XcdBarrier& b) {
    asm volatile("s_waitcnt vmcnt(0)" ::: "memory");
    __syncthreads();
    if (threadIdx.x == 0) {
        unsigned* bar = b.bar;
        __builtin_amdgcn_s_waitcnt(0);
        unsigned nloc = b.st[0], nx = b.st[1];
        if (nloc == 0u) { xcd_barrier_complete(bar, b.x, nloc, nx); b.st[0] = nloc; b.st[1] = nx; }
        const unsigned old = xb_add(&bar[XB_XSUB(b.x)], 1u);
        const unsigned gen = old / nloc;
        if (old + 1u == (gen + 1u) * nloc) {
            __builtin_amdgcn_fence(__ATOMIC_RELEASE, "agent");
            asm volatile("s_waitcnt vmcnt(0)" ::: "memory");
            const unsigned og = xb_add(&bar[XB_TOP], 1u);
            const unsigned tg = og / nx;
            if (og + 1u == (tg + 1u) * nx) xb_add(&bar[XB_TOPGEN], 1u);
            else XB_SPIN(xb_ld(&bar[XB_TOPGEN]) == tg, bar);
            __builtin_amdgcn_fence(__ATOMIC_ACQUIRE, "agent");
            xb_add(&bar[XB_XGEN(b.x)], 1u);
            asm volatile("s_waitcnt vmcnt(0)" ::: "memory");
        } else {
            XB_SPIN(xb_ld(&bar[XB_XGEN(b.x)]) == gen, bar);
            __builtin_amdgcn_fence(__ATOMIC_ACQUIRE, "agent");
            asm volatile("s_waitcnt vmcnt(0)" ::: "memory");
        }
    }
    __syncthreads();
}
typedef const __attribute__((address_space(4))) Args* ArgsP;
struct Ctx {
    ArgsP a; LAS unsigned char* lds; int tid, lane, wave, G, bid;
};

template <bool F8> DI void transpose_job(const Ctx& c, int& rr, const float* src, int ld, int col0, int nvalid, void* dstv, int K, int row0, int ncols, float sc) {
    LAS float* tile = (LAS float*)c.lds;
    const int tilesN = ncols / 256, nt = tilesN * (K / 64);
    int t = c.bid - rr % c.G; if (t < 0) t += c.G;
    rr += nt;
    for (; t < nt; t += c.G) {
        const int tn = t % tilesN, tk = t / tilesN;
        {   const int kk = c.tid >> 4, n4 = (c.tid & 15) * 4;
            f32x4 v[2][4];
#pragma unroll
            for (int i = 0; i < 2; ++i)
#pragma unroll
                for (int j = 0; j < 4; ++j) v[i][j] = *(const f32x4*)(src + (size_t)(tk * 64 + kk + 32 * i) * ld + col0 + tn * 256 + 64 * j + n4);
#pragma unroll
            for (int i = 0; i < 2; ++i)
#pragma unroll
                for (int j = 0; j < 4; ++j)
#pragma unroll
                    for (int e = 0; e < 4; ++e) tile[j * 4160 + (kk + 32 * i) * 65 + n4 + e] = (tn * 256 + 64 * j + n4 + e < nvalid) ? v[i][j][e] : 0.f;
        }
        __syncthreads();
        {   const int n = c.tid >> 3, k8 = (c.tid & 7) * 8;
#pragma unroll
            for (int j = 0; j < 4; ++j) {
                float v[8];
#pragma unroll
                for (int e = 0; e < 8; ++e) v[e] = tile[j * 4160 + (k8 + e) * 65 + n];
                if constexpr (F8) { u32x2 w; w.x = pk4_f8(v[0], v[1], v[2], v[3], sc); w.y = pk4_f8(v[4], v[5], v[6], v[7], sc);
                    *(u32x2*)((unsigned char*)dstv + (size_t)(row0 + tn * 256 + 64 * j + n) * K + tk * 64 + k8) = w; }
                else { u32x4 w; w.x = pk2(v[0], v[1]); w.y = pk2(v[2], v[3]); w.z = pk2(v[4], v[5]); w.w = pk2(v[6], v[7]);
                    *(u32x4*)((bf16_t*)dstv + (size_t)(row0 + tn * 256 + 64 * j + n) * K + tk * 64 + k8) = w; } } }
        __syncthreads();
    }
}
DI void convert_job(const Ctx& c, const float* src, bf16_t* dst, unsigned char* dst8, size_t n, bool nt) {
    const size_t stride = (size_t)c.G * NTHREADS * 8;
    for (size_t i = ((size_t)c.bid * NTHREADS + c.tid) * 8; i < n; i += stride) {
        f32x4 a, b;
        if (nt) { a = __builtin_nontemporal_load((const f32x4*)(src + i)); b = __builtin_nontemporal_load((const f32x4*)(src + i + 4)); }
        else { a = *(const f32x4*)(src + i); b = *(const f32x4*)(src + i + 4); }
        if (dst) { u32x4 w; w.x = pk2(a[0], a[1]); w.y = pk2(a[2], a[3]); w.z = pk2(b[0], b[1]); w.w = pk2(b[2], b[3]); *(u32x4*)(dst + i) = w; }
        u32x2 w8; w8.x = pk4_f8(a[0], a[1], a[2], a[3], F8_ACT); w8.y = pk4_f8(b[0], b[1], b[2], b[3], F8_ACT); *(u32x2*)(dst8 + i) = w8;
    }
}
DI bool fp6_interleaved() {
    f32x16 a, b;
#pragma unroll
    for (int i = 0; i < 16; ++i) { a[i] = 1.0f; b[i] = 2.0f; }
    const f32x32 d = __builtin_amdgcn_cvt_scalef32_pk32_f32_fp6(__builtin_amdgcn_cvt_scalef32_2xpk16_fp6_f32(a, b, 1.0f), 1.0f);
    return d[1] == 2.0f;
}
DI u32x6 fp6_pack32(const float (&e)[32], bool il) {
    f32x16 a, b;
    if (il) {
#pragma unroll
        for (int i = 0; i < 16; ++i) { a[i] = e[2 * i]; b[i] = e[2 * i + 1]; } }
    else {
#pragma unroll
        for (int i = 0; i < 16; ++i) { a[i] = e[i]; b[i] = e[16 + i]; } }
    return __builtin_amdgcn_cvt_scalef32_2xpk16_fp6_f32(a, b, 1.0f);
}
DI bool fp4_swapped() {
    const unsigned w = __builtin_amdgcn_cvt_scalef32_pk_fp4_f32(0u, 1.0f, 2.0f, 1.0f, 0);
    const f32x2 d = __builtin_amdgcn_cvt_scalef32_pk_f32_fp4(w, 1.0f, 0);
    return d.x == 2.0f;
}
DI u32x4 fp4_pack32(const float (&e)[32], bool sw) {
    u32x4 r;
#pragma unroll
    for (int dw = 0; dw < 4; ++dw) {
        unsigned w = 0u;
        const float e0 = sw ? e[8 * dw + 1] : e[8 * dw], e1 = sw ? e[8 * dw] : e[8 * dw + 1], e2 = sw ? e[8 * dw + 3] : e[8 * dw + 2], e3 = sw ? e[8 * dw + 2] : e[8 * dw + 3];
        const float e4 = sw ? e[8 * dw + 5] : e[8 * dw + 4], e5 = sw ? e[8 * dw + 4] : e[8 * dw + 5], e6 = sw ? e[8 * dw + 7] : e[8 * dw + 6], e7 = sw ? e[8 * dw + 6] : e[8 * dw + 7];
        w = __builtin_amdgcn_cvt_scalef32_pk_fp4_f32(w, e0, e1, 1.0f, 0); w = __builtin_amdgcn_cvt_scalef32_pk_fp4_f32(w, e2, e3, 1.0f, 1);
        w = __builtin_amdgcn_cvt_scalef32_pk_fp4_f32(w, e4, e5, 1.0f, 2); w = __builtin_amdgcn_cvt_scalef32_pk_fp4_f32(w, e6, e7, 1.0f, 3);
        r[dw] = w; }
    return r;
}
DI void fp4_unpack32(const u32x4 p, float (&d)[32]) {
#pragma unroll
    for (int dw = 0; dw < 4; ++dw) {
        const f32x2 a = __builtin_amdgcn_cvt_scalef32_pk_f32_fp4(p[dw], 1.0f, 0), b = __builtin_amdgcn_cvt_scalef32_pk_f32_fp4(p[dw], 1.0f, 1);
        const f32x2 cc = __builtin_amdgcn_cvt_scalef32_pk_f32_fp4(p[dw], 1.0f, 2), dd = __builtin_amdgcn_cvt_scalef32_pk_f32_fp4(p[dw], 1.0f, 3);
        d[8 * dw] = a.x; d[8 * dw + 1] = a.y; d[8 * dw + 2] = b.x; d[8 * dw + 3] = b.y; d[8 * dw + 4] = cc.x; d[8 * dw + 5] = cc.y; d[8 * dw + 6] = dd.x; d[8 * dw + 7] = dd.y; }
}
template <int BITS> DI void convert_table_lp(const Ctx& c, const float* src, unsigned char* dst, float* inv_scale, int row_lo, int row_hi, int brank, int nblk) {
    const bool il = (BITS == 6) ? fp6_interleaved() : fp4_swapped();
    constexpr float TOP = (BITS == 6) ? 7.4f : 6.0f;
    for (int row = row_lo + brank * 8 + c.wave; row < row_hi; row += nblk * 8) {
        const float* sp = src + (size_t)row * DM + 4 * c.lane;
        f32x4 v[8];
#pragma unroll
        for (int j = 0; j < 8; ++j) v[j] = __builtin_nontemporal_load((const f32x4*)(sp + 256 * j));
        float mx = 0.f;
#pragma unroll
        for (int j = 0; j < 8; ++j) mx = fmaxf(mx, fmaxf(fmaxf(fabsf(v[j][0]), fabsf(v[j][1])), fmaxf(fabsf(v[j][2]), fabsf(v[j][3]))));
        mx = wave_max(mx);
        const float sc = mx > 0.f ? TOP / mx : 1.0f;
        float e[32];
#pragma unroll
        for (int j = 0; j < 8; ++j)
#pragma unroll
            for (int q = 0; q < 4; ++q) e[4 * j + q] = v[j][q] * sc;
        if constexpr (BITS == 6) {
            const u32x6 pk = fp6_pack32(e, il);
            u32x2* dp = (u32x2*)(dst + (size_t)row * 1536 + 24 * c.lane);
            dp[0] = (u32x2){pk[0], pk[1]}; dp[1] = (u32x2){pk[2], pk[3]}; dp[2] = (u32x2){pk[4], pk[5]};
        } else {
            *(u32x4*)(dst + (size_t)row * 1024 + 16 * c.lane) = fp4_pack32(e, il);
        }
        if (c.lane == 0) inv_scale[row] = mx > 0.f ? mx * (1.0f / TOP) : 1.0f;
    }
}
DI void split_store(LAS unsigned char* hi, LAS unsigned char* lo, const f32x4 v) {
    u32x2 h, l; h.x = pk2(v[0], v[1]); h.y = pk2(v[2], v[3]);
    l.x = pk2(v[0] - bf_lo(h.x), v[1] - bf_hi(h.x)); l.y = pk2(v[2] - bf_lo(h.y), v[3] - bf_hi(h.y));
    *(LAS u32x2*)hi = h; *(LAS u32x2*)lo = l; }
DI void fold_peer(const Ctx& c) {
    constexpr int FP_KH = 0, FP_KL = 128 * 272, FP_WH = 2 * 128 * 272, FP_WL = FP_WH + 64 * 272;
    LAS unsigned char* L = c.lds;
    bf16_t* WP = (bf16_t*)(c.a->ws + WS_WP);
    const int ntile = 4 * 8 * 32, per = (ntile + c.G - 1) / c.G;
    int last = -1;
    for (int t = c.bid * per; t < ntile && t < (c.bid + 1) * per; ++t) {
        const int ihp = t >> 5, dt = t & 31, i = ihp >> 3, hp = ihp & 7, p = hp & 1;
        __syncthreads();
        if (ihp != last) { last = ihp;
            const float* ks = c.a->peer_keys + (size_t)(i * 2 + p) * 128 * 128;
            for (int e = c.tid * 4; e < 128 * 128; e += NTHREADS * 4) { const f32x4 v = *(const f32x4*)(ks + e); const int n = e >> 7, cc = e & 127;
                split_store(L + FP_KH + n * 272 + cc * 2, L + FP_KL + n * 272 + cc * 2, v); } }
        {   const float* wq = c.a->peer_w_q + (size_t)i * DM * 1024 + (size_t)(dt * 64) * 1024 + hp * 128;
            for (int e = c.tid * 4; e < 64 * 128; e += NTHREADS * 4) { const int d = e >> 7, cc = e & 127; const f32x4 v = *(const f32x4*)(wq + (size_t)d * 1024 + cc);
                split_store(L + FP_WH + d * 272 + cc * 2, L + FP_WL + d * 272 + cc * 2, v); } }
        __syncthreads();
        {
            const int r16 = c.lane & 15, q4 = c.lane >> 4;
            f32x4 acc[4];
#pragma unroll
            for (int t4 = 0; t4 < 4; ++t4) acc[t4] = (f32x4){0.f, 0.f, 0.f, 0.f};
#pragma unroll
            for (int ks = 0; ks < 4; ++ks) {
                const int ao = (16 * c.wave + r16) * 272 + (32 * ks + 8 * q4) * 2;
                const bf16x8 ah = *(const LAS bf16x8*)(L + FP_KH + ao), al = *(const LAS bf16x8*)(L + FP_KL + ao);
#pragma unroll
                for (int t4 = 0; t4 < 4; ++t4) {
                    const int bo = (16 * t4 + r16) * 272 + (32 * ks + 8 * q4) * 2;
                    const bf16x8 bh = *(const LAS bf16x8*)(L + FP_WH + bo), bl = *(const LAS bf16x8*)(L + FP_WL + bo);
                    acc[t4] = MFMA16(al, bh, acc[t4]); acc[t4] = MFMA16(ah, bl, acc[t4]); acc[t4] = MFMA16(ah, bh, acc[t4]);
                }
            }
            const float* g1p = c.a->ln_mix_g + i * DM + dt * 64; const float* b1p = c.a->ln_mix_b + i * DM + dt * 64;
            float p1[4] = {0.f, 0.f, 0.f, 0.f}, p2[4] = {0.f, 0.f, 0.f, 0.f};
#pragma unroll
            for (int t4 = 0; t4 < 4; ++t4) { const float gd = g1p[16 * t4 + r16], bd = b1p[16 * t4 + r16];
#pragma unroll
                for (int e = 0; e < 4; ++e) { const unsigned wgb = pk2(acc[t4][e] * gd, 0.f);
                    WP[((size_t)i * 1024 + hp * 128 + 16 * c.wave + 4 * q4 + e) * DM + dt * 64 + 16 * t4 + r16] = (bf16_t)(wgb & 0xffffu);
                    p1[e] += bf_lo(wgb); p2[e] += bd * acc[t4][e]; } }
#pragma unroll
            for (int e = 0; e < 4; ++e) {
                p1[e] = row_sum16(p1[e]); p2[e] = row_sum16(p2[e]);
                if (r16 == 0) { const size_t ix = (size_t)(i * 32 + dt) * 1024 + hp * 128 + 16 * c.wave + 4 * q4 + e;
                    ((float*)(c.a->ws + WS_CP1))[ix] = p1[e]; ((float*)(c.a->ws + WS_CP2))[ix] = p2[e]; } }
        }
    }
    __syncthreads();
}
#ifndef REP_PA
#define REP_PA 1
#define REP_PB 1
#define REP_PC 1
#endif
DI void phase_prologue(const Ctx& c) {
    unsigned char* ws = c.a->ws;
    convert_job(c, c.a->x, (bf16_t*)(ws + WS_XB), ws + WS_X8, (size_t)M_TOK * DM, false);
    convert_job(c, c.a->mem, (bf16_t*)nullptr, ws + WS_MEMB, (size_t)NMEM * DM, false);
    int rr = 0;
#pragma unroll 1
    for (int rpa = 0; rpa < REP_PA; ++rpa) {
    for (int li = 0; li < 2; ++li) {
        const float* src = c.a->gdn_w_in + (size_t)li * DM * 3600; unsigned char* dst = ws + WS_WG + (size_t)li * GDN_NP * DM;
        transpose_job<true>(c, rr, src, 3600, 0, 3072, dst, DM, 0, 3072, F8_WIN);
        transpose_job<true>(c, rr, src, 3600, 3088, 512, dst, DM, GC_QM, 512, F8_WIN);
        transpose_job<true>(c, rr, src, 3600, 3072, 16, dst, DM, GC_B, 256, F8_WIN);
        const float* s2 = c.a->sb_w_in + (size_t)li * DM * 3584; unsigned char* d2 = ws + WS_WSB + (size_t)li * SB_NP * DM;
        transpose_job<true>(c, rr, s2, 3584, 0, 2048, d2, DM, 0, 2048, F8_WIN);
        transpose_job<true>(c, rr, s2, 3584, 3072, 512, d2, DM, SC_QM, 512, F8_WIN);
        transpose_job<true>(c, rr, s2, 3584, 2048, 1024, ws + WS_WSBV + (size_t)li * 1024 * DM, DM, 0, 1024, F8_WIN);
    }
    for (int i = 0; i < DEPTH; ++i) {
        const float* kv = c.a->mem_w_kv + (size_t)i * DM * 1024;
        transpose_job<true>(c, rr, kv, 1024, 0, 512, ws + WS_WK, DM, i * 512, 512, F8_WIN);
        transpose_job<true>(c, rr, kv, 1024, 512, 512, ws + WS_WV, DM, i * 512, 512, F8_WIN);
        transpose_job<true>(c, rr, c.a->w_out + (size_t)i * MIXW * DM, DM, 0, DM, ws + WS_WO + (size_t)i * DM * MIXW, MIXW, 0, DM, F8_WOUT);
    }
    }
#pragma unroll 1
    for (int rpb = 0; rpb < REP_PB; ++rpb) fold_peer(c);
}

DI void convert_tables(const Ctx& c, int l0, int brank, int nblk) {
    if (nblk <= 0) return;
    unsigned char* ws = c.a->ws;
    convert_table_lp<PEER_UBITS>(c, c.a->peer_u, ws + WS_UT, (float*)(ws + WS_USC), l0 * 16384, (l0 + 2) * 16384, brank, nblk);
    convert_table_lp<PEER_VBITS>(c, c.a->peer_v, ws + WS_VTAB, (float*)(ws + WS_VSC), l0 * 16384, (l0 + 2) * 16384, brank, nblk);
}

DI void peer_c12_finalize(const Ctx& c, int i) {
    const float* cp1 = (const float*)(c.a->ws + WS_CP1) + (size_t)i * 32 * 1024; const float* cp2 = (const float*)(c.a->ws + WS_CP2) + (size_t)i * 32 * 1024;
    float* c12 = (float*)(c.a->ws + WS_C12) + (size_t)i * 2 * 1024;
    for (int n = c.tid; n < 1024; n += NTHREADS) { float s1 = 0.f, s2 = 0.f;
        for (int dt = 0; dt < 32; ++dt) { s1 += cp1[dt * 1024 + n]; s2 += cp2[dt * 1024 + n]; }
        c12[n] = s1; c12[1024 + n] = s2; }
}
DI int swap23(int x) { return (x & ~12) | ((x & 4) << 1) | ((x & 8) >> 1); }
constexpr int G2_KBF = 0, G2_QBF = 17408, G2_RHST = 34816, G2_KDT = 71680, G2_MM = 90112, G2_TM = 107520, G2_XS = 124928, G2_GATE = 131456;
DI void phase_gdn_prep(const Ctx& c, int li) {
    unsigned char* ws = c.a->ws;
    const bf16_t* P = (const bf16_t*)(ws + WS_P);
    const float* convw = c.a->gdn_conv + (size_t)li * 4 * 2048;
    LAS unsigned char* L = c.lds;
    LAS float* gate = (LAS float*)(L + G2_GATE);
    LAS float* Mm = (LAS float*)(L + G2_MM);
    LAS float* Tm = (LAS float*)(L + G2_TM);
    LAS float* Xs = (LAS float*)(L + G2_XS);
    const int tid = c.tid, lane = c.lane, w = c.wave;
    unsigned short gb_n = 0, ga_n = 0;
    if (w == 0 && c.bid < 2048) { const size_t row = (size_t)((c.bid >> 3) * 64 + lane) * LDP; gb_n = P[row + GC_B + (c.bid & 7)]; ga_n = P[row + GC_A + (c.bid & 7)]; }
    for (int u = c.bid; u < 2048; u += c.G) {
        const int h = u & 7, n = u >> 3, t0 = n * 64;
        unsigned char* rec = ws + WS_REC + (size_t)(h * 256 + n) * REC_BYTES;
        const unsigned short gb_c = gb_n, ga_c = ga_n;
        if (w == 0 && u + c.G < 2048) { const int un = u + c.G; const size_t row = (size_t)((un >> 3) * 64 + lane) * LDP; gb_n = P[row + GC_B + (un & 7)]; ga_n = P[row + GC_A + (un & 7)]; }
#ifndef RQ0
#define RQ0 1
#define RQ1 1
#define RQ2 1
#define RQ3 1
#define RQ4 1
#endif
#pragma unroll 1
        for (int rq0 = 0; rq0 < RQ0; ++rq0) {
        for (int e = tid; e < 64 * 68; e += NTHREADS) Tm[e] = 0.f;
        if (w == 0) {
            const float b = bf2f(gb_c), a = bf2f(ga_c);
            const float beta = sigmoidf_(b);
            const float xx = a + c.a->gdn_dt_bias[li * 8 + h];
            const float sp = fmaxf(xx, 0.f) + __logf(1.0f + __expf(-fabsf(xx)));
            float g = -__expf(c.a->gdn_a_log[li * 8 + h]) * sp;
#pragma unroll
            for (int o = 1; o < 64; o <<= 1) { const float v = __shfl_up(g, o); if (lane >= o) g += v; }
            const float gl = __shfl(g, 63);
            gate[lane] = beta; gate[64 + lane] = g; gate[128 + lane] = __expf(g); gate[192 + lane] = __expf(gl - g);
            if (lane == 0) ((float*)(ws + WS_GAM))[h * 256 + n] = __expf(gl);
        }
        __syncthreads();
        }
#pragma unroll 1
        for (int rq1 = 0; rq1 < RQ1; ++rq1)
#pragma unroll 1
        for (int sec = 0; sec < 3; ++sec) {
            int tid1 = tid; asm volatile("" : "+v"(tid1));
            const int cg = tid1 & 15, sA = tid1 >> 4;
            const int col = (sec == 0 ? GC_Q + (h >> 1) * 128 : sec == 1 ? GC_K + (h >> 1) * 128 : GC_V + h * 128) + cg * 8;
            u32x4 xr[2][4]; f32x4 cw[4][2];
#pragma unroll
            for (int it = 0; it < 2; ++it)
#pragma unroll
                for (int jj = 0; jj < 4; ++jj) { const int tt = t0 + sA + 32 * it - 3 + jj; const int tc = tt < 0 ? 0 : tt;
                    u32x4 xv = *(const u32x4*)(P + (size_t)tc * LDP + col); if (tt < 0) xv = (u32x4){0u, 0u, 0u, 0u}; xr[it][jj] = xv; }
#pragma unroll
            for (int jj = 0; jj < 4; ++jj) { cw[jj][0] = *(const f32x4*)(convw + jj * 2048 + col); cw[jj][1] = *(const f32x4*)(convw + jj * 2048 + col + 4); }
#pragma unroll
            for (int it = 0; it < 2; ++it) {
                const int s = sA + 32 * it;
                float acc[8];
#pragma unroll
                for (int e = 0; e < 8; ++e) acc[e] = 0.f;
#pragma unroll
                for (int jj = 0; jj < 4; ++jj) {
                    const u32x4 xv = xr[it][jj];
                    const f32x4 w0 = cw[jj][0], w1 = cw[jj][1];
                    acc[0] += w0[0] * bf_lo(xv.x); acc[1] += w0[1] * bf_hi(xv.x); acc[2] += w0[2] * bf_lo(xv.y); acc[3] += w0[3] * bf_hi(xv.y);
                    acc[4] += w1[0] * bf_lo(xv.z); acc[5] += w1[1] * bf_hi(xv.z); acc[6] += w1[2] * bf_lo(xv.w); acc[7] += w1[3] * bf_hi(xv.w);
                }
                float ss = 0.f;
#pragma unroll
                for (int e = 0; e < 8; ++e) { acc[e] = siluf_(acc[e]); ss += acc[e] * acc[e]; }
                const float beta = gate[s], eg = gate[128 + s], egl = gate[192 + s];
                if (sec < 2) {
                    ss = row_sum16(ss);
                    const float r = __builtin_amdgcn_rsqf(ss + RMS_EPS) * (sec == 0 ? 0.08838834764831845f : 1.0f);
#pragma unroll
                    for (int e = 0; e < 8; ++e) acc[e] *= r;
                    u32x4 wv; wv.x = pk2(acc[0], acc[1]); wv.y = pk2(acc[2], acc[3]); wv.z = pk2(acc[4], acc[5]); wv.w = pk2(acc[6], acc[7]);
                    *(LAS u32x4*)(L + (sec == 0 ? G2_QBF : G2_KBF) + s * 272 + cg * 16) = wv;
                    if (sec == 0) {
                        u32x2 lo, hi; lo.x = pk2(acc[0] * eg, acc[1] * eg); lo.y = pk2(acc[2] * eg, acc[3] * eg); hi.x = pk2(acc[4] * eg, acc[5] * eg); hi.y = pk2(acc[6] * eg, acc[7] * eg);
                        bf16_t* qg = (bf16_t*)(rec + REC_QG) + s * 128 + 16 * (cg >> 1) + 4 * (cg & 1);
                        *(u32x2*)qg = lo; *(u32x2*)(qg + 8) = hi;
                    } else {
                        const int ps = (s & ~15) | swap23(s & 15);
#pragma unroll
                        for (int e = 0; e < 8; ++e) {
                            *(LAS bf16_t*)(L + G2_RHST + (128 + cg * 8 + e) * 144 + (s ^ ((cg & 7) << 3)) * 2) = f2bf(acc[e] * beta * eg);
                            *(LAS bf16_t*)(L + G2_KDT + (cg * 8 + e) * 144 + (ps ^ ((cg & 7) << 3)) * 2) = f2bf(acc[e] * egl); }
                    }
                } else {
#pragma unroll
                    for (int e = 0; e < 8; ++e) *(LAS bf16_t*)(L + G2_RHST + (cg * 8 + e) * 144 + (s ^ ((cg & 7) << 3)) * 2) = f2bf(acc[e] * beta);
                }
            }
        }
        __syncthreads();
#pragma unroll 1
        for (int rq2 = 0; rq2 < RQ2; ++rq2)
        {   int lane2 = lane; asm volatile("" : "+v"(lane2));
            const int sel = w >> 2, i = w & 3, r = lane2 & 15, q = lane2 >> 4;
            bf16x8 af[4];
#pragma unroll
            for (int ks = 0; ks < 4; ++ks) af[ks] = *(const LAS bf16x8*)(L + (sel ? G2_QBF : G2_KBF) + (16 * i + r) * 272 + (32 * ks + 8 * q) * 2);
#pragma unroll
            for (int j = 0; j < 4; ++j) {
                f32x4 acc = {0.f, 0.f, 0.f, 0.f};
#pragma unroll
                for (int ks = 0; ks < 4; ++ks) { const bf16x8 bfr = *(const LAS bf16x8*)(L + G2_KBF + (16 * j + r) * 272 + (32 * ks + 8 * q) * 2); acc = MFMA16(af[ks], bfr, acc); }
                const int s = 16 * j + r; const float gs = gate[64 + s];
#pragma unroll
                for (int e = 0; e < 4; ++e) {
                    const int cc = 16 * i + 4 * q + e; const float dec = __expf(gate[64 + cc] - gs);
                    if (sel == 0) Mm[cc * 68 + s] = (s < cc) ? gate[cc] * acc[e] * dec : 0.f;
                    else { const int ps = (s & ~15) | swap23(s & 15); ((bf16_t*)(rec + REC_AQK))[cc * 64 + ps] = f2bf((s <= cc) ? acc[e] * dec : 0.f); }
                }
            }
        }
        __syncthreads();
#pragma unroll 1
        for (int rq3 = 0; rq3 < RQ3; ++rq3) { if (rq3) __syncthreads();
        if (w < 4 && lane < 16) {
            int lane3 = lane; asm volatile("" : "+v"(lane3));
            float mrow[16], tr[16];
#pragma unroll
            for (int i = 0; i < 16; ++i) mrow[i] = Mm[(16 * w + i) * 68 + 16 * w + lane3];
#pragma unroll
            for (int i = 0; i < 16; ++i) {
                float acc = (lane3 == i) ? 1.f : 0.f;
#pragma unroll
                for (int j = 0; j < i; ++j) acc -= __int_as_float(__builtin_amdgcn_readlane(__float_as_int(mrow[i]), j)) * tr[j];
                tr[i] = acc;
            }
#pragma unroll
            for (int i = 0; i < 16; ++i) Tm[(16 * w + i) * 68 + 16 * w + lane3] = tr[i];
        }
        __syncthreads();
#pragma unroll 1
        for (int d = 1; d < 4; ++d) {
            if (w < 4 - d) {
                int l3 = lane; asm volatile("" : "+v"(l3));
                const int J = w, I = w + d, r16 = l3 & 15, q4 = l3 >> 4;
                f32x4 x = {0.f, 0.f, 0.f, 0.f};
                for (int K = J; K < I; ++K)
#pragma unroll
                    for (int ks = 0; ks < 4; ++ks) x = __builtin_amdgcn_mfma_f32_16x16x4f32(Mm[(16 * I + r16) * 68 + 16 * K + 4 * ks + q4], Tm[(16 * K + 4 * ks + q4) * 68 + 16 * J + r16], x, 0, 0, 0);
                LAS float* Xw = Xs + w * (16 * 17);
#pragma unroll
                for (int e = 0; e < 4; ++e) Xw[(4 * q4 + e) * 17 + r16] = x[e];
                f32x4 t = {0.f, 0.f, 0.f, 0.f};
#pragma unroll
                for (int ks = 0; ks < 4; ++ks) t = __builtin_amdgcn_mfma_f32_16x16x4f32(Tm[(16 * I + r16) * 68 + 16 * I + 4 * ks + q4], Xw[(4 * ks + q4) * 17 + r16], t, 0, 0, 0);
#pragma unroll
                for (int e = 0; e < 4; ++e) Tm[(16 * I + 4 * q4 + e) * 68 + 16 * J + r16] = -t[e];
            }
            __syncthreads();
        }
        }
#pragma unroll 1
        for (int rq4 = 0; rq4 < RQ4; ++rq4)
        {   int lane4 = lane, tid4 = tid; asm volatile("" : "+v"(lane4), "+v"(tid4));
            const int r = lane4 & 15, q = lane4 >> 4;
            f32x4 acc[4][2];
#pragma unroll
            for (int i = 0; i < 4; ++i) { acc[i][0] = (f32x4){0.f, 0.f, 0.f, 0.f}; acc[i][1] = (f32x4){0.f, 0.f, 0.f, 0.f}; }
#pragma unroll
            for (int ks = 0; ks < 2; ++ks) {
                bf16x8 bfr[2];
#pragma unroll
                for (int jt = 0; jt < 2; ++jt) { const int nrow = 32 * w + 16 * jt + r; bfr[jt] = *(const LAS bf16x8*)(L + G2_RHST + nrow * 144 + (((4 * ks + q) ^ ((nrow >> 3) & 7)) * 16)); }
#pragma unroll
                for (int i = 0; i < 4; ++i) {
                    const LAS float* tp = Tm + (16 * i + r) * 68 + 32 * ks + 8 * q;
                    const f32x4 t0v = *(const LAS f32x4*)tp, t1v = *(const LAS f32x4*)(tp + 4);
                    const bf16x8 af = pack8(t0v[0], t0v[1], t0v[2], t0v[3], t1v[0], t1v[1], t1v[2], t1v[3]);
                    acc[i][0] = MFMA16(af, bfr[0], acc[i][0]); acc[i][1] = MFMA16(af, bfr[1], acc[i][1]);
                }
            }
#pragma unroll
            for (int jt = 0; jt < 2; ++jt) {
                const int nn = 32 * w + 16 * jt + r;
                if (w < 4) {
#pragma unroll
                    for (int i = 0; i < 4; ++i) {
                        u32x2 wv; wv.x = pk2(acc[i][jt][0], acc[i][jt][1]); wv.y = pk2(acc[i][jt][2], acc[i][jt][3]);
                        *(u32x2*)(rec + REC_U + (size_t)((((nn >> 5) * 2 + (i >> 1)) * 64 + (nn & 31) + 32 * (q & 1)) * 32 + (8 * (i & 1) + 4 * (q >> 1)) * 2)) = wv; }
                } else {
                    const int dk = nn - 128, pd = (dk & ~15) | swap23(dk & 15);
#pragma unroll
                    for (int i = 0; i < 4; ++i)
#pragma unroll
                        for (int e = 0; e < 4; ++e) ((bf16_t*)(rec + REC_W))[(16 * i + 4 * q + e) * 128 + pd] = f2bf(acc[i][jt][e]);
                }
            }
#pragma unroll
            for (int pz = 0; pz < 2; ++pz) { const int piece = tid4 + NTHREADS * pz, row = piece >> 3, seg = piece & 7;
                *(u32x4*)(rec + REC_KDT + row * 128 + seg * 16) = *(const LAS u32x4*)(L + G2_KDT + row * 144 + ((seg ^ ((row >> 3) & 7)) * 16)); }
        }
        __syncthreads();
    }
}
constexpr int MA_K = 0, MA_V = 65536;
DI void mem_attn_all(const Ctx& c, int layer, int qcol, int brank, int nblk) {
    if (nblk < 4) return;
    unsigned char* ws = c.a->ws;
    LAS unsigned char* L = c.lds;
    const bf16_t* P = (const bf16_t*)(ws + WS_P);
    unsigned char* MIX = ws + WS_MIX;
    const int lane = c.lane, w = c.wave, r = lane & 15, q = lane >> 4;
    const int hm = brank & 3, rank4 = brank >> 2, n4 = (nblk - hm + 3) >> 2;
    {
        const unsigned char* kg = (const unsigned char*)((const bf16_t*)(ws + WS_KM) + layer * 512 + hm * 128);
        const unsigned char* vg = (const unsigned char*)((const bf16_t*)(ws + WS_VMT) + (size_t)(layer * 512 + hm * 128) * NMEM);
#pragma unroll
        for (int i = 0; i < 8; ++i) {
            const int pc = w * 8 + i;
            {   const int row = pc * 4 + (lane >> 4), slot = lane & 15, gs = slot ^ (row & 15);
                __builtin_amdgcn_global_load_lds((const unsigned*)(kg + (size_t)row * 4096 + gs * 16), (LAS unsigned*)(L + MA_K + pc * 1024), 16, 0, 0); }
            {   const int row = pc * 2 + (lane >> 5), slot = lane & 31, gs = slot ^ (row & 15);
                __builtin_amdgcn_global_load_lds((const unsigned*)(vg + (size_t)row * 512 + gs * 16), (LAS unsigned*)(L + MA_V + pc * 1024), 16, 0, 0); }
        }
        asm volatile("s_waitcnt vmcnt(0)" ::: "memory");
        __syncthreads();
    }
    const float sc = 0.08838834764831845f * 1.44269504088896f;
    const int tile0 = rank4 * 8 + w;
    bf16x8 qn[4];
    if (tile0 < M_TOK / 16) {
#pragma unroll
        for (int ks = 0; ks < 4; ++ks) qn[ks] = *(const bf16x8*)(P + (size_t)(tile0 * 16 + r) * LDP + qcol + hm * 128 + 32 * ks + 8 * q); }
#define MA_LDK(F, KT) do { _Pragma("unroll") for (int ks = 0; ks < 4; ++ks) F[ks] = *(const LAS bf16x8*)(kbase + ((64 * ks) ^ xm) + 4096 * (KT)); } while (0)
#define MA_QK(F, KT) do { f32x4 acc_ = {0.f, 0.f, 0.f, 0.f}; _Pragma("unroll") for (int ks = 0; ks < 4; ++ks) acc_ = MFMA16(F[ks], qf[ks], acc_); st[KT] = acc_; } while (0)
#define MA_LDV(F, KK) do { const LAS unsigned char* v0_ = vbase0 + ((64 * (KK)) ^ xm); const LAS unsigned char* v1_ = vbase1 + ((64 * (KK)) ^ xm); \
            _Pragma("unroll") for (int dt = 0; dt < 8; ++dt) { const s16x4 lo_ = *(const LAS s16x4*)(v0_ + 8192 * dt), hi_ = *(const LAS s16x4*)(v1_ + 8192 * dt); \
            F[dt] = __builtin_shufflevector(lo_, hi_, 0, 1, 2, 3, 4, 5, 6, 7); } } while (0)
#define MA_PV(F, KK) do { const bf16x8 pb_ = pack8(st[2 * (KK)][0], st[2 * (KK)][1], st[2 * (KK)][2], st[2 * (KK)][3], st[2 * (KK) + 1][0], st[2 * (KK) + 1][1], st[2 * (KK) + 1][2], st[2 * (KK) + 1][3]); \
            _Pragma("unroll") for (int dt = 0; dt < 8; ++dt) ot[dt] = MFMA16(F[dt], pb_, ot[dt]); } while (0)
#pragma unroll 1
    for (int tile = tile0; tile < M_TOK / 16; tile += n4 * 8) {
        const int t0 = tile * 16;
        int lane_ = lane; asm volatile("" : "+v"(lane_));
        const int r_ = lane_ & 15, q_ = lane_ >> 4, xm = 64 * (r_ >> 2);
        const LAS unsigned char* kbase = L + MA_K + r_ * 256 + ((q_ ^ (r_ & 3)) * 16);
        const LAS unsigned char* vbase0 = L + MA_V + r_ * 512 + (q_ & 1) * 8 + (((q_ >> 1) ^ (r_ & 3)) * 16);
        const LAS unsigned char* vbase1 = L + MA_V + r_ * 512 + (q_ & 1) * 8 + (((2 + (q_ >> 1)) ^ (r_ & 3)) * 16);
        bf16x8 qf[4];
#pragma unroll
        for (int ks = 0; ks < 4; ++ks) qf[ks] = qn[ks];
        if (tile + n4 * 8 < M_TOK / 16) {
#pragma unroll
            for (int ks = 0; ks < 4; ++ks) qn[ks] = *(const bf16x8*)(P + (size_t)((tile + n4 * 8) * 16 + r) * LDP + qcol + hm * 128 + 32 * ks + 8 * q); }
        f32x4 st[16];
        {   bf16x8 ka[4], kb[4];
            MA_LDK(ka, 0);
#pragma unroll
            for (int kt = 0; kt < 16; kt += 2) {
                MA_LDK(kb, kt + 1); asm volatile("" ::: "memory");
                MA_QK(ka, kt);
                if (kt + 2 < 16) MA_LDK(ka, kt + 2);
                asm volatile("" ::: "memory");
                MA_QK(kb, kt + 1);
            } }
        float mx = -3.0e38f;
#pragma unroll
        for (int kt = 0; kt < 16; ++kt)
#pragma unroll
            for (int e = 0; e < 4; ++e) mx = fmaxf(mx, st[kt][e]);
        { auto r_ = __builtin_amdgcn_permlane16_swap(__float_as_uint(mx), __float_as_uint(mx), false, false); mx = fmaxf(__uint_as_float(r_[0]), __uint_as_float(r_[1])); }
        { auto r_ = __builtin_amdgcn_permlane32_swap(__float_as_uint(mx), __float_as_uint(mx), false, false); mx = fmaxf(__uint_as_float(r_[0]), __uint_as_float(r_[1])); }
        float sum = 0.f;
#pragma unroll
        for (int kt = 0; kt < 16; ++kt)
#pragma unroll
            for (int e = 0; e < 4; ++e) { const float p = __builtin_amdgcn_exp2f((st[kt][e] - mx) * sc); st[kt][e] = p; sum += p; }
        sum = swap32_sum(swap16_sum(sum, sum), swap16_sum(sum, sum));
        const float inv = __builtin_amdgcn_rcpf(sum);
        f32x4 ot[8];
#pragma unroll
        for (int dt = 0; dt < 8; ++dt) ot[dt] = (f32x4){0.f, 0.f, 0.f, 0.f};
        {   bf16x8 va[8], vb[8];
            MA_LDV(va, 0);
#pragma unroll
            for (int kk = 0; kk < 8; kk += 2) {
                MA_LDV(vb, kk + 1); asm volatile("" ::: "memory");
                MA_PV(va, kk);
                if (kk + 2 < 8) MA_LDV(va, kk + 2);
                asm volatile("" ::: "memory");
                MA_PV(vb, kk + 1);
            } }
#pragma unroll
        for (int dt = 0; dt < 8; ++dt) {
            *(unsigned*)(MIX + (size_t)(t0 + r) * MIXW + 1024 + hm * 128 + 16 * dt + 4 * q) = pk4_f8(ot[dt][0] * inv, ot[dt][1] * inv, ot[dt][2] * inv, ot[dt][3] * inv, F8_ACT); }
    }
    __syncthreads();
}

DI bf16x8 packS(const f32x16& x, int s) { return pack8(x[8 * s], x[8 * s + 1], x[8 * s + 2], x[8 * s + 3], x[8 * s + 4], x[8 * s + 5], x[8 * s + 6], x[8 * s + 7]); }
DI void scan_dma(LAS unsigned char* buf, const unsigned char* rec, int w8, int lane, bool full) {
    asm volatile("" : "+s"(rec));
    const unsigned vA = (unsigned)((lane >> 4) * 256 + (((lane & 15) ^ (((w8 & 3) * 4 + (lane >> 4)) & 15)) * 16));
    const unsigned vB = (unsigned)((lane >> 3) * 128 + (((lane & 7) ^ (((lane >> 4) + 4 * (w8 & 1)) & 7)) * 16));
    const unsigned vC = (unsigned)(lane * 16);
#pragma unroll
    for (int i = 0; i < 9; ++i) {
        const int qq = w8 + 8 * i;
        if (!full && (i == 2 || i == 3 || i == 6)) continue;
        const unsigned char* gp = rec + qq * 1024;
        const unsigned vo = (i < 4) ? vA : (i < 7) ? vB : vC;
        __builtin_amdgcn_global_load_lds((const unsigned*)(gp + vo), (LAS unsigned*)(buf + qq * 1024), 16, 0, 0);
    }
}
template <int G_> DI void scan_ld(const LAS unsigned char* buf, int r, int hh, bf16x8 (&f)[4]) {
    asm volatile("" : "+v"(r), "+v"(hh));
    if constexpr (G_ < 4) {
#pragma unroll
        for (int rho = 0; rho < 2; ++rho)
#pragma unroll
            for (int s = 0; s < 2; ++s) { const int cr = 32 * rho + r, p = (4 * G_ + 2 * s + hh) ^ (cr & 15); f[rho * 2 + s] = *(const LAS bf16x8*)(buf + REC_W + cr * 256 + p * 16); } }
    else if constexpr (G_ < 10 && ((G_ - 4) % 3) < 2) { constexpr int rho = (G_ - 4) / 3, i0 = 2 * ((G_ - 4) % 3); const int cr = 32 * rho + r;
#pragma unroll
        for (int ii = 0; ii < 2; ++ii)
#pragma unroll
            for (int s = 0; s < 2; ++s) { const int p = (4 * (i0 + ii) + 2 * s + hh) ^ (cr & 15); f[ii * 2 + s] = *(const LAS bf16x8*)(buf + REC_QG + cr * 256 + p * 16); } }
    else { constexpr int row0 = (G_ < 10) ? 32 * ((G_ - 4) / 3) : 32 * (G_ - 10); constexpr int base = (G_ < 10) ? REC_AQK : REC_KDT; const int rr = row0 + r;
#pragma unroll
        for (int ts = 0; ts < 4; ++ts) { const int p = (2 * ts + hh) ^ ((rr >> 1) & 7); f[ts] = *(const LAS bf16x8*)(buf + base + rr * 128 + p * 16); } }
}
#define SCAN_END() asm volatile("" ::: "memory")
#define SCAN_VNEW(Y, uu, HAVE_U) do { _Pragma("unroll") for (int rho = 0; rho < 2; ++rho) { const u32x4 u0 = uu[rho][0], u1 = uu[rho][1]; \
        if (HAVE_U) { \
            Y[rho][0] = bf_lo(u0.x) - Y[rho][0]; Y[rho][1] = bf_hi(u0.x) - Y[rho][1]; Y[rho][2] = bf_lo(u0.y) - Y[rho][2]; Y[rho][3] = bf_hi(u0.y) - Y[rho][3]; \
            Y[rho][4] = bf_lo(u0.z) - Y[rho][4]; Y[rho][5] = bf_hi(u0.z) - Y[rho][5]; Y[rho][6] = bf_lo(u0.w) - Y[rho][6]; Y[rho][7] = bf_hi(u0.w) - Y[rho][7]; \
            Y[rho][8] = bf_lo(u1.x) - Y[rho][8]; Y[rho][9] = bf_hi(u1.x) - Y[rho][9]; Y[rho][10] = bf_lo(u1.y) - Y[rho][10]; Y[rho][11] = bf_hi(u1.y) - Y[rho][11]; \
            Y[rho][12] = bf_lo(u1.z) - Y[rho][12]; Y[rho][13] = bf_hi(u1.z) - Y[rho][13]; Y[rho][14] = bf_lo(u1.w) - Y[rho][14]; Y[rho][15] = bf_hi(u1.w) - Y[rho][15]; \
        } else { _Pragma("unroll") for (int e = 0; e < 16; ++e) Y[rho][e] = -Y[rho][e]; } \
        Vb[rho][0] = packS(Y[rho], 0); Vb[rho][1] = packS(Y[rho], 1); } } while (0)
#define SCAN_Y(g, gn) do { scan_ld<gn>(buf, r, hh, fr[((g) + 1) & 1]); const bf16x8 sb0 = packS(S[g], 0), sb1 = packS(S[g], 1); \
        Y[0] = MFMA32(fr[(g) & 1][0], sb0, Y[0]); Y[1] = MFMA32(fr[(g) & 1][2], sb0, Y[1]); Y[0] = MFMA32(fr[(g) & 1][1], sb1, Y[0]); Y[1] = MFMA32(fr[(g) & 1][3], sb1, Y[1]); SCAN_END(); } while (0)

constexpr int SCAN_G = 8, SCAN_NG = 256 / SCAN_G;
DI void scan_pass_a(const Ctx& c, int unit) {
    unsigned char* ws = c.a->ws;
    LAS unsigned char* L = c.lds;
    const int lane = c.lane, w = c.wave, r = lane & 31, hh = lane >> 5;
    const int head = unit / SCAN_NG, g = unit % SCAN_NG, n0 = g * SCAN_G;
    const unsigned char* recs = ws + WS_REC + (size_t)(head * 256 + n0) * REC_BYTES;
    const float* gam = (const float*)(ws + WS_GAM) + head * 256 + n0;
    const bool phi = w < 4; const int usl = w & 3;
    f32x16 S[4];
#pragma unroll
    for (int i = 0; i < 4; ++i)
#pragma unroll
        for (int e = 0; e < 16; ++e) S[i][e] = (phi && w == i && ((e & 3) + 8 * (e >> 2) + 4 * hh) == r) ? 1.f : 0.f;
    scan_dma(L, recs, w, lane, false);
    asm volatile("s_waitcnt vmcnt(0)" ::: "memory");
    __syncthreads();
#pragma unroll 1
    for (int n = 0; n < SCAN_G; ++n) {
        LAS unsigned char* buf = L + (n & 1) * REC_BYTES;
        if (n + 1 < SCAN_G) scan_dma(L + ((n + 1) & 1) * REC_BYTES, recs + (size_t)(n + 1) * REC_BYTES, w, lane, false);
        const float gamma = gam[n];
        bf16x8 fr[2][4];
        scan_ld<0>(buf, r, hh, fr[0]);
        bf16x8 Vb[2][2];
        {   f32x16 Y[2];
#pragma unroll
            for (int e = 0; e < 16; ++e) { Y[0][e] = 0.f; Y[1][e] = 0.f; }
            SCAN_Y(0, 1); SCAN_Y(1, 2); SCAN_Y(2, 3); SCAN_Y(3, 10);
            u32x4 uu[2][2];
#pragma unroll
            for (int rho = 0; rho < 2; ++rho) { const LAS u32x4* up = (const LAS u32x4*)(buf + REC_U + ((usl * 2 + rho) * 64 + lane) * 32); uu[rho][0] = up[0]; uu[rho][1] = up[1]; }
            if (phi) SCAN_VNEW(Y, uu, false); else SCAN_VNEW(Y, uu, true);
        }
#define SCAN_S(g, gn, i, HAS_NEXT) do { if (HAS_NEXT) scan_ld<gn>(buf, r, hh, fr[((g) + 1) & 1]); _Pragma("unroll") for (int e = 0; e < 16; ++e) S[i][e] *= gamma; \
            S[i] = MFMA32(fr[(g) & 1][0], Vb[0][0], S[i]); S[i] = MFMA32(fr[(g) & 1][1], Vb[0][1], S[i]); S[i] = MFMA32(fr[(g) & 1][2], Vb[1][0], S[i]); S[i] = MFMA32(fr[(g) & 1][3], Vb[1][1], S[i]); SCAN_END(); } while (0)
        SCAN_S(4, 11, 0, true); SCAN_S(5, 12, 1, true); SCAN_S(6, 13, 2, true); SCAN_S(7, 13, 3, false);
#undef SCAN_S
        asm volatile("s_waitcnt vmcnt(0)" ::: "memory");
        __syncthreads();
    }
    if (phi) {
        const int cin = 32 * w + r, pc = (cin & ~15) | swap23(cin & 15);
        bf16_t* ph = (bf16_t*)(ws + WS_PHI) + (size_t)unit * 128 * 128 + (4 * hh) * 128 + pc;
#pragma unroll
        for (int i = 0; i < 4; ++i) {
#pragma unroll
            for (int e = 0; e < 16; ++e) ph[((e & 3) + 8 * (e >> 2)) * 128] = f2bf(S[i][e]);
            ph += 32 * 128; asm volatile("" : "+v"(ph)); }
    } else {
        bf16_t* sl = (bf16_t*)(ws + WS_SLOC) + ((size_t)(unit * 4 + usl) * 4 * 64 + lane) * 16;
#pragma unroll
        for (int i = 0; i < 4; ++i) { u32x4* op = (u32x4*)(sl + (size_t)i * 64 * 16);
            u32x4 a, b; a.x = pk2(S[i][0], S[i][1]); a.y = pk2(S[i][2], S[i][3]); a.z = pk2(S[i][4], S[i][5]); a.w = pk2(S[i][6], S[i][7]);
            b.x = pk2(S[i][8], S[i][9]); b.y = pk2(S[i][10], S[i][11]); b.z = pk2(S[i][12], S[i][13]); b.w = pk2(S[i][14], S[i][15]);
            op[0] = a; op[1] = b; }
    }
}

constexpr int PB_XCH = 98304;
DI void scan_pass_b(const Ctx& c, int head) {
    unsigned char* ws = c.a->ws;
    LAS unsigned char* L = c.lds;
    const int lane = c.lane, w = c.wave, r = lane & 31, hh = lane >> 5, j = w & 3, rh = w >> 2;
    const unsigned char* phis = ws + WS_PHI + (size_t)head * SCAN_NG * 32768;
    const unsigned vA = (unsigned)((lane >> 4) * 256 + (((lane & 15) ^ (((w & 3) * 4 + (lane >> 4)) & 15)) * 16));
#define PB_DMA(gg) do { const unsigned char* pp_ = phis + (size_t)(gg) * 32768; asm volatile("" : "+s"(pp_)); LAS unsigned char* sl_ = L + ((gg) % 3) * 32768; \
        _Pragma("unroll") for (int i = 0; i < 4; ++i) { const int qq = w + 8 * i; __builtin_amdgcn_global_load_lds((const unsigned*)(pp_ + qq * 1024 + vA), (LAS unsigned*)(sl_ + qq * 1024), 16, 0, 0); } } while (0)
    constexpr size_t GSTR = (size_t)4 * 4 * 64 * 16;
    const size_t tb = ((size_t)((head * SCAN_NG) * 4 + j) * 4 + 2 * rh) * 64 * 16 + (size_t)lane * 16;
    const bf16_t* slb = (const bf16_t*)(ws + WS_SLOC) + tb;
    bf16_t* sib = (bf16_t*)(ws + WS_SIN) + tb;
    LAS bf16x8* xch = (LAS bf16x8*)(L + PB_XCH);
    u32x4 N[2][2];
#pragma unroll
    for (int t = 0; t < 2; ++t) { const u32x4* ip = (const u32x4*)(slb + (size_t)t * 1024); N[t][0] = ip[0]; N[t][1] = ip[1]; }
    {   bf16x8 z;
#pragma unroll
        for (int e = 0; e < 8; ++e) z[e] = 0;
#pragma unroll
        for (int t = 0; t < 2; ++t) { xch[((j * 4 + 2 * rh + t) * 2 + 0) * 64 + lane] = z; xch[((j * 4 + 2 * rh + t) * 2 + 1) * 64 + lane] = z;
            bf16x8* op = (bf16x8*)(sib + (size_t)t * 1024); op[0] = z; op[1] = z; } }
    asm volatile("" ::: "memory");
    PB_DMA(0); PB_DMA(1);
#pragma unroll 1
    for (int g = 0; g < SCAN_NG; ++g) {
        asm volatile("s_waitcnt vmcnt(4)" ::: "memory");
        __syncthreads();
        bf16x8 Sb[4][2];
#pragma unroll
        for (int i = 0; i < 4; ++i) { Sb[i][0] = xch[((j * 4 + i) * 2 + 0) * 64 + lane]; Sb[i][1] = xch[((j * 4 + i) * 2 + 1) * 64 + lane]; }
        asm volatile("s_waitcnt lgkmcnt(0)" ::: "memory");
        __syncthreads();
        const LAS unsigned char* slot = L + (g % 3) * 32768;
        f32x16 A2[2];
#pragma unroll
        for (int t = 0; t < 2; ++t) {
            const u32x4 n0 = N[t][0], n1 = N[t][1];
            A2[t][0] = bf_lo(n0.x); A2[t][1] = bf_hi(n0.x); A2[t][2] = bf_lo(n0.y); A2[t][3] = bf_hi(n0.y); A2[t][4] = bf_lo(n0.z); A2[t][5] = bf_hi(n0.z); A2[t][6] = bf_lo(n0.w); A2[t][7] = bf_hi(n0.w);
            A2[t][8] = bf_lo(n1.x); A2[t][9] = bf_hi(n1.x); A2[t][10] = bf_lo(n1.y); A2[t][11] = bf_hi(n1.y); A2[t][12] = bf_lo(n1.z); A2[t][13] = bf_hi(n1.z); A2[t][14] = bf_lo(n1.w); A2[t][15] = bf_hi(n1.w);
            const u32x4* ip = (const u32x4*)(slb + (size_t)(g + 1) * GSTR + (size_t)t * 1024); N[t][0] = ip[0]; N[t][1] = ip[1]; }
#pragma unroll
        for (int t = 0; t < 2; ++t) {
            const int row = 32 * (2 * rh + t) + r;
#pragma unroll
            for (int half = 0; half < 2; ++half) {
                bf16x8 fr[4]; int row_ = row, hh_ = hh; asm volatile("" : "+v"(row_), "+v"(hh_));
#pragma unroll
                for (int q4 = 0; q4 < 4; ++q4) { const int p = (4 * (2 * half + (q4 >> 1)) + 2 * (q4 & 1) + hh_) ^ (row_ & 15); fr[q4] = *(const LAS bf16x8*)(slot + row_ * 256 + p * 16); }
                A2[t] = MFMA32(fr[0], Sb[2 * half][0], A2[t]); A2[t] = MFMA32(fr[1], Sb[2 * half][1], A2[t]); A2[t] = MFMA32(fr[2], Sb[2 * half + 1][0], A2[t]); A2[t] = MFMA32(fr[3], Sb[2 * half + 1][1], A2[t]);
            }
            const bf16x8 p0 = packS(A2[t], 0), p1 = packS(A2[t], 1);
            xch[((j * 4 + 2 * rh + t) * 2 + 0) * 64 + lane] = p0; xch[((j * 4 + 2 * rh + t) * 2 + 1) * 64 + lane] = p1;
            if (g + 1 < SCAN_NG) { bf16x8* op = (bf16x8*)(sib + (size_t)(g + 1) * GSTR + (size_t)t * 1024); op[0] = p0; op[1] = p1; }
        }
        asm volatile("" ::: "memory");
        if (g + 2 < SCAN_NG) PB_DMA(g + 2);
    }
#undef PB_DMA
    asm volatile("s_waitcnt vmcnt(0)" ::: "memory");
    __syncthreads();
}

DI void scan_pass_c(const Ctx& c, int unit) {
    unsigned char* ws = c.a->ws;
    LAS unsigned char* L = c.lds;
    const int lane = c.lane, w = c.wave, r = lane & 31, hh = lane >> 5;
    const int head = unit / SCAN_NG, g = unit % SCAN_NG, n0 = g * SCAN_G;
    const unsigned char* recs = ws + WS_REC + (size_t)(head * 256 + n0) * REC_BYTES;
    const float* gam = (const float*)(ws + WS_GAM) + head * 256 + n0;
    bf16_t* OB = (bf16_t*)(ws + WS_OG);
    f32x16 S[4];
    if (w < 4) {
        const bf16_t* sib = (const bf16_t*)(ws + WS_SIN) + ((size_t)(unit * 4 + w) * 4 * 64 + lane) * 16;
#pragma unroll
        for (int i = 0; i < 4; ++i) { const u32x4* ip = (const u32x4*)(sib + (size_t)i * 1024); const u32x4 n0 = ip[0], n1 = ip[1];
            S[i][0] = bf_lo(n0.x); S[i][1] = bf_hi(n0.x); S[i][2] = bf_lo(n0.y); S[i][3] = bf_hi(n0.y); S[i][4] = bf_lo(n0.z); S[i][5] = bf_hi(n0.z); S[i][6] = bf_lo(n0.w); S[i][7] = bf_hi(n0.w);
            S[i][8] = bf_lo(n1.x); S[i][9] = bf_hi(n1.x); S[i][10] = bf_lo(n1.y); S[i][11] = bf_hi(n1.y); S[i][12] = bf_lo(n1.z); S[i][13] = bf_hi(n1.z); S[i][14] = bf_lo(n1.w); S[i][15] = bf_hi(n1.w); }
    }
    scan_dma(L, recs, w, lane, true);
    asm volatile("s_waitcnt vmcnt(0)" ::: "memory");
    __syncthreads();
#pragma unroll 1
    for (int n = 0; n < SCAN_G; ++n) {
        LAS unsigned char* buf = L + (n & 1) * REC_BYTES;
        if (n + 1 < SCAN_G) scan_dma(L + ((n + 1) & 1) * REC_BYTES, recs + (size_t)(n + 1) * REC_BYTES, w, lane, true);
        if (w < 4) {
            const float gamma = gam[n];
            u32x4 uu[2][2];
#pragma unroll
            for (int rho = 0; rho < 2; ++rho) { const LAS u32x4* up = (const LAS u32x4*)(buf + REC_U + ((w * 2 + rho) * 64 + lane) * 32); uu[rho][0] = up[0]; uu[rho][1] = up[1]; }
            bf16x8 fr[2][4];
            scan_ld<0>(buf, r, hh, fr[0]);
#define SCAN_NEXT(g) do { if ((g) + 1 < 14) scan_ld<(g) + 1>(buf, r, hh, fr[((g) + 1) & 1]); } while (0)
            bf16x8 Vb[2][2];
            {   f32x16 Y[2];
#pragma unroll
                for (int e = 0; e < 16; ++e) { Y[0][e] = 0.f; Y[1][e] = 0.f; }
                SCAN_Y(0, 1); SCAN_Y(1, 2); SCAN_Y(2, 3); SCAN_Y(3, 4);
                SCAN_VNEW(Y, uu, true);
            }
#define SCAN_Z(g0, rho) do { f32x16 Z; _Pragma("unroll") for (int e = 0; e < 16; ++e) Z[e] = 0.f; \
                SCAN_NEXT(g0); { const bf16x8 a0 = packS(S[0], 0), a1 = packS(S[0], 1), a2 = packS(S[1], 0), a3 = packS(S[1], 1); \
                    Z = MFMA32(fr[(g0) & 1][0], a0, Z); Z = MFMA32(fr[(g0) & 1][1], a1, Z); Z = MFMA32(fr[(g0) & 1][2], a2, Z); Z = MFMA32(fr[(g0) & 1][3], a3, Z); } SCAN_END(); \
                SCAN_NEXT((g0) + 1); { const bf16x8 a0 = packS(S[2], 0), a1 = packS(S[2], 1), a2 = packS(S[3], 0), a3 = packS(S[3], 1); \
                    Z = MFMA32(fr[((g0) + 1) & 1][0], a0, Z); Z = MFMA32(fr[((g0) + 1) & 1][1], a1, Z); Z = MFMA32(fr[((g0) + 1) & 1][2], a2, Z); Z = MFMA32(fr[((g0) + 1) & 1][3], a3, Z); } SCAN_END(); \
                SCAN_NEXT((g0) + 2); Z = MFMA32(fr[((g0) + 2) & 1][0], Vb[0][0], Z); Z = MFMA32(fr[((g0) + 2) & 1][1], Vb[0][1], Z); Z = MFMA32(fr[((g0) + 2) & 1][2], Vb[1][0], Z); Z = MFMA32(fr[((g0) + 2) & 1][3], Vb[1][1], Z); \
                { bf16_t* op = OB + (size_t)((n0 + n) * 64 + 32 * (rho) + 4 * hh) * 1024 + head * 128 + 32 * w + r; \
                  _Pragma("unroll") for (int e = 0; e < 16; ++e) op[((e & 3) + 8 * (e >> 2)) * 1024] = f2bf(Z[e]); } SCAN_END(); } while (0)
            SCAN_Z(4, 0); SCAN_Z(7, 1);
#undef SCAN_Z
#define SCAN_S(g, i) do { SCAN_NEXT(g); _Pragma("unroll") for (int e = 0; e < 16; ++e) S[i][e] *= gamma; \
                S[i] = MFMA32(fr[(g) & 1][0], Vb[0][0], S[i]); S[i] = MFMA32(fr[(g) & 1][1], Vb[0][1], S[i]); S[i] = MFMA32(fr[(g) & 1][2], Vb[1][0], S[i]); S[i] = MFMA32(fr[(g) & 1][3], Vb[1][1], S[i]); SCAN_END(); } while (0)
            SCAN_S(10, 0); SCAN_S(11, 1); SCAN_S(12, 2); SCAN_S(13, 3);
#undef SCAN_S
#undef SCAN_NEXT
        }
        asm volatile("s_waitcnt vmcnt(0)" ::: "memory");
        __syncthreads();
    }
}
#undef SCAN_Y
#undef SCAN_VNEW
#undef SCAN_END
DI void phase_gdn_out(const Ctx& c, int li) {
    unsigned char* ws = c.a->ws;
    const bf16_t* OB = (const bf16_t*)(ws + WS_OG); const bf16_t* P = (const bf16_t*)(ws + WS_P); unsigned char* MIX = ws + WS_MIX;
    const float* gn = c.a->gdn_onorm + li * 128;
    const int cg = c.tid & 15;
    const f32x4 g0 = *(const f32x4*)(gn + cg * 8), g1 = *(const f32x4*)(gn + cg * 8 + 4);
    for (int it0 = c.bid * 32 + (c.tid >> 4); it0 < M_TOK * 8; it0 += c.G * 32 * 4) {
        u32x4 ov4[4], zv4[4];
#pragma unroll
        for (int u = 0; u < 4; ++u) { const int it = it0 + u * c.G * 32; if (it < M_TOK * 8) { const int t = it >> 3, h = it & 7;
            ov4[u] = *(const u32x4*)(OB + (size_t)t * 1024 + h * 128 + cg * 8); zv4[u] = *(const u32x4*)(P + (size_t)t * LDP + GC_Z + h * 128 + cg * 8); } }
        asm volatile("" ::: "memory");
#pragma unroll
        for (int u = 0; u < 4; ++u) { const int it = it0 + u * c.G * 32; if (it < M_TOK * 8) { const int t = it >> 3, h = it & 7;
            const u32x4 ov = ov4[u], zv = zv4[u];
            const float o[8] = {bf_lo(ov.x), bf_hi(ov.x), bf_lo(ov.y), bf_hi(ov.y), bf_lo(ov.z), bf_hi(ov.z), bf_lo(ov.w), bf_hi(ov.w)};
            float ss = 0.f;
#pragma unroll
            for (int e = 0; e < 8; ++e) ss += o[e] * o[e];
            ss = row_sum16(ss);
            const float rr = __builtin_amdgcn_rsqf(ss * (1.0f / 128.0f) + RMS_EPS);
            u32x2 wv;
            wv.x = pk4_f8(o[0] * rr * g0[0] * siluf_(bf_lo(zv.x)), o[1] * rr * g0[1] * siluf_(bf_hi(zv.x)), o[2] * rr * g0[2] * siluf_(bf_lo(zv.y)), o[3] * rr * g0[3] * siluf_(bf_hi(zv.y)), F8_ACT);
            wv.y = pk4_f8(o[4] * rr * g1[0] * siluf_(bf_lo(zv.z)), o[5] * rr * g1[1] * siluf_(bf_hi(zv.z)), o[6] * rr * g1[2] * siluf_(bf_lo(zv.w)), o[7] * rr * g1[3] * siluf_(bf_hi(zv.w)), F8_ACT);
            *(u32x2*)(MIX + (size_t)t * MIXW + h * 128 + cg * 8) = wv; } }
    }
}

DI void ln_row(const float (&v)[32], const float* g, const float* b, float* dstf, bf16_t* dstb, int lane) {
    float s = 0.f;
#pragma unroll
    for (int i = 0; i < 32; ++i) s += v[i];
    const float mu = wave_sum(s) * (1.0f / 2048.0f);
    float qv = 0.f;
#pragma unroll
    for (int i = 0; i < 32; ++i) { const float d = v[i] - mu; qv += d * d; }
    const float rstd = __builtin_amdgcn_rsqf(wave_sum(qv) * (1.0f / 2048.0f) + LN_EPS);
#pragma unroll
    for (int i = 0; i < 4; ++i) {
        const int e0 = 512 * i + 8 * lane;
        const f32x4 ga = *(const f32x4*)(g + e0), gb = *(const f32x4*)(g + e0 + 4), ba = *(const f32x4*)(b + e0), bb = *(const f32x4*)(b + e0 + 4);
        f32x4 ya, yb;
#pragma unroll
        for (int j = 0; j < 4; ++j) { ya[j] = (v[8 * i + j] - mu) * rstd * ga[j] + ba[j]; yb[j] = (v[8 * i + 4 + j] - mu) * rstd * gb[j] + bb[j]; }
        *(f32x4*)(dstf + e0) = ya; *(f32x4*)(dstf + e0 + 4) = yb;
        if (dstb) { u32x4 wv; wv.x = pk2(ya[0], ya[1]); wv.y = pk2(ya[2], ya[3]); wv.z = pk2(yb[0], yb[1]); wv.w = pk2(yb[2], yb[3]); *(u32x4*)(dstb + e0) = wv; }
    }
}
template <class GP> DI void ln_row16(const float (&v)[32], GP g, GP b, float* dstf, bf16_t* dstb, unsigned char* dst8, int lane) {
    float s = 0.f;
#pragma unroll
    for (int i = 0; i < 32; ++i) s += v[i];
    const float mu = wave_sum(s) * (1.0f / 2048.0f);
    float qv = 0.f;
#pragma unroll
    for (int i = 0; i < 32; ++i) { const float d = v[i] - mu; qv += d * d; }
    const float rstd = __builtin_amdgcn_rsqf(wave_sum(qv) * (1.0f / 2048.0f) + LN_EPS);
#pragma unroll
    for (int j = 0; j < 8; ++j) {
        const int e0 = 256 * j + 4 * lane;
        const f32x4 ga = *(const f32x4 __attribute__((address_space(3)))*)(g + e0), ba = *(const f32x4 __attribute__((address_space(3)))*)(b + e0);
        f32x4 ya;
#pragma unroll
        for (int e = 0; e < 4; ++e) ya[e] = (v[4 * j + e] - mu) * rstd * ga[e] + ba[e];
        if (dstf) *(f32x4*)(dstf + e0) = ya;
        u32x2 wv; wv.x = pk2(ya[0], ya[1]); wv.y = pk2(ya[2], ya[3]); *(u32x2*)(dstb + e0) = wv;
        *(unsigned*)(dst8 + e0) = pk4_f8(ya[0], ya[1], ya[2], ya[3], F8_ACT);
    }
}
DI void phase_ln(const Ctx& c, const bf16_t* src, const float* g, const float* b, float* stats, bf16_t* dstb) {
    LAS float* pg = (LAS float*)c.lds; LAS float* pb = pg + DM;
    for (int e = c.tid * 4; e < DM; e += NTHREADS * 4) { *(LAS f32x4*)(pg + e) = *(const f32x4*)(g + e); *(LAS f32x4*)(pb + e) = *(const f32x4*)(b + e); }
    __syncthreads();
    for (int row = c.bid * 8 + c.wave; row < M_TOK; row += c.G * 8) {
        float v[32];
        const bf16_t* sp = src + (size_t)row * DM;
#pragma unroll
        for (int i = 0; i < 4; ++i) { const u32x4 a = *(const u32x4*)(sp + 512 * i + 8 * c.lane);
            v[8 * i] = bf_lo(a.x); v[8 * i + 1] = bf_hi(a.x); v[8 * i + 2] = bf_lo(a.y); v[8 * i + 3] = bf_hi(a.y); v[8 * i + 4] = bf_lo(a.z); v[8 * i + 5] = bf_hi(a.z); v[8 * i + 6] = bf_lo(a.w); v[8 * i + 7] = bf_hi(a.w); }
        float s = 0.f;
#pragma unroll
        for (int i = 0; i < 32; ++i) s += v[i];
        const float mu = wave_sum(s) * (1.0f / 2048.0f);
        float qv = 0.f;
#pragma unroll
        for (int i = 0; i < 32; ++i) { const float d = v[i] - mu; qv += d * d; }
        const float rstd = __builtin_amdgcn_rsqf(wave_sum(qv) * (1.0f / 2048.0f) + LN_EPS);
        if (c.lane == 0) { f32x2 st = {mu, rstd}; *(f32x2*)(stats + 2 * (size_t)row) = st; }
        bf16_t* db = dstb + (size_t)row * DM;
#pragma unroll
        for (int i = 0; i < 4; ++i) {
            const int e0 = 512 * i + 8 * c.lane;
            const f32x4 ga = *(const LAS f32x4*)(pg + e0), gb = *(const LAS f32x4*)(pg + e0 + 4), ba = *(const LAS f32x4*)(pb + e0), bb = *(const LAS f32x4*)(pb + e0 + 4);
            float y[8];
#pragma unroll
            for (int j = 0; j < 4; ++j) { y[j] = (v[8 * i + j] - mu) * rstd * ga[j] + ba[j]; y[4 + j] = (v[8 * i + 4 + j] - mu) * rstd * gb[j] + bb[j]; }
            u32x4 wv; wv.x = pk2(y[0], y[1]); wv.y = pk2(y[2], y[3]); wv.z = pk2(y[4], y[5]); wv.w = pk2(y[6], y[7]); *(u32x4*)(db + e0) = wv;
        }
    }
}

constexpr int SBA_K = 0, SBA_V = 65536;
DI void sb_attn_block(const Ctx& c, int task) {
    unsigned char* ws = c.a->ws;
    LAS unsigned char* L = c.lds;
    const bf16_t* P = (const bf16_t*)(ws + WS_P); const bf16_t* VT = (const bf16_t*)(ws + WS_VT); unsigned char* MIX = ws + WS_MIX;
    const int lane = c.lane, w = c.wave, r = lane & 15, q = lane >> 4;
    const int h = task & 7, q0 = (task >> 3) * 128, win_lo = q0 >= 128 ? q0 - 128 : 0;
    {
        const unsigned char* kg = (const unsigned char*)(P + (size_t)win_lo * LDP + SC_K + h * 128);
        const unsigned char* vg = (const unsigned char*)(VT + (size_t)(h * 128) * M_TOK + win_lo);
#pragma unroll
        for (int i = 0; i < 8; ++i) {
            const int pc = w * 8 + i;
            {   const int row = pc * 4 + (lane >> 4), slot = lane & 15, gs = slot ^ (row & 15);
                __builtin_amdgcn_global_load_lds((const unsigned*)(kg + (size_t)row * (LDP * 2) + gs * 16), (LAS unsigned*)(L + SBA_K + pc * 1024), 16, 0, 0); }
            {   const int row = pc * 2 + (lane >> 5), slot = lane & 31, gs = slot ^ (row & 15);
                __builtin_amdgcn_global_load_lds((const unsigned*)(vg + (size_t)row * (M_TOK * 2) + gs * 16), (LAS unsigned*)(L + SBA_V + pc * 1024), 16, 0, 0); }
        }
        asm volatile("s_waitcnt vmcnt(0)" ::: "memory");
        __syncthreads();
    }
    const int t0 = q0 + 16 * w, tq = t0 + r;
    bf16x8 qf[4];
#pragma unroll
    for (int ks = 0; ks < 4; ++ks) qf[ks] = *(const bf16x8*)(P + (size_t)tq * LDP + SC_Q + h * 128 + 32 * ks + 8 * q);
    f32x4 ot[8];
#pragma unroll
    for (int dt = 0; dt < 8; ++dt) ot[dt] = (f32x4){0.f, 0.f, 0.f, 0.f};
    float R = 0.f;
    const float sc = 0.08838834764831845f * 1.44269504088896f;
#pragma unroll 1
    for (int kb = (t0 + 15) >> 5; kb >= 0; --kb) {
        const int k0 = kb * 32;
        bf16x8 kf[2][4], vf[8];
        if (k0 >= win_lo) {
            const int kr = k0 - win_lo;
#pragma unroll
            for (int tl = 0; tl < 2; ++tl) { const int row = kr + 16 * tl + r;
#pragma unroll
                for (int ks = 0; ks < 4; ++ks) kf[tl][ks] = *(const LAS bf16x8*)(L + SBA_K + row * 256 + (((4 * ks + q) ^ (row & 15)) * 16)); }
#pragma unroll
            for (int dt = 0; dt < 8; ++dt) { const int row = 16 * dt + r; const int g = (kr >> 3) + (q >> 1);
                const LAS unsigned char* vp = L + SBA_V + row * 512 + (q & 1) * 8;
                const s16x4 lo = *(const LAS s16x4*)(vp + ((g ^ (row & 15)) * 16)), hi = *(const LAS s16x4*)(vp + (((g + 2) ^ (row & 15)) * 16));
                vf[dt] = __builtin_shufflevector(lo, hi, 0, 1, 2, 3, 4, 5, 6, 7); }
        } else {
#pragma unroll
            for (int tl = 0; tl < 2; ++tl)
#pragma unroll
                for (int ks = 0; ks < 4; ++ks) kf[tl][ks] = *(const bf16x8*)(P + (size_t)(k0 + 16 * tl + r) * LDP + SC_K + h * 128 + 32 * ks + 8 * q);
#pragma unroll
            for (int dt = 0; dt < 8; ++dt) { const bf16_t* vp = VT + (size_t)(h * 128 + 16 * dt + r) * M_TOK + k0 + 4 * q;
                const s16x4 lo = *(const s16x4*)vp, hi = *(const s16x4*)(vp + 16);
                vf[dt] = __builtin_shufflevector(lo, hi, 0, 1, 2, 3, 4, 5, 6, 7); }
        }
        f32x4 z[2];
#pragma unroll
        for (int tl = 0; tl < 2; ++tl) {
            f32x4 acc = {0.f, 0.f, 0.f, 0.f};
#pragma unroll
            for (int ks = 0; ks < 4; ++ks) acc = MFMA16(kf[tl][ks], qf[ks], acc);
            z[tl] = acc;
        }
        float ln[2][4], zz[2][4]; bool vis[2][4];
#pragma unroll
        for (int tl = 0; tl < 2; ++tl)
#pragma unroll
            for (int e = 0; e < 4; ++e) {
                const int key = k0 + 16 * tl + 4 * q + e;
                vis[tl][e] = key < tq;
                const float x = z[tl][e] * sc;
                const float l = fminf(-x, 0.f) - __builtin_amdgcn_logf(1.0f + __builtin_amdgcn_exp2f(-fabsf(x)));
                zz[tl][e] = x; ln[tl][e] = vis[tl][e] ? l : 0.f;
            }
        float g1 = ln[1][0] + ln[1][1] + ln[1][2] + ln[1][3], g0 = ln[0][0] + ln[0][1] + ln[0][2] + ln[0][3];
        const float b1 = __shfl_xor(g1, 16), c1 = __shfl_xor(g1, 32), d1 = __shfl_xor(b1, 32);
        const float b0 = __shfl_xor(g0, 16), c0 = __shfl_xor(g0, 32), d0 = __shfl_xor(b0, 32);
        const float tot1 = g1 + b1 + c1 + d1, tot0 = g0 + b0 + c0 + d0;
        const float e1 = (q == 3) ? 0.f : (q == 2) ? b1 : (q == 1) ? (c1 + d1) : (b1 + c1 + d1);
        const float e0 = ((q == 3) ? 0.f : (q == 2) ? b0 : (q == 1) ? (c0 + d0) : (b0 + c0 + d0)) + tot1;
        float p[2][4];
        {   float run = R + e1;
#pragma unroll
            for (int e = 3; e >= 0; --e) { p[1][e] = vis[1][e] ? __builtin_amdgcn_exp2f(ln[1][e] + zz[1][e] + run) : 0.f; run += ln[1][e]; }
            run = R + e0;
#pragma unroll
            for (int e = 3; e >= 0; --e) { p[0][e] = vis[0][e] ? __builtin_amdgcn_exp2f(ln[0][e] + zz[0][e] + run) : 0.f; run += ln[0][e]; }
        }
        R += tot0 + tot1;
        const bf16x8 pb = pack8(p[0][0], p[0][1], p[0][2], p[0][3], p[1][0], p[1][1], p[1][2], p[1][3]);
#pragma unroll
        for (int dt = 0; dt < 8; ++dt) ot[dt] = MFMA16(vf[dt], pb, ot[dt]);
        if (__all(R < -40.0f)) break;
    }
#pragma unroll
    for (int dt = 0; dt < 8; ++dt)
        *(unsigned*)(MIX + (size_t)tq * MIXW + h * 128 + 16 * dt + 4 * q) = pk4_f8(ot[dt][0], ot[dt][1], ot[dt][2], ot[dt][3], F8_ACT);
    __syncthreads();
}
DI void phase_sb_attn(const Ctx& c, int layer) {
    for (int task = c.bid; task < (M_TOK / 128) * 8; task += c.G) sb_attn_block(c, task);
#ifndef REP_MEMATT
#define REP_MEMATT 1
#endif
#pragma unroll 1
    for (int rm_ = 0; rm_ < REP_MEMATT; ++rm_) mem_attn_all(c, layer, SC_QM, c.bid, c.G);
}
template <int N> DI void topk_insert(float (&L)[N], float x) {
#pragma unroll
    for (int i = 0; i < N; ++i) { const float hi = fmaxf(L[i], x); x = fminf(L[i], x); L[i] = hi; }
}
DI float key_of(float v, int idx) { return __uint_as_float((__float_as_uint(v) & ~127u) | (unsigned)(127 - idx)); }
DI int idx_of(float k) { return 127 - (int)(__float_as_uint(k) & 127u); }
DI float val_of(float k) { return __uint_as_float(__float_as_uint(k) & ~127u); }
DI float gelu_erf(float x) {
    const float ax = fabsf(x) * 0.70710678118654752f;
    const float t = __builtin_amdgcn_rcpf(1.0f + 0.3275911f * ax);
    const float poly = ((((1.061405429f * t - 1.453152027f) * t + 1.421413741f) * t - 0.284496736f) * t + 0.254829592f) * t;
    const float er = 1.0f - poly * __expf(-ax * ax);
    return 0.5f * x * (1.0f + (x < 0.f ? -er : er));
}
template <int BITS> struct RowBits;
template <> struct RowBits<6> { u32x2 a, b, cc;
    DI void load(const unsigned char* tab, int ex, int lane) { const u32x2* rp = (const u32x2*)(tab + (size_t)ex * 1536 + 24 * lane); a = rp[0]; b = rp[1]; cc = rp[2]; }
    DI void decode(float (&d)[32]) const { const u32x6 pk = {a.x, a.y, b.x, b.y, cc.x, cc.y}; const f32x32 t = __builtin_amdgcn_cvt_scalef32_pk32_f32_fp6(pk, 1.0f);
        _Pragma("unroll") for (int i = 0; i < 32; ++i) d[i] = t[i]; } };
template <> struct RowBits<4> { u32x4 a;
    DI void load(const unsigned char* tab, int ex, int lane) { a = *(const u32x4*)(tab + (size_t)ex * 1024 + 16 * lane); }
    DI void decode(float (&d)[32]) const { fp4_unpack32(a, d); } };
constexpr int PK_EID = 0, PK_GATE = 8192;
DI void phase_peer(const Ctx& c, int layer, const float* g1, const float* b1, const float* lg, const float* lb, float* dstf) {
    unsigned char* ws = c.a->ws;
    const float* SC = (const float*)(ws + WS_SC);
    const bf16_t* T1 = (const bf16_t*)(ws + WS_F1);
    const unsigned char* UT = ws + WS_UT + (size_t)layer * 16384 * UROW;
    const unsigned char* VTB = ws + WS_VTAB + (size_t)layer * 16384 * VROW;
    const float* USC = (const float*)(ws + WS_USC) + layer * 16384; const float* VSC = (const float*)(ws + WS_VSC) + layer * 16384;
    bf16_t* XB = (bf16_t*)(ws + WS_XB);
    LAS int* eid = (LAS int*)(c.lds + PK_EID); LAS float* gat = (LAS float*)(c.lds + PK_GATE);
    const int lane = c.lane, w = c.wave;
    LAS float* pg1 = (LAS float*)(c.lds + 16384); LAS float* pb1 = pg1 + DM; LAS float* pg2 = pb1 + DM; LAS float* pb2 = pg2 + DM;
    LAS float* pc1 = pb2 + DM; LAS float* pc2 = pc1 + 1024; LAS float* stl = pc2 + 1024;
    const float* c12 = (const float*)(ws + WS_C12) + (size_t)layer * 2 * 1024;
    for (int e = c.tid * 4; e < 2048; e += NTHREADS * 4) *(LAS f32x4*)(pc1 + e) = *(const f32x4*)(c12 + e);
    for (int e = c.tid * 4; e < DM; e += NTHREADS * 4) { *(LAS f32x4*)(pg1 + e) = *(const f32x4*)(g1 + e); *(LAS f32x4*)(pb1 + e) = *(const f32x4*)(b1 + e); *(LAS f32x4*)(pg2 + e) = *(const f32x4*)(lg + e); *(LAS f32x4*)(pb2 + e) = *(const f32x4*)(lb + e); }
    __syncthreads();
    for (int tb = c.bid; tb < M_TOK / 64; tb += c.G) {
        const int tok0 = tb * 64;
#pragma unroll 1
        for (int t4 = 0; t4 < 8; t4 += 4) {
            u32x2 raw[4][8];
#pragma unroll
            for (int q = 0; q < 4; ++q) { const bf16_t* xp = T1 + (size_t)(tok0 + w * 8 + t4 + q) * DM + 4 * lane;
#pragma unroll
                for (int j = 0; j < 8; ++j) raw[q][j] = *(const u32x2*)(xp + 256 * j); }
            asm volatile("" ::: "memory");
#pragma unroll
            for (int q = 0; q < 4; ++q) {
                float tv[32];
#pragma unroll
                for (int j = 0; j < 8; ++j) { const u32x2 ta = raw[q][j]; tv[4 * j] = bf_lo(ta.x); tv[4 * j + 1] = bf_hi(ta.x); tv[4 * j + 2] = bf_lo(ta.y); tv[4 * j + 3] = bf_hi(ta.y); }
                float s = 0.f;
#pragma unroll
                for (int i = 0; i < 32; ++i) s += tv[i];
                const float mu = wave_sum(s) * (1.0f / 2048.0f);
                float qv = 0.f;
#pragma unroll
                for (int i = 0; i < 32; ++i) { const float d = tv[i] - mu; qv += d * d; }
                const float rstd = __builtin_amdgcn_rsqf(wave_sum(qv) * (1.0f / 2048.0f) + LN_EPS);
                if (lane == 0) { stl[2 * (w * 8 + t4 + q)] = mu; stl[2 * (w * 8 + t4 + q) + 1] = rstd; }
            }
        }
        __syncthreads();
#ifndef REP_TOPK
#define REP_TOPK 1
#endif
#pragma unroll 1
        for (int rtk_ = 0; rtk_ < REP_TOPK; ++rtk_)
        {
            const int pr = w * 32 + (lane & 31), tl = pr >> 2, hd = pr & 3, hf = lane >> 5;
            const float* sp = SC + (size_t)(tok0 + tl) * 1024 + hd * 256 + hf * 128;
            LAS float* q1 = pc1 + hd * 256 + hf * 128; LAS float* q2 = pc2 + hd * 256 + hf * 128;
            const float tmu = stl[2 * tl], trs = stl[2 * tl + 1];
            float L[8];
#pragma unroll
            for (int i = 0; i < 8; ++i) L[i] = -3.0e38f;
#pragma unroll 1
            for (int i0 = 0; i0 < 128; i0 += 32) {
                f32x4 a8[8];
#pragma unroll
                for (int q = 0; q < 8; ++q) a8[q] = *(const f32x4*)(sp + i0 + 4 * q);
                asm volatile("" ::: "memory");
#pragma unroll
                for (int q = 0; q < 8; ++q) {
                    const int i = i0 + 4 * q;
                    const f32x4 ca = *(const LAS f32x4*)(q1 + i), da = *(const LAS f32x4*)(q2 + i);
#pragma unroll
                    for (int j = 0; j < 4; ++j) topk_insert<8>(L, key_of((a8[q][j] - tmu * ca[j]) * trs + da[j], i + j));
                }
            }
            float L1[8], L2[8];
#pragma unroll
            for (int i = 0; i < 8; ++i) { auto r = __builtin_amdgcn_permlane32_swap(__float_as_uint(L[i]), __float_as_uint(L[i]), false, false); L1[i] = __uint_as_float(r[0]); L2[i] = __uint_as_float(r[1]); }
            float cv[8], ce[8];
#pragma unroll
            for (int i = 0; i < 8; ++i) { cv[i] = -3.0e38f; ce[i] = 0.f; }
#pragma unroll
            for (int i = 0; i < 8; ++i)
#pragma unroll
                for (int j = 0; j < 8; ++j)
                    if ((i + 1) * (j + 1) <= 8) {
                        float v = val_of(L1[i]) + val_of(L2[j]);
                        float ex = __int_as_float(idx_of(L1[i]) * 128 + idx_of(L2[j]));
#pragma unroll
                        for (int k = 0; k < 8; ++k) { const bool gt = v > cv[k]; const float tv = gt ? cv[k] : v, te = gt ? ce[k] : ex; cv[k] = gt ? v : cv[k]; ce[k] = gt ? ex : ce[k]; v = tv; ex = te; }
                    }
            float sm = 0.f, pe[8];
#pragma unroll
            for (int k = 0; k < 8; ++k) { pe[k] = __expf(cv[k] - cv[0]); sm += pe[k]; }
            const float inv = 1.0f / sm;
            if (lane < 32)
#pragma unroll
            for (int k = 0; k < 8; ++k) { eid[tl * 32 + hd * 8 + k] = __float_as_int(ce[k]); gat[tl * 32 + hd * 8 + k] = pe[k] * inv; }
        }
        __syncthreads();
#define PEER_LD4(R, TAB, B0) _Pragma("unroll") for (int k = 0; k < 4; ++k) R[k].load(TAB, __builtin_amdgcn_readlane(my_e, (B0) + k), lane); asm volatile("" ::: "memory")
#define PEER_U4(R, B0) do { float s4[4]; \
                _Pragma("unroll") for (int k = 0; k < 4; ++k) { float d[32]; R[k].decode(d); f32x2 a0 = {0.f, 0.f}, a1 = {0.f, 0.f}; \
                    _Pragma("unroll") for (int i = 0; i < 32; i += 4) { a0 = __builtin_elementwise_fma(f32x2{xv[i], xv[i + 1]}, f32x2{d[i], d[i + 1]}, a0); a1 = __builtin_elementwise_fma(f32x2{xv[i + 2], xv[i + 3]}, f32x2{d[i + 2], d[i + 3]}, a1); } \
                    s4[k] = (a0.x + a0.y) + (a1.x + a1.y); } \
                const float r4 = wave_sum4(s4[0], s4[1], s4[2], s4[3]); \
                _Pragma("unroll") for (int k = 0; k < 4; ++k) { const float sk = __int_as_float(__builtin_amdgcn_readlane(__float_as_int(r4), 16 * k)); if (lane == (B0) + k) hsum = sk; } } while (0)
#define PEER_V4(R, B0) do { _Pragma("unroll") for (int k = 0; k < 4; ++k) { const float ak = __int_as_float(__builtin_amdgcn_readlane(__float_as_int(act), (B0) + k)); float d[32]; R[k].decode(d); \
                    _Pragma("unroll") for (int i = 0; i < 32; i += 2) { const f32x2 o = __builtin_elementwise_fma(f32x2{ak, ak}, f32x2{d[i], d[i + 1]}, f32x2{ov[i], ov[i + 1]}); ov[i] = o.x; ov[i + 1] = o.y; } } } while (0)
        u32x2 traw[8];
        {   const bf16_t* xp = T1 + (size_t)(tok0 + w * 8) * DM + 4 * lane;
#pragma unroll
            for (int j = 0; j < 8; ++j) traw[j] = *(const u32x2*)(xp + 256 * j); }
        int my_e = eid[(w * 8) * 32 + (lane & 31)];
        RowBits<PEER_UBITS> ra[4], rb[4];
        PEER_LD4(ra, UT, 0);
#pragma unroll 1
        for (int tt = 0; tt < 8; ++tt) {
            const int tl = w * 8 + tt, tok = tok0 + tl, tln = w * 8 + (tt < 7 ? tt + 1 : 7);
            float xv[32];
            const f32x2 st = {stl[2 * tl], stl[2 * tl + 1]};
            {   int l4 = 4 * lane; asm volatile("" : "+v"(l4));
#pragma unroll
                for (int j = 0; j < 8; ++j) {
                    const u32x2 ta = traw[j];
                    const f32x4 gg = *(const LAS f32x4*)(pg1 + l4 + 256 * j), bb = *(const LAS f32x4*)(pb1 + l4 + 256 * j);
                    xv[4 * j] = (bf_lo(ta.x) - st.x) * st.y * gg[0] + bb[0]; xv[4 * j + 1] = (bf_hi(ta.x) - st.x) * st.y * gg[1] + bb[1];
                    xv[4 * j + 2] = (bf_lo(ta.y) - st.x) * st.y * gg[2] + bb[2]; xv[4 * j + 3] = (bf_hi(ta.y) - st.x) * st.y * gg[3] + bb[3]; } }
            {   const bf16_t* xp = T1 + (size_t)(tok0 + tln) * DM + 4 * lane;
#pragma unroll
                for (int j = 0; j < 8; ++j) traw[j] = *(const u32x2*)(xp + 256 * j); }
            const float my_g = gat[tl * 32 + (lane & 31)];
            const float my_us = USC[my_e], my_vs = VSC[my_e];
            float hsum = 0.f;
            RowBits<PEER_VBITS> va[4], vb[4];
#pragma unroll 1
            for (int e0 = 0; e0 < 24; e0 += 8) { PEER_LD4(rb, UT, e0 + 4); PEER_U4(ra, e0); PEER_LD4(ra, UT, e0 + 8); PEER_U4(rb, e0 + 4); }
            PEER_LD4(rb, UT, 28); PEER_U4(ra, 24);
            PEER_LD4(va, VTB, 0);
            PEER_U4(rb, 28);
            const float act = gelu_erf(hsum * my_us) * my_g * my_vs;
            float ov[32];
#pragma unroll
            for (int i = 0; i < 32; ++i) ov[i] = 0.f;
#pragma unroll 1
            for (int e0 = 0; e0 < 24; e0 += 8) { PEER_LD4(vb, VTB, e0 + 4); PEER_V4(va, e0); PEER_LD4(va, VTB, e0 + 8); PEER_V4(vb, e0 + 4); }
            PEER_LD4(vb, VTB, 28); PEER_V4(va, 24);
            {   const int e_cur = my_e; my_e = eid[tln * 32 + (lane & 31)]; PEER_LD4(ra, UT, 0); (void)e_cur; }
            PEER_V4(vb, 28);
#pragma unroll
            for (int i = 0; i < 32; ++i) ov[i] += DN_ALPHA * xv[i];
            {   LAS float* g2_ = pg2; LAS float* b2_ = pb2; asm volatile("" : "+v"(g2_), "+v"(b2_));
                ln_row16<LAS float*>(ov, g2_, b2_, dstf ? dstf + (size_t)tok * DM : nullptr, XB + (size_t)tok * DM, ws + WS_X8 + (size_t)tok * DM, lane); }
        }
        __syncthreads();
    }
}
#ifndef REP_PRO
#define REP_PRO 1
#endif
#ifndef REP_GEMM0
#define REP_GEMM0 1
#endif
#ifndef REP_PREP
#define REP_PREP 1
#endif
#ifndef REP_SB
#define REP_SB 1
#endif
#ifndef REP_SCAN
#define REP_SCAN 1
#endif
#ifndef REP_SCANB
#define REP_SCANB 1
#endif
#ifndef REP_SCANC
#define REP_SCANC 1
#endif
#ifndef REP_GOUT
#define REP_GOUT 1
#endif
#ifndef REP_GEMM4
#define REP_GEMM4 1
#endif
#ifndef REP_LN
#define REP_LN 1
#endif
#ifndef REP_GEMM6
#define REP_GEMM6 1
#endif
#ifndef REP_PEER
#define REP_PEER 1
#endif
#ifndef REP_PRO
#define REP_PRO 1
#endif
#ifndef REP_GEMM0
#define REP_GEMM0 1
#endif
#ifndef REP_PREP
#define REP_PREP 1
#endif
#ifndef REP_SB
#define REP_SB 1
#endif
#ifndef REP_SCAN
#define REP_SCAN 1
#endif
#ifndef REP_SCANB
#define REP_SCANB 1
#endif
#ifndef REP_SCANC
#define REP_SCANC 1
#endif
#ifndef REP_GOUT
#define REP_GOUT 1
#endif
#ifndef REP_GEMM4
#define REP_GEMM4 1
#endif
#ifndef REP_LN
#define REP_LN 1
#endif
#ifndef REP_GEMM6
#define REP_GEMM6 1
#endif
#ifndef REP_PEER
#define REP_PEER 1
#endif
#ifndef REP_PBS
#define REP_PBS 1
#endif
#ifndef REP_OTH
#define REP_OTH 1
#endif
#ifndef REP_CT
#define REP_CT 1
#endif
#ifndef EN_PRO
#define EN_PRO 1
#endif
#ifndef EN_GEMM0
#define EN_GEMM0 1
#endif
#ifndef EN_PREP
#define EN_PREP 1
#endif
#ifndef EN_SB
#define EN_SB 1
#endif
#ifndef EN_SCAN
#define EN_SCAN 1
#endif
#ifndef EN_GOUT
#define EN_GOUT 1
#endif
#ifndef EN_GEMM4
#define EN_GEMM4 1
#endif
#ifndef EN_LN
#define EN_LN 1
#endif
#ifndef EN_GEMM6
#define EN_GEMM6 1
#endif
#ifndef EN_PEER
#define EN_PEER 1
#endif
constexpr int NPL = 10, NPH = 1 + NPL * DEPTH;
__host__ __device__ constexpr bool phase_exists(int ph) { return ph == 0 || !(((((ph - 1) / NPL) & 1) != 0) && (((ph - 1) % NPL) >= 2) && (((ph - 1) % NPL) <= 5)) && (((ph - 1) % NPL) != 7); }

__global__ void __launch_bounds__(NTHREADS, 2) hybrid_fwd(Args args) {
    extern __shared__ __attribute__((aligned(16))) unsigned char lds_raw[];
    Ctx c;
    c.a = (ArgsP)__builtin_amdgcn_kernarg_segment_ptr(); c.lds = (LAS unsigned char*)lds_raw; c.tid = threadIdx.x; c.lane = c.tid & 63; c.wave = __builtin_amdgcn_readfirstlane(c.tid >> 6); c.G = gridDim.x; c.bid = blockIdx.x;
    unsigned char* ws = c.a->ws;
    const int lo = c.a->ph_lo, hi = c.a->ph_hi;
    const bool fused = (hi - lo) > 1;
    volatile LAS unsigned* xbst = (volatile LAS unsigned*)(c.lds + LDS_CTL);
    if (c.tid < 4) xbst[c.tid] = 0u;
    __syncthreads();
    XcdBarrier bar; bar.bar = (unsigned*)(ws + WS_CTL); bar.x = 0; bar.st = xbst;
    if (fused) bar = xcd_barrier_post((unsigned*)(ws + WS_CTL), xbst);
#define IN(k) (lo <= (k) && (k) < hi)
#define FRESH() do { int t_ = threadIdx.x; asm volatile("" : "+v"(t_)); c.tid = t_; c.lane = t_ & 63; c.wave = __builtin_amdgcn_readfirstlane(t_ >> 6); ArgsP a_ = (ArgsP)__builtin_amdgcn_kernarg_segment_ptr(); asm volatile("" : "+s"(a_)); c.a = a_; ws = a_->ws; } while (0)
#ifndef SEAM_REP
#define SEAM_REP 1
#endif
#define SEAM(k) do { if (fused && (k) + 1 < hi) { for (int sr_ = 0; sr_ < SEAM_REP; ++sr_) xcd_barrier(bar); } } while (0)
    LAS unsigned char* glds = (LAS unsigned char*)c.lds;

    if (IN(0)) {
#if EN_PRO
#pragma unroll 1
 for (int rep_ = 0; rep_ < REP_PRO; ++rep_) { if (rep_) __syncthreads();
 FRESH(); phase_prologue(c);
 }
#endif
 SEAM(0); }

#pragma unroll 1
    for (int L = 0; L < DEPTH; ++L) {
        const int base = 1 + NPL * L, li = L >> 1;
        const bool gdn = (L & 1) == 0;

        if (IN(base + 0)) {
#if EN_GEMM0
#pragma unroll 1
 for (int rep_ = 0; rep_ < REP_GEMM0; ++rep_) { if (rep_) __syncthreads();
            FRESH();
            {   pg8::MultiOrder S; S.G = c.G; S.c = c.bid; S.nj = 0;
                const bf16_t* const X8p = (const bf16_t*)(ws + WS_X8); bf16_t* const Pp = (bf16_t*)(ws + WS_P);
                pg8::Job jz{X8p, X8p, Pp, 0, 0, 0};
                S.j[0] = jz; S.j[1] = jz; S.j[2] = jz; S.j[3] = jz;
                if (gdn) { S.j[0] = pg8::Job{X8p, (const bf16_t*)(ws + WS_WG + (size_t)li * GDN_NP * DM), Pp, M_TOK, GDN_NP, LDP}; S.nj = 1; }
                else { S.j[0] = pg8::Job{X8p, (const bf16_t*)(ws + WS_WSB + (size_t)li * SB_NP * DM), Pp, M_TOK, SB_NP, LDP};
                       S.j[1] = pg8::Job{(const bf16_t*)(ws + WS_WSBV + (size_t)li * 1024 * DM), X8p, (bf16_t*)(ws + WS_VT), 1024, M_TOK, M_TOK}; S.nj = 2; }
                if (L == 0) {
                    S.j[1] = pg8::Job{(const bf16_t*)(ws + WS_MEMB), (const bf16_t*)(ws + WS_WK), (bf16_t*)(ws + WS_KM), NMEM, 2048, 2048};
                    S.j[2] = pg8::Job{(const bf16_t*)(ws + WS_WV), (const bf16_t*)(ws + WS_MEMB), (bf16_t*)(ws + WS_VMT), 2048, NMEM, NMEM}; S.nj = 3; }
                pg8::Gemm g{X8p, X8p, M_TOK, 256, DM / 2, E8_WIN, E8_ACT};
                pg8::EpiBf16Multi E{S.j[0].O, S.j[1].O, S.j[2].O, S.j[3].O, S.j[0].ldc, S.j[1].ldc, S.j[2].ldc, S.j[3].ldc};
                pg8::gemm_phase<pg8::EpiBf16Multi, pg8::MultiOrder, false, true, E8_WIN, E8_ACT>(glds, g, S, E, nullptr); }
            if (c.bid == c.G - 1) peer_c12_finalize(c, L);
 }
#endif
            SEAM(base + 0);
        }
        if (IN(base + 1)) {

#if EN_PREP
#pragma unroll 1
 for (int rep_ = 0; rep_ < REP_PREP; ++rep_) { if (rep_) __syncthreads();
 FRESH(); if (gdn) phase_gdn_prep(c, li);
 }
#endif
#if EN_SB
#pragma unroll 1
 for (int rep_ = 0; rep_ < REP_SB; ++rep_) { if (rep_) __syncthreads();
 FRESH(); if (!gdn) phase_sb_attn(c, L);
 }
#endif

            SEAM(base + 1);
        }
        if (gdn && IN(base + 2)) {
#if EN_SCAN
#pragma unroll 1
            for (int rep_ = 0; rep_ < REP_SCAN; ++rep_) { if (rep_) __syncthreads();
            FRESH();
            for (int u = c.bid; u < 8 * SCAN_NG; u += c.G) { scan_pass_a(c, u); __syncthreads(); } }
#endif
            SEAM(base + 2);
        }
        if (gdn && IN(base + 3)) {
#if EN_SCAN
#pragma unroll 1
            for (int rep_ = 0; rep_ < REP_SCANB; ++rep_) { if (rep_) __syncthreads();
            FRESH();
            if (c.G > 8) { if (c.bid < 8) { for (int rb_ = 0; rb_ < REP_PBS; ++rb_) { if (rb_) __syncthreads(); scan_pass_b(c, c.bid); } } else { mem_attn_all(c, L, GC_QM, c.bid - 8, c.G - 8); if (REP_OTH > 1) { __syncthreads(); mem_attn_all(c, L, GC_QM, c.bid - 8, c.G - 8); } if (REP_OTH > 2) { __syncthreads(); mem_attn_all(c, L, GC_QM, c.bid - 8, c.G - 8); } for (int rb_ = 0; rb_ < REP_CT; ++rb_) { if (rb_) __syncthreads(); convert_tables(c, L, c.bid - 8, c.G - 8); } } }
            else { for (int hd = c.bid; hd < 8; hd += c.G) scan_pass_b(c, hd); mem_attn_all(c, L, GC_QM, c.bid, c.G); convert_tables(c, L, c.bid, c.G); } }
#endif
            SEAM(base + 3);
        }
        if (gdn && IN(base + 4)) {
#if EN_SCAN
#pragma unroll 1
            for (int rep_ = 0; rep_ < REP_SCANC; ++rep_) { if (rep_) __syncthreads();
            FRESH();
            for (int u = c.bid; u < 8 * SCAN_NG; u += c.G) { scan_pass_c(c, u); __syncthreads(); } }
#endif
            SEAM(base + 4);
        }
        if (gdn && IN(base + 5)) {
#if EN_GOUT
#pragma unroll 1
 for (int rep_ = 0; rep_ < REP_GOUT; ++rep_) { if (rep_) __syncthreads();
 FRESH(); phase_gdn_out(c, li);
 }
#endif
 SEAM(base + 5); }
        if (IN(base + 6)) {
#if EN_GEMM4
#pragma unroll 1
 for (int rep_ = 0; rep_ < REP_GEMM4; ++rep_) { if (rep_) __syncthreads();
            FRESH();
            pg8::Gemm g{(const bf16_t*)(ws + WS_MIX), (const bf16_t*)(ws + WS_WO + (size_t)L * DM * MIXW), M_TOK, DM, MIXW / 2, E8_WOUT, E8_ACT};
            pg8::StaticOrder S; S.init(M_TOK, DM, c.G, c.bid);
            pg8::EpiResid E{(const bf16_t*)(ws + WS_XB), (bf16_t*)(ws + WS_F1), DM, DN_ALPHA};
            pg8::gemm_phase<pg8::EpiResid, pg8::StaticOrder, false, true, E8_WOUT, E8_ACT>(glds, g, S, E, nullptr);
 }
#endif
            SEAM(base + 6);
        }
        if (IN(base + 8)) {
#if EN_GEMM6
#pragma unroll 1
 for (int rep_ = 0; rep_ < REP_GEMM6; ++rep_) { if (rep_) __syncthreads();
            FRESH();
            pg8::Gemm g{(const bf16_t*)(ws + WS_F1), (const bf16_t*)(ws + WS_WP) + (size_t)L * 1024 * DM, M_TOK, 1024, DM};
            pg8::StaticOrder S; S.init(M_TOK, 1024, c.G, c.bid);
            pg8::EpiF32 E{(float*)(ws + WS_SC), 1024};
            pg8::gemm_phase<pg8::EpiF32, pg8::StaticOrder>(glds, g, S, E, nullptr);
 }
#endif
            SEAM(base + 8);
        }
        if (IN(base + 9)) {
#if EN_PEER
#pragma unroll 1
 for (int rep_ = 0; rep_ < REP_PEER; ++rep_) { if (rep_) __syncthreads();
FRESH();             phase_peer(c, L, c.a->ln_mix_g + L * DM, c.a->ln_mix_b + L * DM, c.a->ln_ffn_g + L * DM, c.a->ln_ffn_b + L * DM, (L == DEPTH - 1) ? c.a->out : (float*)nullptr);
 }
#endif
            SEAM(base + 9);
        }
    }
#undef IN
#undef SEAM
}

#ifndef MK_FUSED
#define MK_FUSED 1
#endif
extern "C" void kernel_launch(void* const* d_in, const int* in_sizes, int n_in, void* d_out, int out_size, void* d_ws, size_t ws_size, hipStream_t stream) {
    static int grid = 0;
    if (grid == 0) {
        if (n_in != 18 || out_size != M_TOK * DM || ws_size < WS_END) { fprintf(stderr, "kernel_launch: unexpected shapes (n_in %d out %d ws %zu need %zu)\n", n_in, out_size, ws_size, (size_t)WS_END); grid = -1; return; }
        int dev = 0, cus = 0, per_cu = 0;
        if (hipGetDevice(&dev) != hipSuccess || hipDeviceGetAttribute(&cus, hipDeviceAttributeMultiprocessorCount, dev) != hipSuccess) { grid = -1; return; }
        if (hipFuncSetAttribute((const void*)hybrid_fwd, hipFuncAttributeMaxDynamicSharedMemorySize, LDS_BYTES) != hipSuccess) { fprintf(stderr, "kernel_launch: hipFuncSetAttribute failed\n"); grid = -1; return; }
        if (hipOccupancyMaxActiveBlocksPerMultiprocessor(&per_cu, (const void*)hybrid_fwd, NTHREADS, LDS_BYTES) != hipSuccess || per_cu < 1) { fprintf(stderr, "kernel_launch: occupancy query says %d\n", per_cu); (void)hipGetLastError(); }
        grid = cus;
    }
    if (grid < 0) return;
    hipMemsetAsync((char*)d_ws + WS_CTL, 0, WS_CTL_BYTES, stream);
    Args a{};
    a.x = (const float*)d_in[0]; a.mem = (const float*)d_in[1]; a.gdn_w_in = (const float*)d_in[2]; a.gdn_conv = (const float*)d_in[3]; a.gdn_a_log = (const float*)d_in[4];
    a.gdn_dt_bias = (const float*)d_in[5]; a.gdn_onorm = (const float*)d_in[6]; a.sb_w_in = (const float*)d_in[7]; a.mem_w_kv = (const float*)d_in[8]; a.w_out = (const float*)d_in[9];
    a.ln_mix_g = (const float*)d_in[10]; a.ln_mix_b = (const float*)d_in[11]; a.peer_w_q = (const float*)d_in[12]; a.peer_keys = (const float*)d_in[13]; a.peer_u = (const float*)d_in[14];
    a.peer_v = (const float*)d_in[15]; a.ln_ffn_g = (const float*)d_in[16]; a.ln_ffn_b = (const float*)d_in[17];
    a.out = (float*)d_out; a.ws = (unsigned char*)d_ws;
#if MK_FUSED
    a.ph_lo = 0; a.ph_hi = NPH;
    hipLaunchKernelGGL(hybrid_fwd, dim3(grid), dim3(NTHREADS), LDS_BYTES, stream, a);
#else
    for (int ph = 0; ph < NPH; ++ph) {
        if (!phase_exists(ph)) continue;
        a.ph_lo = ph; a.ph_hi = ph + 1;
        hipLaunchKernelGGL(hybrid_fwd, dim3(grid), dim3(NTHREADS), LDS_BYTES, stream, a);
    }
#endif
}
```

```cpp
#include <hip/hip_runtime.h>
#include <stdio.h>
#include <stdint.h>

#define LAS __attribute__((address_space(3)))
typedef unsigned short bf16_t;
typedef short bf16x8 __attribute__((ext_vector_type(8)));
typedef short s16x4 __attribute__((ext_vector_type(4)));
typedef float f32x2 __attribute__((ext_vector_type(2)));
typedef float f32x4 __attribute__((ext_vector_type(4)));
typedef float f32x16 __attribute__((ext_vector_type(16)));
typedef unsigned u32x2 __attribute__((ext_vector_type(2)));
typedef unsigned u32x4 __attribute__((ext_vector_type(4)));
typedef __bf16 bfx2 __attribute__((ext_vector_type(2)));
typedef float f32x32 __attribute__((ext_vector_type(32)));
typedef unsigned u32x6 __attribute__((ext_vector_type(6)));
#define DI __device__ __forceinline__

DI unsigned pk2(float lo, float hi) { f32x2 v = {lo, hi}; return __builtin_bit_cast(unsigned, __builtin_convertvector(v, bfx2)); }
DI bf16_t f2bf(float f) { return (bf16_t)(pk2(f, 0.f) & 0xffffu); }
DI float bf_lo(unsigned w) { return __uint_as_float(w << 16); }
DI float bf_hi(unsigned w) { return __uint_as_float(w & 0xffff0000u); }
DI float bf2f(bf16_t b) { return __uint_as_float(((unsigned)b) << 16); }
DI float row_sum16(float v) {
    v += __int_as_float(__builtin_amdgcn_update_dpp(0, __float_as_int(v), 0xB1, 0xF, 0xF, true));
    v += __int_as_float(__builtin_amdgcn_update_dpp(0, __float_as_int(v), 0x4E, 0xF, 0xF, true));
    v += __int_as_float(__builtin_amdgcn_update_dpp(0, __float_as_int(v), 0x141, 0xF, 0xF, true));
    v += __int_as_float(__builtin_amdgcn_update_dpp(0, __float_as_int(v), 0x140, 0xF, 0xF, true));
    return v; }
DI float swap16_sum(float a, float b) { auto r = __builtin_amdgcn_permlane16_swap(__float_as_uint(a), __float_as_uint(b), false, false); return __uint_as_float(r[0]) + __uint_as_float(r[1]); }
DI float swap32_sum(float a, float b) { auto r = __builtin_amdgcn_permlane32_swap(__float_as_uint(a), __float_as_uint(b), false, false); return __uint_as_float(r[0]) + __uint_as_float(r[1]); }
DI float wave_sum(float v) { v = row_sum16(v); v = swap16_sum(v, v); return swap32_sum(v, v); }
DI float wave_max(float v) {
    v = fmaxf(v, __int_as_float(__builtin_amdgcn_update_dpp(0, __float_as_int(v), 0xB1, 0xF, 0xF, true)));
    v = fmaxf(v, __int_as_float(__builtin_amdgcn_update_dpp(0, __float_as_int(v), 0x4E, 0xF, 0xF, true)));
    v = fmaxf(v, __int_as_float(__builtin_amdgcn_update_dpp(0, __float_as_int(v), 0x141, 0xF, 0xF, true)));
    v = fmaxf(v, __int_as_float(__builtin_amdgcn_update_dpp(0, __float_as_int(v), 0x140, 0xF, 0xF, true)));
    { auto r = __builtin_amdgcn_permlane16_swap(__float_as_uint(v), __float_as_uint(v), false, false); v = fmaxf(__uint_as_float(r[0]), __uint_as_float(r[1])); }
    { auto r = __builtin_amdgcn_permlane32_swap(__float_as_uint(v), __float_as_uint(v), false, false); v = fmaxf(__uint_as_float(r[0]), __uint_as_float(r[1])); }
    return v; }
DI float wave_sum4(float s0, float s1, float s2, float s3) { return row_sum16(swap16_sum(swap32_sum(s0, s2), swap32_sum(s1, s3))); }
DI float fast_exp(float x) { return __builtin_amdgcn_exp2f(x * 1.44269504088896f); }
DI float sigmoidf_(float x) { return __builtin_amdgcn_rcpf(1.0f + fast_exp(-x)); }
DI float siluf_(float x) { return x * sigmoidf_(x); }
constexpr float F8_ACT = 16.0f, F8_WIN = 2048.0f, F8_WOUT = 4096.0f;
constexpr int E8_ACT = 123, E8_WIN = 116, E8_WOUT = 115;
DI float f8c(float v, float sc) { return fminf(fmaxf(v * sc, -448.0f), 448.0f); }
DI unsigned pk4_f8(float a, float b, float c2, float d, float sc) { int t = 0; t = __builtin_amdgcn_cvt_pk_fp8_f32(f8c(a, sc), f8c(b, sc), t, false); t = __builtin_amdgcn_cvt_pk_fp8_f32(f8c(c2, sc), f8c(d, sc), t, true); return (unsigned)t; }
DI bf16x8 pack8(float a0, float a1, float a2, float a3, float a4, float a5, float a6, float a7) {
    u32x4 p; p.x = pk2(a0, a1); p.y = pk2(a2, a3); p.z = pk2(a4, a5); p.w = pk2(a6, a7); return __builtin_bit_cast(bf16x8, p); }
#define MFMA32(a, b, c) __builtin_amdgcn_mfma_f32_32x32x16_bf16((a), (b), (c), 0, 0, 0)
#define MFMA16(a, b, c) __builtin_amdgcn_mfma_f32_16x16x32_bf16((a), (b), (c), 0, 0, 0)

constexpr int M_TOK = 16384, DM = 2048, DEPTH = 4, NMEM = 256, HD = 128;
constexpr int LDP = 3840;
constexpr int GDN_NP = 3840, SB_NP = 2560;
constexpr int MIXW = 1536;
constexpr float DN_ALPHA = 1.681792830507429f;
constexpr float LN_EPS = 1e-5f, RMS_EPS = 1e-6f;
constexpr int NTHREADS = 512;
constexpr int LDS_BYTES = 160 * 1024;
constexpr int LDS_CTL = LDS_BYTES - 256;

constexpr int GC_Q = 0, GC_K = 512, GC_V = 1024, GC_Z = 2048, GC_QM = 3072, GC_B = 3584, GC_A = 3592;
constexpr int SC_Q = 0, SC_K = 1024, SC_QM = 2048;

constexpr int REC_W = 0, REC_QG = 16384, REC_KDT = 32768, REC_AQK = 49152, REC_U = 57344, REC_BYTES = 73728;

constexpr size_t al256(size_t x) { return (x + 255) & ~(size_t)255; }
constexpr size_t WS_CTL = 0;
constexpr size_t WS_CTL_BYTES = 65536;
constexpr size_t WS_XB = WS_CTL + WS_CTL_BYTES;
constexpr size_t WS_F0 = WS_XB + (size_t)M_TOK * DM * 2;
constexpr size_t WS_F1 = WS_F0 + (size_t)M_TOK * DM * 4;
constexpr size_t WS_F2 = WS_F1 + (size_t)M_TOK * DM * 4;
constexpr size_t WS_P = WS_F2 + (size_t)M_TOK * DM * 4;
constexpr size_t WS_VT = WS_P + (size_t)M_TOK * LDP * 2;
constexpr size_t WS_REC = WS_VT + (size_t)1024 * M_TOK * 2;
constexpr size_t WS_GAM = WS_REC + (size_t)2048 * REC_BYTES;
constexpr size_t WS_OG = WS_GAM + 8192;
constexpr size_t WS_MIX = WS_OG + (size_t)M_TOK * 1024 * 4;
constexpr size_t WS_SC = WS_MIX + (size_t)M_TOK * MIXW * 2;
constexpr size_t WS_MEMB = WS_SC + (size_t)M_TOK * 1024 * 4;
constexpr size_t WS_KM = WS_MEMB + (size_t)NMEM * DM * 2;
constexpr size_t WS_VMT = WS_KM + (size_t)NMEM * 2048 * 2;
constexpr size_t WS_WG = WS_VMT + (size_t)2048 * NMEM * 2;
constexpr size_t WS_WSB = WS_WG + (size_t)2 * GDN_NP * DM * 2;
constexpr size_t WS_WSBV = WS_WSB + (size_t)2 * SB_NP * DM * 2;
constexpr size_t WS_WK = WS_WSBV + (size_t)2 * 1024 * DM * 2;
constexpr size_t WS_WV = WS_WK + (size_t)2048 * DM * 2;
constexpr size_t WS_WO = WS_WV + (size_t)2048 * DM * 2;
constexpr size_t WS_WP = WS_WO + (size_t)4 * DM * MIXW * 2;
#ifndef PEER_UBITS
#define PEER_UBITS 4
#endif
#ifndef PEER_VBITS
#define PEER_VBITS 4
#endif
constexpr int UROW = 256 * PEER_UBITS, VROW = 256 * PEER_VBITS;
constexpr size_t WS_UT = WS_WP + (size_t)4 * 1024 * DM * 2;
constexpr size_t WS_VTAB = WS_UT + (size_t)4 * 16384 * UROW;
constexpr size_t WS_USC = WS_VTAB + (size_t)4 * 16384 * VROW;
constexpr size_t WS_VSC = WS_USC + (size_t)4 * 16384 * 4;
constexpr size_t WS_PHI = WS_VSC + (size_t)4 * 16384 * 4;
constexpr size_t WS_SLOC = WS_PHI + (size_t)256 * 32768;
constexpr size_t WS_SIN = WS_SLOC + (size_t)256 * 32768;
constexpr size_t WS_X8 = WS_SIN + (size_t)256 * 32768;
constexpr size_t WS_CP1 = WS_X8 + (size_t)M_TOK * DM;
constexpr size_t WS_CP2 = WS_CP1 + (size_t)4 * 32 * 1024 * 4;
constexpr size_t WS_C12 = WS_CP2 + (size_t)4 * 32 * 1024 * 4;
constexpr size_t WS_END = WS_C12 + (size_t)4 * 2 * 1024 * 4;

struct Args {
    const float* x; const float* mem; const float* gdn_w_in; const float* gdn_conv; const float* gdn_a_log; const float* gdn_dt_bias; const float* gdn_onorm;
    const float* sb_w_in; const float* mem_w_kv; const float* w_out; const float* ln_mix_g; const float* ln_mix_b; const float* peer_w_q; const float* peer_keys;
    const float* peer_u; const float* peer_v; const float* ln_ffn_g; const float* ln_ffn_b;
    float* out; unsigned char* ws; int ph_lo, ph_hi;
};
namespace pg8 {
#define PG8_LAS __attribute__((address_space(3)))
typedef unsigned short bf16_t;
typedef short bf16x8 __attribute__((ext_vector_type(8)));
typedef float f32x4 __attribute__((ext_vector_type(4)));
typedef unsigned u32x4 __attribute__((ext_vector_type(4)));
constexpr int BM = 256, BK = 64, HALF = 128, HTB = HALF * BK * 2  , STAGE_BYTES = 8 * HTB, NXCD = 8, WGM = 8;

__host__ __device__ __forceinline__ int lds_byte(int r, int c) { const int st = (r >> 4) * 2 + (c >> 5), rr = r & 15, cc = c & 31, ob = rr * 64 + cc * 2; return st * 1024 + (ob ^ (((ob >> 9) & 1) << 5)); }
__host__ __device__ __forceinline__ void stage_rc(int b, int& R, int& C) { const int st = b / 1024, sb = b % 1024, swz = sb ^ (((sb >> 9) & 1) << 5); R = (st >> 1) * 16 + swz / 64; C = (st & 1) * 32 + (swz % 64) / 2; }
__host__ __device__ __forceinline__ int perm32(int rho) { const int n = rho >> 4, i = rho & 15; return 8 * (i >> 2) + 4 * n + (i & 3); }

struct Unit { int pm, pn, job; };
struct Gemm { const bf16_t* A; const bf16_t* Bt; int M, N, K; int sA, sB; };
typedef int i32x4v __attribute__((ext_vector_type(4)));
typedef int i32x8v __attribute__((ext_vector_type(8)));

struct StaticOrder {
    int nM, nN, nwg, G, c;
    __host__ __device__ void init(int M, int N, int G_, int c_) { nM = M / BM; nN = N / BM; nwg = nM * nN; G = G_; c = c_; }
    __host__ __device__ bool next(int i, Unit& u) const {
        const long L = (long)i * G + c; if (L >= nwg) return false;
        int wgid = (int)L; { const int q = nwg / NXCD, r = nwg % NXCD, xcd = wgid % NXCD, off = wgid / NXCD; wgid = (xcd < r ? xcd * (q + 1) : r * (q + 1) + (xcd - r) * q) + off; }
        const int nig = WGM * nN, gid = wgid / nig, fm = gid * WGM, gsz = (nM - fm) < WGM ? (nM - fm) : WGM;
        u.pm = fm + ((wgid % nig) % gsz); u.pn = (wgid % nig) / gsz; u.job = 0; return true;
    }
    __device__ __forceinline__ const char* ptrA(const Gemm& g, const Unit&) const { return (const char*)g.A; }
    __device__ __forceinline__ const char* ptrB(const Gemm& g, const Unit&) const { return (const char*)g.Bt; }
    __device__ __forceinline__ void a_ready(const Unit&) const {}
    __device__ __forceinline__ void done(const Unit&) const {}
};
struct EpiF32 {
    static constexpr bool PERM = false, AFTER_DRAIN = false;
    float* C; int ldc;
    __device__ __forceinline__ void operator()(const f32x4 (&acc)[2][2][4][2], const Unit& u, int wr, int wc, int fr, int fq) const {
        const int row0 = u.pm * BM + wr * 64 + fr, col0 = u.pn * BM + wc * 32 + 4 * fq;
#pragma unroll
        for (int ai = 0; ai < 2; ++ai)
#pragma unroll
            for (int m = 0; m < 4; ++m) { float* rowp = C + (size_t)(row0 + ai * HALF + m * 16) * ldc + col0;
#pragma unroll
                for (int bj = 0; bj < 2; ++bj)
#pragma unroll
                    for (int n = 0; n < 2; ++n) *(f32x4*)(rowp + bj * HALF + n * 16) = acc[ai][bj][m][n]; }
    }
};
struct EpiResid {
    static constexpr bool PERM = true, AFTER_DRAIN = false;
    const bf16_t* X; bf16_t* T; int ldc; float alpha;
    __device__ __forceinline__ void operator()(const f32x4 (&acc)[2][2][4][2], const Unit& u, int wr, int wc, int fr, int fq) const {
        const int row0 = u.pm * BM + wr * 64 + fr, col0 = u.pn * BM + wc * 32 + 8 * fq;
        u32x4 xv[2][4][2];
#pragma unroll
        for (int ai = 0; ai < 2; ++ai)
#pragma unroll
            for (int m = 0; m < 4; ++m)
#pragma unroll
                for (int bj = 0; bj < 2; ++bj) xv[ai][m][bj] = *(const u32x4*)(X + (size_t)(row0 + ai * HALF + m * 16) * ldc + col0 + bj * HALF);
#pragma unroll
        for (int ai = 0; ai < 2; ++ai)
#pragma unroll
            for (int m = 0; m < 4; ++m) { const size_t off = (size_t)(row0 + ai * HALF + m * 16) * ldc + col0;
#pragma unroll
                for (int bj = 0; bj < 2; ++bj) { const f32x4 v0 = acc[ai][bj][m][0], v1 = acc[ai][bj][m][1]; const u32x4 x = xv[ai][m][bj];
                    u32x4 w; w.x = ::pk2(::bf_lo(x.x) * alpha + v0[0], ::bf_hi(x.x) * alpha + v0[1]); w.y = ::pk2(::bf_lo(x.y) * alpha + v0[2], ::bf_hi(x.y) * alpha + v0[3]);
                    w.z = ::pk2(::bf_lo(x.z) * alpha + v1[0], ::bf_hi(x.z) * alpha + v1[1]); w.w = ::pk2(::bf_lo(x.w) * alpha + v1[2], ::bf_hi(x.w) * alpha + v1[3]);
                    *(u32x4*)(T + off + bj * HALF) = w; } }
    }
};
struct EpiBf16 {
    static constexpr bool PERM = true, AFTER_DRAIN = false;
    bf16_t* O; int ldc;
    __device__ __forceinline__ void operator()(const f32x4 (&acc)[2][2][4][2], const Unit& u, int wr, int wc, int fr, int fq) const {
        const int row0 = u.pm * BM + wr * 64 + fr, col0 = u.pn * BM + wc * 32 + 8 * fq;
#pragma unroll
        for (int ai = 0; ai < 2; ++ai)
#pragma unroll
            for (int m = 0; m < 4; ++m) { bf16_t* rowp = O + (size_t)(row0 + ai * HALF + m * 16) * ldc + col0;
#pragma unroll
                for (int bj = 0; bj < 2; ++bj) { const f32x4 v0 = acc[ai][bj][m][0], v1 = acc[ai][bj][m][1];
                    u32x4 w; w.x = ::pk2(v0[0], v0[1]); w.y = ::pk2(v0[2], v0[3]); w.z = ::pk2(v1[0], v1[1]); w.w = ::pk2(v1[2], v1[3]);
                    *(u32x4*)(rowp + bj * HALF) = w; } }
    }
};

struct Job { const bf16_t* A; const bf16_t* Bt; bf16_t* O; int M, N, ldc; };
struct MultiOrder {
    Job j[4]; int nj, G, c;
    __device__ __forceinline__ bool next(int i, Unit& u) const {
        long L = (long)i * G + c; int job = -1, M = 0, N = 0;
#pragma unroll
        for (int k = 0; k < 4; ++k) { if (job < 0 && k < nj) { const int n = (j[k].M / BM) * (j[k].N / BM); if (L < n) { job = k; M = j[k].M; N = j[k].N; } else L -= n; } }
        if (job < 0) return false;
        const int nM = M / BM, nN = N / BM, nwg = nM * nN;
        int wgid = (int)L; { const int q = nwg / NXCD, r = nwg % NXCD, xcd = wgid % NXCD, off = wgid / NXCD; wgid = (xcd < r ? xcd * (q + 1) : r * (q + 1) + (xcd - r) * q) + off; }
        const int nig = WGM * nN, gid = wgid / nig, fm = gid * WGM, gsz = (nM - fm) < WGM ? (nM - fm) : WGM;
        u.pm = fm + ((wgid % nig) % gsz); u.pn = (wgid % nig) / gsz; u.job = job; return true;
    }
    __device__ __forceinline__ const char* ptrA(const Gemm&, const Unit& u) const { return (const char*)(u.job == 0 ? j[0].A : u.job == 1 ? j[1].A : u.job == 2 ? j[2].A : j[3].A); }
    __device__ __forceinline__ const char* ptrB(const Gemm&, const Unit& u) const { return (const char*)(u.job == 0 ? j[0].Bt : u.job == 1 ? j[1].Bt : u.job == 2 ? j[2].Bt : j[3].Bt); }
    __device__ __forceinline__ void a_ready(const Unit&) const {}
    __device__ __forceinline__ void done(const Unit&) const {}
};
struct EpiBf16Multi {
    static constexpr bool PERM = true, AFTER_DRAIN = false;
    bf16_t* O0; bf16_t* O1; bf16_t* O2; bf16_t* O3; int l0, l1, l2, l3;
    __device__ __forceinline__ void operator()(const f32x4 (&acc)[2][2][4][2], const Unit& u, int wr, int wc, int fr, int fq) const {
        bf16_t* O = u.job == 0 ? O0 : u.job == 1 ? O1 : u.job == 2 ? O2 : O3; const int ldc = u.job == 0 ? l0 : u.job == 1 ? l1 : u.job == 2 ? l2 : l3;
        const int row0 = u.pm * BM + wr * 64 + fr, col0 = u.pn * BM + wc * 32 + 8 * fq;
#pragma unroll
        for (int ai = 0; ai < 2; ++ai)
#pragma unroll
            for (int m = 0; m < 4; ++m) { bf16_t* rowp = O + (size_t)(row0 + ai * HALF + m * 16) * ldc + col0;
#pragma unroll
                for (int bj = 0; bj < 2; ++bj) { const f32x4 v0 = acc[ai][bj][m][0], v1 = acc[ai][bj][m][1];
                    u32x4 w; w.x = ::pk2(v0[0], v0[1]); w.y = ::pk2(v0[2], v0[3]); w.z = ::pk2(v1[0], v1[1]); w.w = ::pk2(v1[2], v1[3]);
                    *(u32x4*)(rowp + bj * HALF) = w; } }
    }
};
template <class Epi, class Sched, bool STAMP = false, bool F8 = false, int SA = 127, int SB = 127>
__device__ __forceinline__ void gemm_phase(PG8_LAS unsigned char* lds, const Gemm g, const Sched& S, const Epi& E, unsigned long long* stamps) {
    int tid_ = threadIdx.x; asm volatile("" : "+v"(tid_));
    const int tid = tid_, wid = __builtin_amdgcn_readfirstlane(tid >> 6), lane = tid & 63, wr = wid >> 2, wc = wid & 3, fr = lane & 15, fq = lane >> 4;
    const int K = g.K, nt = K / BK;
    int ts_lo = 0, ts_hi = 0, nts = 0; const unsigned long long rt_entry = STAMP ? (unsigned long long)wall_clock64() : 0ull;
#define PG8_STAMP() do { if (STAMP && wid == 0 && nts < 64) { const unsigned long long _c = (unsigned long long)clock64(); \
        ts_lo = (lane == nts) ? (int)(unsigned)_c : ts_lo; ts_hi = (lane == nts) ? (int)(unsigned)(_c >> 32) : ts_hi; ++nts; } } while (0)
    PG8_STAMP();
    unsigned voffA[2], voffB[2];
#pragma unroll
    for (int i = 0; i < 2; ++i) { int R, C; stage_rc(tid * 16 + i * 8192, R, C); const int Rb = Epi::PERM ? ((R & ~31) + perm32(R & 31)) : R;
        voffA[i] = (unsigned)(R * K + C) * 2u; voffB[i] = (unsigned)(Rb * K + C) * 2u; }
    const size_t kstep = (size_t)(BK * 2);
    const size_t hstep = (size_t)HALF * K * 2;
    const size_t tstep = 2 * hstep;
    const unsigned ldsw = (unsigned)wid * 1024u;
    const int aoff = lds_byte(wr * 64 + fr, fq * 8), boff = lds_byte(wc * 32 + fr, fq * 8);
#define PG8_SA(b, h) (((b) * 2 + (h)) * HTB)
#define PG8_SB(b, h) ((4 + (b) * 2 + (h)) * HTB)
#define PG8_STAGE(bufoff, gbase, voff) do { _Pragma("unroll") for (int _i = 0; _i < 2; ++_i) \
        __builtin_amdgcn_global_load_lds((const unsigned*)((const char*)(gbase) + (voff)[_i]), (PG8_LAS unsigned*)(lds + (bufoff) + ldsw + _i * 8192), 16, 0, 0); } while (0)
#define PG8_LDA(dst, b, h) do { _Pragma("unroll") for (int m = 0; m < 4; ++m) _Pragma("unroll") for (int k = 0; k < 2; ++k) dst[m][k] = *(const PG8_LAS bf16x8*)(lds + PG8_SA(b, h) + aoff + m * 2048 + k * 1024); } while (0)
#define PG8_LDB(dst, b, h) do { _Pragma("unroll") for (int n = 0; n < 2; ++n) _Pragma("unroll") for (int k = 0; k < 2; ++k) dst[n][k] = *(const PG8_LAS bf16x8*)(lds + PG8_SB(b, h) + boff + n * 2048 + k * 1024); } while (0)
#define PG8_MMA_BF(ai, bj, At, Bt) do { __builtin_amdgcn_s_setprio(1); _Pragma("unroll") for (int m = 0; m < 4; ++m) _Pragma("unroll") for (int n = 0; n < 2; ++n) _Pragma("unroll") for (int k = 0; k < 2; ++k) \
        acc[ai][bj][m][n] = __builtin_amdgcn_mfma_f32_16x16x32_bf16(Bt[n][k], At[m][k], acc[ai][bj][m][n], 0, 0, 0); __builtin_amdgcn_s_setprio(0); } while (0)
#define PG8_MMA_F8(ai, bj, At, Bt) do { __builtin_amdgcn_s_setprio(1); _Pragma("unroll") for (int m = 0; m < 4; ++m) _Pragma("unroll") for (int n = 0; n < 2; ++n) { \
        const i32x8v bq_ = __builtin_shufflevector(__builtin_bit_cast(i32x4v, Bt[n][0]), __builtin_bit_cast(i32x4v, Bt[n][1]), 0, 1, 2, 3, 4, 5, 6, 7); \
        const i32x8v aq_ = __builtin_shufflevector(__builtin_bit_cast(i32x4v, At[m][0]), __builtin_bit_cast(i32x4v, At[m][1]), 0, 1, 2, 3, 4, 5, 6, 7); \
          \
        asm volatile("v_mfma_scale_f32_16x16x128_f8f6f4 %0, %1, %2, %0, %3, %4 op_sel_hi:[0,0,0]" : "+v"(acc[ai][bj][m][n]) : "v"(bq_), "v"(aq_), "v"(f8_sa), "v"(f8_sb)); } __builtin_amdgcn_s_setprio(0); } while (0)
#define PG8_MMA(ai, bj, At, Bt) do { if constexpr (F8) PG8_MMA_F8(ai, bj, At, Bt); else PG8_MMA_BF(ai, bj, At, Bt); } while (0)
#define PG8_WAIT_V(n) asm volatile("s_waitcnt vmcnt(" #n ")" ::: "memory")
#define PG8_WAIT_L(n) asm volatile("s_waitcnt lgkmcnt(" #n ")" ::: "memory")
#define PG8_BAR __builtin_amdgcn_s_barrier()
#define PG8_SCHED __builtin_amdgcn_sched_barrier(0)
    Unit cur, nxt; int ui = 0;
    if (!S.next(0, cur)) return;
    f32x4 acc[2][2][4][2];
#pragma unroll
    for (int a = 0; a < 2; ++a)
#pragma unroll
        for (int b = 0; b < 2; ++b)
#pragma unroll
            for (int m = 0; m < 4; ++m)
#pragma unroll
                for (int n = 0; n < 2; ++n) acc[a][b][m][n] = (f32x4){0.f, 0.f, 0.f, 0.f};
    bf16x8 At[4][2], B0[2][2], B1[2][2];
    int f8_sa = SA, f8_sb = SB; if constexpr (F8) asm volatile("" : "+v"(f8_sa), "+v"(f8_sb));
    const char* cA = S.ptrA(g, cur) + (size_t)cur.pm * tstep; const char* cB = S.ptrB(g, cur) + (size_t)cur.pn * tstep;
    S.a_ready(cur);
    PG8_STAGE(PG8_SB(0, 0), cB, voffB); PG8_STAGE(PG8_SA(0, 0), cA, voffA); PG8_STAGE(PG8_SB(0, 1), cB + hstep, voffB); PG8_STAGE(PG8_SA(0, 1), cA + hstep, voffA);
    if (wr == 1) PG8_BAR;
    PG8_WAIT_V(4); PG8_BAR;
    PG8_STAGE(PG8_SB(1, 0), cB + kstep, voffB); PG8_STAGE(PG8_SA(1, 0), cA + kstep, voffA); PG8_STAGE(PG8_SB(1, 1), cB + hstep + kstep, voffB);
    PG8_WAIT_V(6); PG8_BAR;
    PG8_STAMP();
    for (;;) {
        const bool has_next = S.next(ui + 1, nxt);
        const char* nA = has_next ? S.ptrA(g, nxt) + (size_t)nxt.pm * tstep : cA; const char* nB = has_next ? S.ptrB(g, nxt) + (size_t)nxt.pn * tstep : cB;
        for (int t = 0; t < nt; t += 2) {
            const bool last = (t == nt - 2);
            const char* a1 = cA + (size_t)(t + 1) * kstep;
            const char* a2 = last ? nA : cA + (size_t)(t + 2) * kstep; const char* b2 = last ? nB : cB + (size_t)(t + 2) * kstep;
            const char* a3 = a2 + kstep; const char* b3 = b2 + kstep;
            if (last && has_next) S.a_ready(nxt);
            PG8_LDB(B0, 0, 0); PG8_SCHED; PG8_LDA(At, 0, 0); PG8_STAGE(PG8_SA(1, 1), a1 + hstep, voffA);
            PG8_WAIT_L(8); PG8_BAR; PG8_WAIT_L(0); PG8_MMA(0, 0, At, B0); PG8_BAR; PG8_SCHED;
            PG8_LDB(B1, 0, 1); PG8_STAGE(PG8_SB(0, 0), b2, voffB);
            PG8_BAR; PG8_WAIT_L(0); PG8_MMA(0, 1, At, B1); PG8_BAR;
            PG8_LDA(At, 0, 1); PG8_STAGE(PG8_SA(0, 0), a2, voffA);
            PG8_BAR; PG8_WAIT_L(0); PG8_MMA(1, 0, At, B0); PG8_BAR; PG8_SCHED;
            PG8_STAGE(PG8_SB(0, 1), b2 + hstep, voffB);
            PG8_WAIT_V(6); PG8_BAR; PG8_MMA(1, 1, At, B1); PG8_BAR;
            PG8_LDB(B0, 1, 0); PG8_SCHED; PG8_LDA(At, 1, 0); PG8_STAGE(PG8_SA(0, 1), a2 + hstep, voffA);
            PG8_WAIT_L(8); PG8_BAR; PG8_WAIT_L(0); PG8_MMA(0, 0, At, B0); PG8_BAR; PG8_SCHED;
            PG8_LDB(B1, 1, 1); PG8_STAGE(PG8_SB(1, 0), b3, voffB);
            PG8_BAR; PG8_WAIT_L(0); PG8_MMA(0, 1, At, B1); PG8_BAR;
            PG8_LDA(At, 1, 1); PG8_STAGE(PG8_SA(1, 0), a3, voffA);
            PG8_BAR; PG8_WAIT_L(0); PG8_MMA(1, 0, At, B0); PG8_BAR; PG8_SCHED;
            PG8_STAGE(PG8_SB(1, 1), b3 + hstep, voffB);
            PG8_WAIT_V(6); PG8_BAR; PG8_MMA(1, 1, At, B1); PG8_BAR;
        }
        PG8_STAMP();
        if constexpr (F8) asm volatile("s_nop 15\n\ts_nop 15" ::: "memory");
        if constexpr (!Epi::AFTER_DRAIN) { E(acc, cur, wr, wc, fr, fq); S.done(cur); }
        PG8_STAMP();
        if (!has_next) break;
#pragma unroll
        for (int a = 0; a < 2; ++a)
#pragma unroll
            for (int b = 0; b < 2; ++b)
#pragma unroll
                for (int m = 0; m < 4; ++m)
#pragma unroll
                    for (int n = 0; n < 2; ++n) acc[a][b][m][n] = (f32x4){0.f, 0.f, 0.f, 0.f};
        cur = nxt; cA = nA; cB = nB; ++ui;
    }
    PG8_WAIT_V(0);
    if (wr == 0) PG8_BAR;
    PG8_BAR;
    if constexpr (Epi::AFTER_DRAIN) { E.fused(acc, cur, wr, wc, fr, fq, lds, wid, lane); S.done(cur); }
    PG8_STAMP();
    if (STAMP && wid == 0) { stamps[lane] = lane < nts ? (((unsigned long long)(unsigned)ts_hi << 32) | (unsigned)ts_lo) : 0ull;
        if (lane == 62) stamps[62] = rt_entry; if (lane == 63) stamps[63] = (unsigned long long)wall_clock64(); }
#undef PG8_STAMP
#undef PG8_SA
#undef PG8_SB
#undef PG8_STAGE
#undef PG8_LDA
#undef PG8_LDB
#undef PG8_MMA
#undef PG8_MMA_BF
#undef PG8_MMA_F8
#undef PG8_WAIT_V
#undef PG8_WAIT_L
#undef PG8_BAR
#undef PG8_SCHED
}
}
#define XB_TMO      128
#define XB_XCNT(j)  (256  + 64 * (j))
#define XB_XSUB(j)  (1280 + 64 * (j))
#define XB_XGEN(j)  (2304 + 64 * (j))
#define XB_TOP      3328
#define XB_TOPGEN   3392
#define XCD_BAR_WORDS 3456
#define XB_SPIN_CAP (1u << 18)

__device__ __forceinline__ unsigned xb_ld(unsigned* p)              { return __hip_atomic_load(p, __ATOMIC_RELAXED, __HIP_MEMORY_SCOPE_AGENT); }
__device__ __forceinline__ unsigned xb_add(unsigned* p, unsigned v) { return __hip_atomic_fetch_add(p, v, __ATOMIC_RELAXED, __HIP_MEMORY_SCOPE_AGENT); }
__device__ __forceinline__ unsigned xb_xcc_id() { return (unsigned)__builtin_amdgcn_s_getreg((3 << 11) | 20) & 0xFu; }
#define XB_SPIN(cond, bar) do { unsigned _sp = 0; while (cond) { __builtin_amdgcn_s_sleep(1); \
    if ((++_sp & 255u) == 0u) { if (xb_ld(&(bar)[XB_TMO])) break; if (_sp > XB_SPIN_CAP) { atomicAdd(&(bar)[XB_TMO], 1u); break; } } } } while (0)

struct XcdBarrier {
    unsigned* bar; unsigned x;
    volatile LAS unsigned* st;
};

__device__ __forceinline__ XcdBarrier xcd_barrier_post(unsigned* bar, volatile LAS unsigned* st) {
    XcdBarrier b; b.bar = bar; b.x = xb_xcc_id(); b.st = st;
    if (threadIdx.x == 0) (void)xb_add(&bar[XB_XCNT(b.x)], 1u);
    return b;
}
__device__ __forceinline__ void xcd_barrier_complete(unsigned* bar, unsigned x, unsigned& nloc, unsigned& nx) {
    const unsigned G = gridDim.x * gridDim.y * gridDim.z;
    unsigned sum, cnt, mine, sp = 0u;
    for (;;) {
        sum = 0u; cnt = 0u; mine = 0u;
#pragma unroll
        for (unsigned j = 0; j < 16; ++j) { const unsigned c = xb_ld(&bar[XB_XCNT(j)]); sum += c; cnt += (c > 0u) ? 1u : 0u; mine = (j == x) ? c : mine; }
        if (sum == G) break;
        __builtin_amdgcn_s_sleep(1);
        if ((++sp & 255u) == 0u) { if (xb_ld(&bar[XB_TMO])) break; if (sp > XB_SPIN_CAP) { atomicAdd(&bar[XB_TMO], 1u); break; } }
    }
    nloc = mine > 0u ? mine : 1u; nx = cnt > 0u ? cnt : 1u;
}

__device__ __forceinline__ void xcd_barrier(const XcdBarrier& b) {
    asm volatile("s_waitcnt vmcnt(0)" ::: "memory");
    __syncthreads();
    if (threadIdx.x == 0) {
        unsigned* bar = b.bar;
        __builtin_amdgcn_s_waitcnt(0);
        unsigned nloc = b.st[0], nx = b.st[1];
        if (nloc == 0u) { xcd_barrier_complete(bar, b.x, nloc, nx); b.st[0] = nloc; b.st[1] = nx; }
        const unsigned old = xb_add(&bar[XB_XSUB(b.x)], 1u);
        const unsigned gen = old / nloc;
        if (old + 1u == (gen + 1u) * nloc) {
            __builtin_amdgcn_fence(__ATOMIC_RELEASE, "agent");
            asm volatile("s_waitcnt vmcnt(0)" ::: "memory");
            const unsigned og = xb_add(&bar[XB_TOP], 1u);
            const unsigned tg = og / nx;
            if (og + 1u == (tg + 1u) * nx) xb_add(&bar[XB_TOPGEN], 1u);
            else XB_SPIN(xb_ld(&bar[XB_TOPGEN]) == tg, bar);
            __builtin_amdgcn_fence(__ATOMIC_ACQUIRE, "agent");
            asm volatile("s_waitcnt vmcnt(0)" ::: "memory");
        } else {
            XB_SPIN(xb_ld(&bar[XB_TOPGEN]) == gen, bar);
            __builtin_amdgcn_fence(__ATOMIC_ACQUIRE, "agent");
            asm volatile("s_waitcnt vmcnt(0)" ::: "memory");
        }
    }
    __syncthreads();
}
typedef const __attribute__((address_space(4))) Args* ArgsP;
struct Ctx {
    ArgsP a; LAS unsigned char* lds; int tid, lane, wave, G, bid;
};

template <bool F8> DI void transpose_job(const Ctx& c, int& rr, const float* src, int ld, int col0, int nvalid, void* dstv, int K, int row0, int ncols, float sc) {
    LAS float* tile = (LAS float*)c.lds;
    const int tilesN = ncols / 256, nt = tilesN * (K / 64);
    int t = c.bid - rr % c.G; if (t < 0) t += c.G;
    rr += nt;
    for (; t < nt; t += c.G) {
        const int tn = t % tilesN, tk = t / tilesN;
        {   const int kk = c.tid >> 4, n4 = (c.tid & 15) * 4;
            f32x4 v[2][4];
#pragma unroll
            for (int i = 0; i < 2; ++i)
#pragma unroll
                for (int j = 0; j < 4; ++j) v[i][j] = *(const f32x4*)(src + (size_t)(tk * 64 + kk + 32 * i) * ld + col0 + tn * 256 + 64 * j + n4);
#pragma unroll
            for (int i = 0; i < 2; ++i)
#pragma unroll
                for (int j = 0; j < 4; ++j)
#pragma unroll
                    for (int e = 0; e < 4; ++e) tile[j * 4160 + (kk + 32 * i) * 65 + n4 + e] = (tn * 256 + 64 * j + n4 + e < nvalid) ? v[i][j][e] : 0.f;
        }
        __syncthreads();
        {   const int n = c.tid >> 3, k8 = (c.tid & 7) * 8;
#pragma unroll
            for (int j = 0; j < 4; ++j) {
                float v[8];
#pragma unroll
                for (int e = 0; e < 8; ++e) v[e] = tile[j * 4160 + (k8 + e) * 65 + n];
                if constexpr (F8) { u32x2 w; w.x = pk4_f8(v[0], v[1], v[2], v[3], sc); w.y = pk4_f8(v[4], v[5], v[6], v[7], sc);
                    *(u32x2*)((unsigned char*)dstv + (size_t)(row0 + tn * 256 + 64 * j + n) * K + tk * 64 + k8) = w; }
                else { u32x4 w; w.x = pk2(v[0], v[1]); w.y = pk2(v[2], v[3]); w.z = pk2(v[4], v[5]); w.w = pk2(v[6], v[7]);
                    *(u32x4*)((bf16_t*)dstv + (size_t)(row0 + tn * 256 + 64 * j + n) * K + tk * 64 + k8) = w; } } }
        __syncthreads();
    }
}
DI void convert_job(const Ctx& c, const float* src, bf16_t* dst, unsigned char* dst8, size_t n, bool nt) {
    const size_t stride = (size_t)c.G * NTHREADS * 8;
    for (size_t i = ((size_t)c.bid * NTHREADS + c.tid) * 8; i < n; i += stride) {
        f32x4 a, b;
        if (nt) { a = __builtin_nontemporal_load((const f32x4*)(src + i)); b = __builtin_nontemporal_load((const f32x4*)(src + i + 4)); }
        else { a = *(const f32x4*)(src + i); b = *(const f32x4*)(src + i + 4); }
        if (dst) { u32x4 w; w.x = pk2(a[0], a[1]); w.y = pk2(a[2], a[3]); w.z = pk2(b[0], b[1]); w.w = pk2(b[2], b[3]); *(u32x4*)(dst + i) = w; }
        u32x2 w8; w8.x = pk4_f8(a[0], a[1], a[2], a[3], F8_ACT); w8.y = pk4_f8(b[0], b[1], b[2], b[3], F8_ACT); *(u32x2*)(dst8 + i) = w8;
    }
}
DI bool fp6_interleaved() {
    f32x16 a, b;
#pragma unroll
    for (int i = 0; i < 16; ++i) { a[i] = 1.0f; b[i] = 2.0f; }
    const f32x32 d = __builtin_amdgcn_cvt_scalef32_pk32_f32_fp6(__builtin_amdgcn_cvt_scalef32_2xpk16_fp6_f32(a, b, 1.0f), 1.0f);
    return d[1] == 2.0f;
}
DI u32x6 fp6_pack32(const float (&e)[32], bool il) {
    f32x16 a, b;
    if (il) {
#pragma unroll
        for (int i = 0; i < 16; ++i) { a[i] = e[2 * i]; b[i] = e[2 * i + 1]; } }
    else {
#pragma unroll
        for (int i = 0; i < 16; ++i) { a[i] = e[i]; b[i] = e[16 + i]; } }
    return __builtin_amdgcn_cvt_scalef32_2xpk16_fp6_f32(a, b, 1.0f);
}
DI bool fp4_swapped() {
    const unsigned w = __builtin_amdgcn_cvt_scalef32_pk_fp4_f32(0u, 1.0f, 2.0f, 1.0f, 0);
    const f32x2 d = __builtin_amdgcn_cvt_scalef32_pk_f32_fp4(w, 1.0f, 0);
    return d.x == 2.0f;
}
DI u32x4 fp4_pack32(const float (&e)[32], bool sw) {
    u32x4 r;
#pragma unroll
    for (int dw = 0; dw < 4; ++dw) {
        unsigned w = 0u;
        const float e0 = sw ? e[8 * dw + 1] : e[8 * dw], e1 = sw ? e[8 * dw] : e[8 * dw + 1], e2 = sw ? e[8 * dw + 3] : e[8 * dw + 2], e3 = sw ? e[8 * dw + 2] : e[8 * dw + 3];
        const float e4 = sw ? e[8 * dw + 5] : e[8 * dw + 4], e5 = sw ? e[8 * dw + 4] : e[8 * dw + 5], e6 = sw ? e[8 * dw + 7] : e[8 * dw + 6], e7 = sw ? e[8 * dw + 6] : e[8 * dw + 7];
        w = __builtin_amdgcn_cvt_scalef32_pk_fp4_f32(w, e0, e1, 1.0f, 0); w = __builtin_amdgcn_cvt_scalef32_pk_fp4_f32(w, e2, e3, 1.0f, 1);
        w = __builtin_amdgcn_cvt_scalef32_pk_fp4_f32(w, e4, e5, 1.0f, 2); w = __builtin_amdgcn_cvt_scalef32_pk_fp4_f32(w, e6, e7, 1.0f, 3);
        r[dw] = w; }
    return r;
}
DI void fp4_unpack32(const u32x4 p, float (&d)[32]) {
#pragma unroll
    for (int dw = 0; dw < 4; ++dw) {
        const f32x2 a = __builtin_amdgcn_cvt_scalef32_pk_f32_fp4(p[dw], 1.0f, 0), b = __builtin_amdgcn_cvt_scalef32_pk_f32_fp4(p[dw], 1.0f, 1);
        const f32x2 cc = __builtin_amdgcn_cvt_scalef32_pk_f32_fp4(p[dw], 1.0f, 2), dd = __builtin_amdgcn_cvt_scalef32_pk_f32_fp4(p[dw], 1.0f, 3);
        d[8 * dw] = a.x; d[8 * dw + 1] = a.y; d[8 * dw + 2] = b.x; d[8 * dw + 3] = b.y; d[8 * dw + 4] = cc.x; d[8 * dw + 5] = cc.y; d[8 * dw + 6] = dd.x; d[8 * dw + 7] = dd.y; }
}
template <int BITS> DI void convert_table_lp(const Ctx& c, const float* src, unsigned char* dst, float* inv_scale, int row_lo, int row_hi, int brank, int nblk) {
    const bool il = (BITS == 6) ? fp6_interleaved() : fp4_swapped();
    constexpr float TOP = (BITS == 6) ? 7.4f : 6.0f;
    for (int row = row_lo + brank * 8 + c.wave; row < row_hi; row += nblk * 8) {
        const float* sp = src + (size_t)row * DM + 4 * c.lane;
        f32x4 v[8];
#pragma unroll
        for (int j = 0; j < 8; ++j) v[j] = __builtin_nontemporal_load((const f32x4*)(sp + 256 * j));
        float mx = 0.f;
#pragma unroll
        for (int j = 0; j < 8; ++j) mx = fmaxf(mx, fmaxf(fmaxf(fabsf(v[j][0]), fabsf(v[j][1])), fmaxf(fabsf(v[j][2]), fabsf(v[j][3]))));
        mx = wave_max(mx);
        const float sc = mx > 0.f ? TOP / mx : 1.0f;
        float e[32];
#pragma unroll
        for (int j = 0; j < 8; ++j)
#pragma unroll
            for (int q = 0; q < 4; ++q) e[4 * j + q] = v[j][q] * sc;
        if constexpr (BITS == 6) {
            const u32x6 pk = fp6_pack32(e, il);
            u32x2* dp = (u32x2*)(dst + (size_t)row * 1536 + 24 * c.lane);
            dp[0] = (u32x2){pk[0], pk[1]}; dp[1] = (u32x2){pk[2], pk[3]}; dp[2] = (u32x2){pk[4], pk[5]};
        } else {
            __builtin_nontemporal_store(fp4_pack32(e, il), (u32x4*)(dst + (size_t)row * 1024 + 16 * c.lane));
        }
        if (c.lane == 0) inv_scale[row] = mx > 0.f ? mx * (1.0f / TOP) : 1.0f;
    }
}
DI void split_store(LAS unsigned char* hi, LAS unsigned char* lo, const f32x4 v) {
    u32x2 h, l; h.x = pk2(v[0], v[1]); h.y = pk2(v[2], v[3]);
    l.x = pk2(v[0] - bf_lo(h.x), v[1] - bf_hi(h.x)); l.y = pk2(v[2] - bf_lo(h.y), v[3] - bf_hi(h.y));
    *(LAS u32x2*)hi = h; *(LAS u32x2*)lo = l; }
DI void fold_peer(const Ctx& c) {
    constexpr int FP_KH = 0, FP_KL = 128 * 272, FP_WH = 2 * 128 * 272, FP_WL = FP_WH + 64 * 272;
    LAS unsigned char* L = c.lds;
    bf16_t* WP = (bf16_t*)(c.a->ws + WS_WP);
    const int ntile = 4 * 8 * 32, per = (ntile + c.G - 1) / c.G;
    int last = -1;
    for (int t = c.bid * per; t < ntile && t < (c.bid + 1) * per; ++t) {
        const int ihp = t >> 5, dt = t & 31, i = ihp >> 3, hp = ihp & 7, p = hp & 1;
        __syncthreads();
        if (ihp != last) { last = ihp;
            const float* ks = c.a->peer_keys + (size_t)(i * 2 + p) * 128 * 128;
            for (int e = c.tid * 4; e < 128 * 128; e += NTHREADS * 4) { const f32x4 v = *(const f32x4*)(ks + e); const int n = e >> 7, cc = e & 127;
                split_store(L + FP_KH + n * 272 + cc * 2, L + FP_KL + n * 272 + cc * 2, v); } }
        {   const float* wq = c.a->peer_w_q + (size_t)i * DM * 1024 + (size_t)(dt * 64) * 1024 + hp * 128;
            for (int e = c.tid * 4; e < 64 * 128; e += NTHREADS * 4) { const int d = e >> 7, cc = e & 127; const f32x4 v = *(const f32x4*)(wq + (size_t)d * 1024 + cc);
                split_store(L + FP_WH + d * 272 + cc * 2, L + FP_WL + d * 272 + cc * 2, v); } }
        __syncthreads();
        {
            const int r16 = c.lane & 15, q4 = c.lane >> 4;
            f32x4 acc[4];
#pragma unroll
            for (int t4 = 0; t4 < 4; ++t4) acc[t4] = (f32x4){0.f, 0.f, 0.f, 0.f};
#pragma unroll
            for (int ks = 0; ks < 4; ++ks) {
                const int ao = (16 * c.wave + r16) * 272 + (32 * ks + 8 * q4) * 2;
                const bf16x8 ah = *(const LAS bf16x8*)(L + FP_KH + ao), al = *(const LAS bf16x8*)(L + FP_KL + ao);
#pragma unroll
                for (int t4 = 0; t4 < 4; ++t4) {
                    const int bo = (16 * t4 + r16) * 272 + (32 * ks + 8 * q4) * 2;
                    const bf16x8 bh = *(const LAS bf16x8*)(L + FP_WH + bo), bl = *(const LAS bf16x8*)(L + FP_WL + bo);
                    acc[t4] = MFMA16(al, bh, acc[t4]); acc[t4] = MFMA16(ah, bl, acc[t4]); acc[t4] = MFMA16(ah, bh, acc[t4]);
                }
            }
            const float* g1p = c.a->ln_mix_g + i * DM + dt * 64; const float* b1p = c.a->ln_mix_b + i * DM + dt * 64;
            float p1[4] = {0.f, 0.f, 0.f, 0.f}, p2[4] = {0.f, 0.f, 0.f, 0.f};
#pragma unroll
            for (int t4 = 0; t4 < 4; ++t4) { const float gd = g1p[16 * t4 + r16], bd = b1p[16 * t4 + r16];
#pragma unroll
                for (int e = 0; e < 4; ++e) { const unsigned wgb = pk2(acc[t4][e] * gd, 0.f);
                    WP[((size_t)i * 1024 + hp * 128 + 16 * c.wave + 4 * q4 + e) * DM + dt * 64 + 16 * t4 + r16] = (bf16_t)(wgb & 0xffffu);
                    p1[e] += bf_lo(wgb); p2[e] += bd * acc[t4][e]; } }
#pragma unroll
            for (int e = 0; e < 4; ++e) {
                p1[e] = row_sum16(p1[e]); p2[e] = row_sum16(p2[e]);
                if (r16 == 0) { const size_t ix = (size_t)(i * 32 + dt) * 1024 + hp * 128 + 16 * c.wave + 4 * q4 + e;
                    ((float*)(c.a->ws + WS_CP1))[ix] = p1[e]; ((float*)(c.a->ws + WS_CP2))[ix] = p2[e]; } }
        }
    }
    __syncthreads();
}
#ifndef REP_PA
#define REP_PA 1
#define REP_PB 1
#define REP_PC 1
#endif
DI void phase_prologue(const Ctx& c) {
    unsigned char* ws = c.a->ws;
    convert_job(c, c.a->x, (bf16_t*)(ws + WS_XB), ws + WS_X8, (size_t)M_TOK * DM, false);
    convert_job(c, c.a->mem, (bf16_t*)nullptr, ws + WS_MEMB, (size_t)NMEM * DM, false);
    int rr = 0;
#pragma unroll 1
    for (int rpa = 0; rpa < REP_PA; ++rpa) {
    for (int li = 0; li < 2; ++li) {
        const float* src = c.a->gdn_w_in + (size_t)li * DM * 3600; unsigned char* dst = ws + WS_WG + (size_t)li * GDN_NP * DM;
        transpose_job<true>(c, rr, src, 3600, 0, 3072, dst, DM, 0, 3072, F8_WIN);
        transpose_job<true>(c, rr, src, 3600, 3088, 512, dst, DM, GC_QM, 512, F8_WIN);
        transpose_job<true>(c, rr, src, 3600, 3072, 16, dst, DM, GC_B, 256, F8_WIN);
        const float* s2 = c.a->sb_w_in + (size_t)li * DM * 3584; unsigned char* d2 = ws + WS_WSB + (size_t)li * SB_NP * DM;
        transpose_job<true>(c, rr, s2, 3584, 0, 2048, d2, DM, 0, 2048, F8_WIN);
        transpose_job<true>(c, rr, s2, 3584, 3072, 512, d2, DM, SC_QM, 512, F8_WIN);
        transpose_job<true>(c, rr, s2, 3584, 2048, 1024, ws + WS_WSBV + (size_t)li * 1024 * DM, DM, 0, 1024, F8_WIN);
    }
    for (int i = 0; i < DEPTH; ++i) {
        const float* kv = c.a->mem_w_kv + (size_t)i * DM * 1024;
        transpose_job<true>(c, rr, kv, 1024, 0, 512, ws + WS_WK, DM, i * 512, 512, F8_WIN);
        transpose_job<true>(c, rr, kv, 1024, 512, 512, ws + WS_WV, DM, i * 512, 512, F8_WIN);
        transpose_job<true>(c, rr, c.a->w_out + (size_t)i * MIXW * DM, DM, 0, DM, ws + WS_WO + (size_t)i * DM * MIXW, MIXW, 0, DM, F8_WOUT);
    }
    }
#pragma unroll 1
    for (int rpb = 0; rpb < REP_PB; ++rpb) fold_peer(c);
}

#ifndef CTE_G
#define CTE_G 1024
#define CTE_S 2560
#endif
constexpr int CT_EARLY_G = CTE_G, CT_EARLY_S = CTE_S;
DI void convert_tables(const Ctx& c, int l0, int brank, int nblk) {
    if (nblk <= 0) return;
    unsigned char* ws = c.a->ws;
    convert_table_lp<PEER_UBITS>(c, c.a->peer_u, ws + WS_UT, (float*)(ws + WS_USC), l0 * 16384 + CT_EARLY_G, (l0 + 1) * 16384, brank, nblk);
    convert_table_lp<PEER_UBITS>(c, c.a->peer_u, ws + WS_UT, (float*)(ws + WS_USC), (l0 + 1) * 16384 + CT_EARLY_S, (l0 + 2) * 16384, brank, nblk);
    convert_table_lp<PEER_VBITS>(c, c.a->peer_v, ws + WS_VTAB, (float*)(ws + WS_VSC), l0 * 16384 + CT_EARLY_G, (l0 + 1) * 16384, brank, nblk);
    convert_table_lp<PEER_VBITS>(c, c.a->peer_v, ws + WS_VTAB, (float*)(ws + WS_VSC), (l0 + 1) * 16384 + CT_EARLY_S, (l0 + 2) * 16384, brank, nblk);
}
DI void convert_tables_early(const Ctx& c, int layer, int brank, int nblk) {
    if (nblk <= 0 || brank < 0) return;
    unsigned char* ws = c.a->ws;
    const int a = (layer & 1) ? CT_EARLY_S : CT_EARLY_G;
    convert_table_lp<PEER_UBITS>(c, c.a->peer_u, ws + WS_UT, (float*)(ws + WS_USC), layer * 16384, layer * 16384 + a, brank, nblk);
    convert_table_lp<PEER_VBITS>(c, c.a->peer_v, ws + WS_VTAB, (float*)(ws + WS_VSC), layer * 16384, layer * 16384 + a, brank, nblk);
}

DI void peer_c12_finalize(const Ctx& c, int i, int brank, int nblk) {
    if (brank < 0 || nblk <= 0) return;
    const float* cp1 = (const float*)(c.a->ws + WS_CP1) + (size_t)i * 32 * 1024; const float* cp2 = (const float*)(c.a->ws + WS_CP2) + (size_t)i * 32 * 1024;
    float* c12 = (float*)(c.a->ws + WS_C12) + (size_t)i * 2 * 1024;
    for (int n = brank * NTHREADS + c.tid; n < 1024; n += nblk * NTHREADS) {
        float v1[32], v2[32];
#pragma unroll
        for (int dt = 0; dt < 32; ++dt) { v1[dt] = cp1[dt * 1024 + n]; v2[dt] = cp2[dt * 1024 + n]; }
        float s1 = 0.f, s2 = 0.f;
#pragma unroll
        for (int dt = 0; dt < 32; ++dt) { s1 += v1[dt]; s2 += v2[dt]; }
        c12[n] = s1; c12[1024 + n] = s2; }
}
DI int swap23(int x) { return (x & ~12) | ((x & 4) << 1) | ((x & 8) >> 1); }
constexpr int G2_KBF = 0, G2_QBF = 17408, G2_RHST = 34816, G2_KDT = 71680, G2_MM = 90112, G2_TM = 107520, G2_XS = 124928, G2_GATE = 131456;
DI void phase_gdn_prep(const Ctx& c, int li) {
    unsigned char* ws = c.a->ws;
    const bf16_t* P = (const bf16_t*)(ws + WS_P);
    const float* convw = c.a->gdn_conv + (size_t)li * 4 * 2048;
    LAS unsigned char* L = c.lds;
    LAS float* gate = (LAS float*)(L + G2_GATE);
    LAS float* Mm = (LAS float*)(L + G2_MM);
    LAS float* Tm = (LAS float*)(L + G2_TM);
    LAS float* Xs = (LAS float*)(L + G2_XS);
    const int tid = c.tid, lane = c.lane, w = c.wave;
    unsigned short gb_n = 0, ga_n = 0;
    if (w == 0 && c.bid < 2048) { const size_t row = (size_t)((c.bid >> 3) * 64 + lane) * LDP; gb_n = P[row + GC_B + (c.bid & 7)]; ga_n = P[row + GC_A + (c.bid & 7)]; }
    for (int u = c.bid; u < 2048; u += c.G) {
        const int h = u & 7, n = u >> 3, t0 = n * 64;
        unsigned char* rec = ws + WS_REC + (size_t)(h * 256 + n) * REC_BYTES;
        const unsigned short gb_c = gb_n, ga_c = ga_n;
        if (w == 0 && u + c.G < 2048) { const int un = u + c.G; const size_t row = (size_t)((un >> 3) * 64 + lane) * LDP; gb_n = P[row + GC_B + (un & 7)]; ga_n = P[row + GC_A + (un & 7)]; }
#ifndef RQ0
#define RQ0 1
#define RQ1 1
#define RQ2 1
#define RQ3 1
#define RQ4 1
#endif
#pragma unroll 1
        for (int rq0 = 0; rq0 < RQ0; ++rq0) {
        for (int e = tid; e < 64 * 68; e += NTHREADS) Tm[e] = 0.f;
        if (w == 0) {
            const float b = bf2f(gb_c), a = bf2f(ga_c);
            const float beta = sigmoidf_(b);
            const float xx = a + c.a->gdn_dt_bias[li * 8 + h];
            const float sp = fmaxf(xx, 0.f) + __logf(1.0f + __expf(-fabsf(xx)));
            float g = -__expf(c.a->gdn_a_log[li * 8 + h]) * sp;
#pragma unroll
            for (int o = 1; o < 64; o <<= 1) { const float v = __shfl_up(g, o); if (lane >= o) g += v; }
            const float gl = __shfl(g, 63);
            gate[lane] = beta; gate[64 + lane] = g; gate[128 + lane] = __expf(g); gate[192 + lane] = __expf(gl - g);
            if (lane == 0) ((float*)(ws + WS_GAM))[h * 256 + n] = __expf(gl);
        }
        __syncthreads();
        }
#pragma unroll 1
        for (int rq1 = 0; rq1 < RQ1; ++rq1)
#pragma unroll 1
        for (int sec = 0; sec < 3; ++sec) {
            int tid1 = tid; asm volatile("" : "+v"(tid1));
            const int cg = tid1 & 15, sA = tid1 >> 4;
            const int col = (sec == 0 ? GC_Q + (h >> 1) * 128 : sec == 1 ? GC_K + (h >> 1) * 128 : GC_V + h * 128) + cg * 8;
            u32x4 xr[2][4]; f32x4 cw[4][2];
#pragma unroll
            for (int it = 0; it < 2; ++it)
#pragma unroll
                for (int jj = 0; jj < 4; ++jj) { const int tt = t0 + sA + 32 * it - 3 + jj; const int tc = tt < 0 ? 0 : tt;
                    u32x4 xv = *(const u32x4*)(P + (size_t)tc * LDP + col); if (tt < 0) xv = (u32x4){0u, 0u, 0u, 0u}; xr[it][jj] = xv; }
#pragma unroll
            for (int jj = 0; jj < 4; ++jj) { cw[jj][0] = *(const f32x4*)(convw + jj * 2048 + col); cw[jj][1] = *(const f32x4*)(convw + jj * 2048 + col + 4); }
#pragma unroll
            for (int it = 0; it < 2; ++it) {
                const int s = sA + 32 * it;
                float acc[8];
#pragma unroll
                for (int e = 0; e < 8; ++e) acc[e] = 0.f;
#pragma unroll
                for (int jj = 0; jj < 4; ++jj) {
                    const u32x4 xv = xr[it][jj];
                    const f32x4 w0 = cw[jj][0], w1 = cw[jj][1];
                    acc[0] += w0[0] * bf_lo(xv.x); acc[1] += w0[1] * bf_hi(xv.x); acc[2] += w0[2] * bf_lo(xv.y); acc[3] += w0[3] * bf_hi(xv.y);
                    acc[4] += w1[0] * bf_lo(xv.z); acc[5] += w1[1] * bf_hi(xv.z); acc[6] += w1[2] * bf_lo(xv.w); acc[7] += w1[3] * bf_hi(xv.w);
                }
                float ss = 0.f;
#pragma unroll
                for (int e = 0; e < 8; ++e) { acc[e] = siluf_(acc[e]); ss += acc[e] * acc[e]; }
                const float beta = gate[s], eg = gate[128 + s], egl = gate[192 + s];
                if (sec < 2) {
                    ss = row_sum16(ss);
                    const float r = __builtin_amdgcn_rsqf(ss + RMS_EPS) * (sec == 0 ? 0.08838834764831845f : 1.0f);
#pragma unroll
                    for (int e = 0; e < 8; ++e) acc[e] *= r;
                    u32x4 wv; wv.x = pk2(acc[0], acc[1]); wv.y = pk2(acc[2], acc[3]); wv.z = pk2(acc[4], acc[5]); wv.w = pk2(acc[6], acc[7]);
                    *(LAS u32x4*)(L + (sec == 0 ? G2_QBF : G2_KBF) + s * 272 + cg * 16) = wv;
                    if (sec == 0) {
                        u32x2 lo, hi; lo.x = pk2(acc[0] * eg, acc[1] * eg); lo.y = pk2(acc[2] * eg, acc[3] * eg); hi.x = pk2(acc[4] * eg, acc[5] * eg); hi.y = pk2(acc[6] * eg, acc[7] * eg);
                        bf16_t* qg = (bf16_t*)(rec + REC_QG) + s * 128 + 16 * (cg >> 1) + 4 * (cg & 1);
                        *(u32x2*)qg = lo; *(u32x2*)(qg + 8) = hi;
                    } else {
                        const int ps = (s & ~15) | swap23(s & 15);
#pragma unroll
                        for (int e = 0; e < 8; ++e) {
                            *(LAS bf16_t*)(L + G2_RHST + (128 + cg * 8 + e) * 144 + (s ^ ((cg & 7) << 3)) * 2) = f2bf(acc[e] * beta * eg);
                            *(LAS bf16_t*)(L + G2_KDT + (cg * 8 + e) * 144 + (ps ^ ((cg & 7) << 3)) * 2) = f2bf(acc[e] * egl); }
                    }
                } else {
#pragma unroll
                    for (int e = 0; e < 8; ++e) *(LAS bf16_t*)(L + G2_RHST + (cg * 8 + e) * 144 + (s ^ ((cg & 7) << 3)) * 2) = f2bf(acc[e] * beta);
                }
            }
        }
        __syncthreads();
#pragma unroll 1
        for (int rq2 = 0; rq2 < RQ2; ++rq2)
        {   int lane2 = lane; asm volatile("" : "+v"(lane2));
            const int sel = w >> 2, i = w & 3, r = lane2 & 15, q = lane2 >> 4;
            bf16x8 af[4];
#pragma unroll
            for (int ks = 0; ks < 4; ++ks) af[ks] = *(const LAS bf16x8*)(L + (sel ? G2_QBF : G2_KBF) + (16 * i + r) * 272 + (32 * ks + 8 * q) * 2);
#pragma unroll
            for (int j = 0; j < 4; ++j) {
                f32x4 acc = {0.f, 0.f, 0.f, 0.f};
#pragma unroll
                for (int ks = 0; ks < 4; ++ks) { const bf16x8 bfr = *(const LAS bf16x8*)(L + G2_KBF + (16 * j + r) * 272 + (32 * ks + 8 * q) * 2); acc = MFMA16(af[ks], bfr, acc); }
                const int s = 16 * j + r; const float gs = gate[64 + s];
#pragma unroll
                for (int e = 0; e < 4; ++e) {
                    const int cc = 16 * i + 4 * q + e; const float dec = __expf(gate[64 + cc] - gs);
                    if (sel == 0) Mm[cc * 68 + s] = (s < cc) ? gate[cc] * acc[e] * dec : 0.f;
                    else { const int ps = (s & ~15) | swap23(s & 15); ((bf16_t*)(rec + REC_AQK))[cc * 64 + ps] = f2bf((s <= cc) ? acc[e] * dec : 0.f); }
                }
            }
        }
        __syncthreads();
#pragma unroll 1
        for (int rq3 = 0; rq3 < RQ3; ++rq3) { if (rq3) __syncthreads();
        if (w < 4 && lane < 16) {
            int lane3 = lane; asm volatile("" : "+v"(lane3));
            float mrow[16], tr[16];
#pragma unroll
            for (int i = 0; i < 16; ++i) mrow[i] = Mm[(16 * w + i) * 68 + 16 * w + lane3];
#pragma unroll
            for (int i = 0; i < 16; ++i) {
                float acc = (lane3 == i) ? 1.f : 0.f;
#pragma unroll
                for (int j = 0; j < i; ++j) acc -= __int_as_float(__builtin_amdgcn_readlane(__float_as_int(mrow[i]), j)) * tr[j];
                tr[i] = acc;
            }
#pragma unroll
            for (int i = 0; i < 16; ++i) Tm[(16 * w + i) * 68 + 16 * w + lane3] = tr[i];
        }
        __syncthreads();
#pragma unroll 1
        for (int d = 1; d < 4; ++d) {
            if (w < 4 - d) {
                int l3 = lane; asm volatile("" : "+v"(l3));
                const int J = w, I = w + d, r16 = l3 & 15, q4 = l3 >> 4;
                f32x4 x = {0.f, 0.f, 0.f, 0.f};
                for (int K = J; K < I; ++K)
#pragma unroll
                    for (int ks = 0; ks < 4; ++ks) x = __builtin_amdgcn_mfma_f32_16x16x4f32(Mm[(16 * I + r16) * 68 + 16 * K + 4 * ks + q4], Tm[(16 * K + 4 * ks + q4) * 68 + 16 * J + r16], x, 0, 0, 0);
                LAS float* Xw = Xs + w * (16 * 17);
#pragma unroll
                for (int e = 0; e < 4; ++e) Xw[(4 * q4 + e) * 17 + r16] = x[e];
                f32x4 t = {0.f, 0.f, 0.f, 0.f};
#pragma unroll
                for (int ks = 0; ks < 4; ++ks) t = __builtin_amdgcn_mfma_f32_16x16x4f32(Tm[(16 * I + r16) * 68 + 16 * I + 4 * ks + q4], Xw[(4 * ks + q4) * 17 + r16], t, 0, 0, 0);
#pragma unroll
                for (int e = 0; e < 4; ++e) Tm[(16 * I + 4 * q4 + e) * 68 + 16 * J + r16] = -t[e];
            }
            __syncthreads();
        }
        }
#pragma unroll 1
        for (int rq4 = 0; rq4 < RQ4; ++rq4)
        {   int lane4 = lane, tid4 = tid; asm volatile("" : "+v"(lane4), "+v"(tid4));
            const int r = lane4 & 15, q = lane4 >> 4;
            f32x4 acc[4][2];
#pragma unroll
            for (int i = 0; i < 4; ++i) { acc[i][0] = (f32x4){0.f, 0.f, 0.f, 0.f}; acc[i][1] = (f32x4){0.f, 0.f, 0.f, 0.f}; }
#pragma unroll
            for (int ks = 0; ks < 2; ++ks) {
                bf16x8 bfr[2];
#pragma unroll
                for (int jt = 0; jt < 2; ++jt) { const int nrow = 32 * w + 16 * jt + r; bfr[jt] = *(const LAS bf16x8*)(L + G2_RHST + nrow * 144 + (((4 * ks + q) ^ ((nrow >> 3) & 7)) * 16)); }
#pragma unroll
                for (int i = 0; i < 4; ++i) {
                    const LAS float* tp = Tm + (16 * i + r) * 68 + 32 * ks + 8 * q;
                    const f32x4 t0v = *(const LAS f32x4*)tp, t1v = *(const LAS f32x4*)(tp + 4);
                    const bf16x8 af = pack8(t0v[0], t0v[1], t0v[2], t0v[3], t1v[0], t1v[1], t1v[2], t1v[3]);
                    acc[i][0] = MFMA16(af, bfr[0], acc[i][0]); acc[i][1] = MFMA16(af, bfr[1], acc[i][1]);
                }
            }
#pragma unroll
            for (int jt = 0; jt < 2; ++jt) {
                const int nn = 32 * w + 16 * jt + r;
                if (w < 4) {
#pragma unroll
                    for (int i = 0; i < 4; ++i) {
                        u32x2 wv; wv.x = pk2(acc[i][jt][0], acc[i][jt][1]); wv.y = pk2(acc[i][jt][2], acc[i][jt][3]);
                        *(u32x2*)(rec + REC_U + (size_t)((((nn >> 5) * 2 + (i >> 1)) * 64 + (nn & 31) + 32 * (q & 1)) * 32 + (8 * (i & 1) + 4 * (q >> 1)) * 2)) = wv; }
                } else {
                    const int dk = nn - 128, pd = (dk & ~15) | swap23(dk & 15);
#pragma unroll
                    for (int i = 0; i < 4; ++i)
#pragma unroll
                        for (int e = 0; e < 4; ++e) ((bf16_t*)(rec + REC_W))[(16 * i + 4 * q + e) * 128 + pd] = f2bf(acc[i][jt][e]);
                }
            }
#pragma unroll
            for (int pz = 0; pz < 2; ++pz) { const int piece = tid4 + NTHREADS * pz, row = piece >> 3, seg = piece & 7;
                *(u32x4*)(rec + REC_KDT + row * 128 + seg * 16) = *(const LAS u32x4*)(L + G2_KDT + row * 144 + ((seg ^ ((row >> 3) & 7)) * 16)); }
        }
        __syncthreads();
    }
}
constexpr int MA_K = 0, MA_V = 65536;
DI void mem_attn_all(const Ctx& c, int layer, int qcol, int brank, int nblk) {
    if (nblk < 4) return;
    unsigned char* ws = c.a->ws;
    LAS unsigned char* L = c.lds;
    const bf16_t* P = (const bf16_t*)(ws + WS_P);
    unsigned char* MIX = ws + WS_MIX;
    const int lane = c.lane, w = c.wave, r = lane & 15, q = lane >> 4;
    const int hm = brank & 3, rank4 = brank >> 2, n4 = (nblk - hm + 3) >> 2;
    {
        const unsigned char* kg = (const unsigned char*)((const bf16_t*)(ws + WS_KM) + layer * 512 + hm * 128);
        const unsigned char* vg = (const unsigned char*)((const bf16_t*)(ws + WS_VMT) + (size_t)(layer * 512 + hm * 128) * NMEM);
#pragma unroll
        for (int i = 0; i < 8; ++i) {
            const int pc = w * 8 + i;
            {   const int row = pc * 4 + (lane >> 4), slot = lane & 15, gs = slot ^ (row & 15);
                __builtin_amdgcn_global_load_lds((const unsigned*)(kg + (size_t)row * 4096 + gs * 16), (LAS unsigned*)(L + MA_K + pc * 1024), 16, 0, 0); }
            {   const int row = pc * 2 + (lane >> 5), slot = lane & 31, gs = slot ^ (row & 15);
                __builtin_amdgcn_global_load_lds((const unsigned*)(vg + (size_t)row * 512 + gs * 16), (LAS unsigned*)(L + MA_V + pc * 1024), 16, 0, 0); }
        }
        asm volatile("s_waitcnt vmcnt(0)" ::: "memory");
        __syncthreads();
    }
    const float sc = 0.08838834764831845f * 1.44269504088896f;
    const int tile0 = rank4 * 8 + w;
    bf16x8 qn[4];
    if (tile0 < M_TOK / 16) {
#pragma unroll
        for (int ks = 0; ks < 4; ++ks) qn[ks] = *(const bf16x8*)(P + (size_t)(tile0 * 16 + r) * LDP + qcol + hm * 128 + 32 * ks + 8 * q); }
#define MA_LDK(F, KT) do { _Pragma("unroll") for (int ks = 0; ks < 4; ++ks) F[ks] = *(const LAS bf16x8*)(kbase + ((64 * ks) ^ xm) + 4096 * (KT)); } while (0)
#define MA_QK(F, KT) do { f32x4 acc_ = {0.f, 0.f, 0.f, 0.f}; _Pragma("unroll") for (int ks = 0; ks < 4; ++ks) acc_ = MFMA16(F[ks], qf[ks], acc_); st[KT] = acc_; } while (0)
#define MA_LDV(F, KK) do { const LAS unsigned char* v0_ = vbase0 + ((64 * (KK)) ^ xm); const LAS unsigned char* v1_ = vbase1 + ((64 * (KK)) ^ xm); \
            _Pragma("unroll") for (int dt = 0; dt < 8; ++dt) { const s16x4 lo_ = *(const LAS s16x4*)(v0_ + 8192 * dt), hi_ = *(const LAS s16x4*)(v1_ + 8192 * dt); \
            F[dt] = __builtin_shufflevector(lo_, hi_, 0, 1, 2, 3, 4, 5, 6, 7); } } while (0)
#define MA_PV(F, KK) do { const bf16x8 pb_ = pack8(st[2 * (KK)][0], st[2 * (KK)][1], st[2 * (KK)][2], st[2 * (KK)][3], st[2 * (KK) + 1][0], st[2 * (KK) + 1][1], st[2 * (KK) + 1][2], st[2 * (KK) + 1][3]); \
            _Pragma("unroll") for (int dt = 0; dt < 8; ++dt) ot[dt] = MFMA16(F[dt], pb_, ot[dt]); } while (0)
#pragma unroll 1
    for (int tile = tile0; tile < M_TOK / 16; tile += n4 * 8) {
        const int t0 = tile * 16;
        int lane_ = lane; asm volatile("" : "+v"(lane_));
        const int r_ = lane_ & 15, q_ = lane_ >> 4, xm = 64 * (r_ >> 2);
        const LAS unsigned char* kbase = L + MA_K + r_ * 256 + ((q_ ^ (r_ & 3)) * 16);
        const LAS unsigned char* vbase0 = L + MA_V + r_ * 512 + (q_ & 1) * 8 + (((q_ >> 1) ^ (r_ & 3)) * 16);
        const LAS unsigned char* vbase1 = L + MA_V + r_ * 512 + (q_ & 1) * 8 + (((2 + (q_ >> 1)) ^ (r_ & 3)) * 16);
        bf16x8 qf[4];
#pragma unroll
        for (int ks = 0; ks < 4; ++ks) qf[ks] = qn[ks];
        if (tile + n4 * 8 < M_TOK / 16) {
#pragma unroll
            for (int ks = 0; ks < 4; ++ks) qn[ks] = *(const bf16x8*)(P + (size_t)((tile + n4 * 8) * 16 + r) * LDP + qcol + hm * 128 + 32 * ks + 8 * q); }
        f32x4 st[16];
        {   bf16x8 ka[4], kb[4];
            MA_LDK(ka, 0);
#pragma unroll
            for (int kt = 0; kt < 16; kt += 2) {
                MA_LDK(kb, kt + 1); asm volatile("" ::: "memory");
                MA_QK(ka, kt);
                if (kt + 2 < 16) MA_LDK(ka, kt + 2);
                asm volatile("" ::: "memory");
                MA_QK(kb, kt + 1);
            } }
        float mx = -3.0e38f;
#pragma unroll
        for (int kt = 0; kt < 16; ++kt)
#pragma unroll
            for (int e = 0; e < 4; ++e) mx = fmaxf(mx, st[kt][e]);
        { auto r_ = __builtin_amdgcn_permlane16_swap(__float_as_uint(mx), __float_as_uint(mx), false, false); mx = fmaxf(__uint_as_float(r_[0]), __uint_as_float(r_[1])); }
        { auto r_ = __builtin_amdgcn_permlane32_swap(__float_as_uint(mx), __float_as_uint(mx), false, false); mx = fmaxf(__uint_as_float(r_[0]), __uint_as_float(r_[1])); }
        float sum = 0.f;
#pragma unroll
        for (int kt = 0; kt < 16; ++kt)
#pragma unroll
            for (int e = 0; e < 4; ++e) { const float p = __builtin_amdgcn_exp2f((st[kt][e] - mx) * sc); st[kt][e] = p; sum += p; }
        sum = swap32_sum(swap16_sum(sum, sum), swap16_sum(sum, sum));
        const float inv = __builtin_amdgcn_rcpf(sum);
        f32x4 ot[8];
#pragma unroll
        for (int dt = 0; dt < 8; ++dt) ot[dt] = (f32x4){0.f, 0.f, 0.f, 0.f};
        {   bf16x8 va[8], vb[8];
            MA_LDV(va, 0);
#pragma unroll
            for (int kk = 0; kk < 8; kk += 2) {
                MA_LDV(vb, kk + 1); asm volatile("" ::: "memory");
                MA_PV(va, kk);
                if (kk + 2 < 8) MA_LDV(va, kk + 2);
                asm volatile("" ::: "memory");
                MA_PV(vb, kk + 1);
            } }
#pragma unroll
        for (int dt = 0; dt < 8; ++dt) {
            *(unsigned*)(MIX + (size_t)(t0 + r) * MIXW + 1024 + hm * 128 + 16 * dt + 4 * q) = pk4_f8(ot[dt][0] * inv, ot[dt][1] * inv, ot[dt][2] * inv, ot[dt][3] * inv, F8_ACT); }
    }
    __syncthreads();
}

DI bf16x8 packS(const f32x16& x, int s) { return pack8(x[8 * s], x[8 * s + 1], x[8 * s + 2], x[8 * s + 3], x[8 * s + 4], x[8 * s + 5], x[8 * s + 6], x[8 * s + 7]); }
DI void scan_dma(LAS unsigned char* buf, const unsigned char* rec, int w8, int lane, bool full) {
    asm volatile("" : "+s"(rec));
    const unsigned vA = (unsigned)((lane >> 4) * 256 + (((lane & 15) ^ (((w8 & 3) * 4 + (lane >> 4)) & 15)) * 16));
    const unsigned vB = (unsigned)((lane >> 3) * 128 + (((lane & 7) ^ (((lane >> 4) + 4 * (w8 & 1)) & 7)) * 16));
    const unsigned vC = (unsigned)(lane * 16);
#pragma unroll
    for (int i = 0; i < 9; ++i) {
        const int qq = w8 + 8 * i;
        if (!full && (i == 2 || i == 3 || i == 6)) continue;
        const unsigned char* gp = rec + qq * 1024;
        const unsigned vo = (i < 4) ? vA : (i < 7) ? vB : vC;
        __builtin_amdgcn_global_load_lds((const unsigned*)(gp + vo), (LAS unsigned*)(buf + qq * 1024), 16, 0, 0);
    }
}
template <int G_> DI void scan_ld(const LAS unsigned char* buf, int r, int hh, bf16x8 (&f)[4]) {
    asm volatile("" : "+v"(r), "+v"(hh));
    if constexpr (G_ < 4) {
#pragma unroll
        for (int rho = 0; rho < 2; ++rho)
#pragma unroll
            for (int s = 0; s < 2; ++s) { const int cr = 32 * rho + r, p = (4 * G_ + 2 * s + hh) ^ (cr & 15); f[rho * 2 + s] = *(const LAS bf16x8*)(buf + REC_W + cr * 256 + p * 16); } }
    else if constexpr (G_ < 10 && ((G_ - 4) % 3) < 2) { constexpr int rho = (G_ - 4) / 3, i0 = 2 * ((G_ - 4) % 3); const int cr = 32 * rho + r;
#pragma unroll
        for (int ii = 0; ii < 2; ++ii)
#pragma unroll
            for (int s = 0; s < 2; ++s) { const int p = (4 * (i0 + ii) + 2 * s + hh) ^ (cr & 15); f[ii * 2 + s] = *(const LAS bf16x8*)(buf + REC_QG + cr * 256 + p * 16); } }
    else { constexpr int row0 = (G_ < 10) ? 32 * ((G_ - 4) / 3) : 32 * (G_ - 10); constexpr int base = (G_ < 10) ? REC_AQK : REC_KDT; const int rr = row0 + r;
#pragma unroll
        for (int ts = 0; ts < 4; ++ts) { const int p = (2 * ts + hh) ^ ((rr >> 1) & 7); f[ts] = *(const LAS bf16x8*)(buf + base + rr * 128 + p * 16); } }
}
#define SCAN_END() asm volatile("" ::: "memory")
#define SCAN_VNEW(Y, uu, HAVE_U) do { _Pragma("unroll") for (int rho = 0; rho < 2; ++rho) { const u32x4 u0 = uu[rho][0], u1 = uu[rho][1]; \
        if (HAVE_U) { \
            Y[rho][0] = bf_lo(u0.x) - Y[rho][0]; Y[rho][1] = bf_hi(u0.x) - Y[rho][1]; Y[rho][2] = bf_lo(u0.y) - Y[rho][2]; Y[rho][3] = bf_hi(u0.y) - Y[rho][3]; \
            Y[rho][4] = bf_lo(u0.z) - Y[rho][4]; Y[rho][5] = bf_hi(u0.z) - Y[rho][5]; Y[rho][6] = bf_lo(u0.w) - Y[rho][6]; Y[rho][7] = bf_hi(u0.w) - Y[rho][7]; \
            Y[rho][8] = bf_lo(u1.x) - Y[rho][8]; Y[rho][9] = bf_hi(u1.x) - Y[rho][9]; Y[rho][10] = bf_lo(u1.y) - Y[rho][10]; Y[rho][11] = bf_hi(u1.y) - Y[rho][11]; \
            Y[rho][12] = bf_lo(u1.z) - Y[rho][12]; Y[rho][13] = bf_hi(u1.z) - Y[rho][13]; Y[rho][14] = bf_lo(u1.w) - Y[rho][14]; Y[rho][15] = bf_hi(u1.w) - Y[rho][15]; \
        } else { _Pragma("unroll") for (int e = 0; e < 16; ++e) Y[rho][e] = -Y[rho][e]; } \
        Vb[rho][0] = packS(Y[rho], 0); Vb[rho][1] = packS(Y[rho], 1); } } while (0)
#define SCAN_Y(g, gn) do { scan_ld<gn>(buf, r, hh, fr[((g) + 1) & 1]); const bf16x8 sb0 = packS(S[g], 0), sb1 = packS(S[g], 1); \
        Y[0] = MFMA32(fr[(g) & 1][0], sb0, Y[0]); Y[1] = MFMA32(fr[(g) & 1][2], sb0, Y[1]); Y[0] = MFMA32(fr[(g) & 1][1], sb1, Y[0]); Y[1] = MFMA32(fr[(g) & 1][3], sb1, Y[1]); SCAN_END(); } while (0)

constexpr int SCAN_G = 8, SCAN_NG = 256 / SCAN_G;
DI void scan_pass_a(const Ctx& c, int unit) {
    unsigned char* ws = c.a->ws;
    LAS unsigned char* L = c.lds;
    const int lane = c.lane, w = c.wave, r = lane & 31, hh = lane >> 5;
    const int head = unit / SCAN_NG, g = unit % SCAN_NG, n0 = g * SCAN_G;
    const unsigned char* recs = ws + WS_REC + (size_t)(head * 256 + n0) * REC_BYTES;
    const float* gam = (const float*)(ws + WS_GAM) + head * 256 + n0;
    const bool phi = w < 4; const int usl = w & 3;
    f32x16 S[4];
#pragma unroll
    for (int i = 0; i < 4; ++i)
#pragma unroll
        for (int e = 0; e < 16; ++e) S[i][e] = (phi && w == i && ((e & 3) + 8 * (e >> 2) + 4 * hh) == r) ? 1.f : 0.f;
    scan_dma(L, recs, w, lane, false);
    asm volatile("s_waitcnt vmcnt(0)" ::: "memory");
    __syncthreads();
#pragma unroll 1
    for (int n = 0; n < SCAN_G; ++n) {
        LAS unsigned char* buf = L + (n & 1) * REC_BYTES;
        if (n + 1 < SCAN_G) scan_dma(L + ((n + 1) & 1) * REC_BYTES, recs + (size_t)(n + 1) * REC_BYTES, w, lane, false);
        const float gamma = gam[n];
        bf16x8 fr[2][4];
        scan_ld<0>(buf, r, hh, fr[0]);
        bf16x8 Vb[2][2];
        {   f32x16 Y[2];
#pragma unroll
            for (int e = 0; e < 16; ++e) { Y[0][e] = 0.f; Y[1][e] = 0.f; }
            SCAN_Y(0, 1); SCAN_Y(1, 2); SCAN_Y(2, 3); SCAN_Y(3, 10);
            u32x4 uu[2][2];
#pragma unroll
            for (int rho = 0; rho < 2; ++rho) { const LAS u32x4* up = (const LAS u32x4*)(buf + REC_U + ((usl * 2 + rho) * 64 + lane) * 32); uu[rho][0] = up[0]; uu[rho][1] = up[1]; }
            if (phi) SCAN_VNEW(Y, uu, false); else SCAN_VNEW(Y, uu, true);
        }
#define SCAN_S(g, gn, i, HAS_NEXT) do { if (HAS_NEXT) scan_ld<gn>(buf, r, hh, fr[((g) + 1) & 1]); _Pragma("unroll") for (int e = 0; e < 16; ++e) S[i][e] *= gamma; \
            S[i] = MFMA32(fr[(g) & 1][0], Vb[0][0], S[i]); S[i] = MFMA32(fr[(g) & 1][1], Vb[0][1], S[i]); S[i] = MFMA32(fr[(g) & 1][2], Vb[1][0], S[i]); S[i] = MFMA32(fr[(g) & 1][3], Vb[1][1], S[i]); SCAN_END(); } while (0)
        SCAN_S(4, 11, 0, true); SCAN_S(5, 12, 1, true); SCAN_S(6, 13, 2, true); SCAN_S(7, 13, 3, false);
#undef SCAN_S
        asm volatile("s_waitcnt vmcnt(0)" ::: "memory");
        __syncthreads();
    }
    if (phi) {
        const int cin = 32 * w + r, pc = (cin & ~15) | swap23(cin & 15);
        bf16_t* ph = (bf16_t*)(ws + WS_PHI) + (size_t)unit * 128 * 128 + (4 * hh) * 128 + pc;
#pragma unroll
        for (int i = 0; i < 4; ++i) {
#pragma unroll
            for (int e = 0; e < 16; ++e) ph[((e & 3) + 8 * (e >> 2)) * 128] = f2bf(S[i][e]);
            ph += 32 * 128; asm volatile("" : "+v"(ph)); }
    } else {
        bf16_t* sl = (bf16_t*)(ws + WS_SLOC) + ((size_t)(unit * 4 + usl) * 4 * 64 + lane) * 16;
#pragma unroll
        for (int i = 0; i < 4; ++i) { u32x4* op = (u32x4*)(sl + (size_t)i * 64 * 16);
            u32x4 a, b; a.x = pk2(S[i][0], S[i][1]); a.y = pk2(S[i][2], S[i][3]); a.z = pk2(S[i][4], S[i][5]); a.w = pk2(S[i][6], S[i][7]);
            b.x = pk2(S[i][8], S[i][9]); b.y = pk2(S[i][10], S[i][11]); b.z = pk2(S[i][12], S[i][13]); b.w = pk2(S[i][14], S[i][15]);
            op[0] = a; op[1] = b; }
    }
}

constexpr int PB_XCH = 98304;
DI void scan_pass_b(const Ctx& c, int head) {
    unsigned char* ws = c.a->ws;
    LAS unsigned char* L = c.lds;
    const int lane = c.lane, w = c.wave, r = lane & 31, hh = lane >> 5, j = w & 3, rh = w >> 2;
    const unsigned char* phis = ws + WS_PHI + (size_t)head * SCAN_NG * 32768;
    const unsigned vA = (unsigned)((lane >> 4) * 256 + (((lane & 15) ^ (((w & 3) * 4 + (lane >> 4)) & 15)) * 16));
#define PB_DMA(gg) do { const unsigned char* pp_ = phis + (size_t)(gg) * 32768; asm volatile("" : "+s"(pp_)); LAS unsigned char* sl_ = L + ((gg) % 3) * 32768; \
        _Pragma("unroll") for (int i = 0; i < 4; ++i) { const int qq = w + 8 * i; __builtin_amdgcn_global_load_lds((const unsigned*)(pp_ + qq * 1024 + vA), (LAS unsigned*)(sl_ + qq * 1024), 16, 0, 0); } } while (0)
    constexpr size_t GSTR = (size_t)4 * 4 * 64 * 16;
    const size_t tb = ((size_t)((head * SCAN_NG) * 4 + j) * 4 + 2 * rh) * 64 * 16 + (size_t)lane * 16;
    const bf16_t* slb = (const bf16_t*)(ws + WS_SLOC) + tb;
    bf16_t* sib = (bf16_t*)(ws + WS_SIN) + tb;
    LAS bf16x8* xch = (LAS bf16x8*)(L + PB_XCH);
    u32x4 N[2][2];
#pragma unroll
    for (int t = 0; t < 2; ++t) { const u32x4* ip = (const u32x4*)(slb + (size_t)t * 1024); N[t][0] = ip[0]; N[t][1] = ip[1]; }
    {   bf16x8 z;
#pragma unroll
        for (int e = 0; e < 8; ++e) z[e] = 0;
#pragma unroll
        for (int t = 0; t < 2; ++t) { xch[((j * 4 + 2 * rh + t) * 2 + 0) * 64 + lane] = z; xch[((j * 4 + 2 * rh + t) * 2 + 1) * 64 + lane] = z;
            bf16x8* op = (bf16x8*)(sib + (size_t)t * 1024); op[0] = z; op[1] = z; } }
    asm volatile("" ::: "memory");
    PB_DMA(0); PB_DMA(1);
#pragma unroll 1
    for (int g = 0; g < SCAN_NG; ++g) {
        asm volatile("s_waitcnt vmcnt(4)" ::: "memory");
        __syncthreads();
        bf16x8 Sb[4][2];
#pragma unroll
        for (int i = 0; i < 4; ++i) { Sb[i][0] = xch[((j * 4 + i) * 2 + 0) * 64 + lane]; Sb[i][1] = xch[((j * 4 + i) * 2 + 1) * 64 + lane]; }
        asm volatile("s_waitcnt lgkmcnt(0)" ::: "memory");
        __syncthreads();
        const LAS unsigned char* slot = L + (g % 3) * 32768;
        f32x16 A2[2];
#pragma unroll
        for (int t = 0; t < 2; ++t) {
            const u32x4 n0 = N[t][0], n1 = N[t][1];
            A2[t][0] = bf_lo(n0.x); A2[t][1] = bf_hi(n0.x); A2[t][2] = bf_lo(n0.y); A2[t][3] = bf_hi(n0.y); A2[t][4] = bf_lo(n0.z); A2[t][5] = bf_hi(n0.z); A2[t][6] = bf_lo(n0.w); A2[t][7] = bf_hi(n0.w);
            A2[t][8] = bf_lo(n1.x); A2[t][9] = bf_hi(n1.x); A2[t][10] = bf_lo(n1.y); A2[t][11] = bf_hi(n1.y); A2[t][12] = bf_lo(n1.z); A2[t][13] = bf_hi(n1.z); A2[t][14] = bf_lo(n1.w); A2[t][15] = bf_hi(n1.w);
            const u32x4* ip = (const u32x4*)(slb + (size_t)(g + 1) * GSTR + (size_t)t * 1024); N[t][0] = ip[0]; N[t][1] = ip[1]; }
#pragma unroll
        for (int t = 0; t < 2; ++t) {
            const int row = 32 * (2 * rh + t) + r;
#pragma unroll
            for (int half = 0; half < 2; ++half) {
                bf16x8 fr[4]; int row_ = row, hh_ = hh; asm volatile("" : "+v"(row_), "+v"(hh_));
#pragma unroll
                for (int q4 = 0; q4 < 4; ++q4) { const int p = (4 * (2 * half + (q4 >> 1)) + 2 * (q4 & 1) + hh_) ^ (row_ & 15); fr[q4] = *(const LAS bf16x8*)(slot + row_ * 256 + p * 16); }
                A2[t] = MFMA32(fr[0], Sb[2 * half][0], A2[t]); A2[t] = MFMA32(fr[1], Sb[2 * half][1], A2[t]); A2[t] = MFMA32(fr[2], Sb[2 * half + 1][0], A2[t]); A2[t] = MFMA32(fr[3], Sb[2 * half + 1][1], A2[t]);
            }
            const bf16x8 p0 = packS(A2[t], 0), p1 = packS(A2[t], 1);
            xch[((j * 4 + 2 * rh + t) * 2 + 0) * 64 + lane] = p0; xch[((j * 4 + 2 * rh + t) * 2 + 1) * 64 + lane] = p1;
            if (g + 1 < SCAN_NG) { bf16x8* op = (bf16x8*)(sib + (size_t)(g + 1) * GSTR + (size_t)t * 1024); op[0] = p0; op[1] = p1; }
        }
        asm volatile("" ::: "memory");
        if (g + 2 < SCAN_NG) PB_DMA(g + 2);
    }
#undef PB_DMA
    asm volatile("s_waitcnt vmcnt(0)" ::: "memory");
    __syncthreads();
}

DI void gdn_gate_group(const Ctx& c, const float* gn, int head, int tbase) {
    unsigned char* ws = c.a->ws;
    const bf16_t* OB = (const bf16_t*)(ws + WS_OG); const bf16_t* P = (const bf16_t*)(ws + WS_P); unsigned char* MIX = ws + WS_MIX;
    int tid_ = c.tid; asm volatile("" : "+v"(tid_));
    const int cg = tid_ & 15;
    const f32x4 g0 = *(const f32x4*)(gn + cg * 8), g1 = *(const f32x4*)(gn + cg * 8 + 4);
#pragma unroll 1
    for (int rb = 0; rb < 16; rb += 4) {
        u32x4 ov4[4], zv4[4];
#pragma unroll
        for (int u = 0; u < 4; ++u) { const int t = tbase + (tid_ >> 4) + 32 * (rb + u);
            ov4[u] = *(const u32x4*)(OB + (size_t)t * 1024 + head * 128 + cg * 8); zv4[u] = *(const u32x4*)(P + (size_t)t * LDP + GC_Z + head * 128 + cg * 8); }
        asm volatile("" ::: "memory");
#pragma unroll
        for (int u = 0; u < 4; ++u) { const int t = tbase + (tid_ >> 4) + 32 * (rb + u);
            const u32x4 ov = ov4[u], zv = zv4[u];
            const float o[8] = {bf_lo(ov.x), bf_hi(ov.x), bf_lo(ov.y), bf_hi(ov.y), bf_lo(ov.z), bf_hi(ov.z), bf_lo(ov.w), bf_hi(ov.w)};
            float ss = 0.f;
#pragma unroll
            for (int e = 0; e < 8; ++e) ss += o[e] * o[e];
            ss = row_sum16(ss);
            const float rr = __builtin_amdgcn_rsqf(ss * (1.0f / 128.0f) + RMS_EPS);
            u32x2 wv;
            wv.x = pk4_f8(o[0] * rr * g0[0] * siluf_(bf_lo(zv.x)), o[1] * rr * g0[1] * siluf_(bf_hi(zv.x)), o[2] * rr * g0[2] * siluf_(bf_lo(zv.y)), o[3] * rr * g0[3] * siluf_(bf_hi(zv.y)), F8_ACT);
            wv.y = pk4_f8(o[4] * rr * g1[0] * siluf_(bf_lo(zv.z)), o[5] * rr * g1[1] * siluf_(bf_hi(zv.z)), o[6] * rr * g1[2] * siluf_(bf_lo(zv.w)), o[7] * rr * g1[3] * siluf_(bf_hi(zv.w)), F8_ACT);
            *(u32x2*)(MIX + (size_t)t * MIXW + head * 128 + cg * 8) = wv; }
    }
}
DI void scan_pass_c(const Ctx& c, int unit) {
    unsigned char* ws = c.a->ws;
    LAS unsigned char* L = c.lds;
    const int lane = c.lane, w = c.wave, r = lane & 31, hh = lane >> 5;
    const int head = unit / SCAN_NG, g = unit % SCAN_NG, n0 = g * SCAN_G;
    const unsigned char* recs = ws + WS_REC + (size_t)(head * 256 + n0) * REC_BYTES;
    const float* gam = (const float*)(ws + WS_GAM) + head * 256 + n0;
    bf16_t* OB = (bf16_t*)(ws + WS_OG);
    f32x16 S[4];
    if (w < 4) {
        const bf16_t* sib = (const bf16_t*)(ws + WS_SIN) + ((size_t)(unit * 4 + w) * 4 * 64 + lane) * 16;
#pragma unroll
        for (int i = 0; i < 4; ++i) { const u32x4* ip = (const u32x4*)(sib + (size_t)i * 1024); const u32x4 n0 = ip[0], n1 = ip[1];
            S[i][0] = bf_lo(n0.x); S[i][1] = bf_hi(n0.x); S[i][2] = bf_lo(n0.y); S[i][3] = bf_hi(n0.y); S[i][4] = bf_lo(n0.z); S[i][5] = bf_hi(n0.z); S[i][6] = bf_lo(n0.w); S[i][7] = bf_hi(n0.w);
            S[i][8] = bf_lo(n1.x); S[i][9] = bf_hi(n1.x); S[i][10] = bf_lo(n1.y); S[i][11] = bf_hi(n1.y); S[i][12] = bf_lo(n1.z); S[i][13] = bf_hi(n1.z); S[i][14] = bf_lo(n1.w); S[i][15] = bf_hi(n1.w); }
    }
    scan_dma(L, recs, w, lane, true);
    asm volatile("s_waitcnt vmcnt(0)" ::: "memory");
    __syncthreads();
#pragma unroll 1
    for (int n = 0; n < SCAN_G; ++n) {
        LAS unsigned char* buf = L + (n & 1) * REC_BYTES;
        if (n + 1 < SCAN_G) scan_dma(L + ((n + 1) & 1) * REC_BYTES, recs + (size_t)(n + 1) * REC_BYTES, w, lane, true);
        if (w < 4) {
            const float gamma = gam[n];
            u32x4 uu[2][2];
#pragma unroll
            for (int rho = 0; rho < 2; ++rho) { const LAS u32x4* up = (const LAS u32x4*)(buf + REC_U + ((w * 2 + rho) * 64 + lane) * 32); uu[rho][0] = up[0]; uu[rho][1] = up[1]; }
            bf16x8 fr[2][4];
            scan_ld<0>(buf, r, hh, fr[0]);
#define SCAN_NEXT(g) do { if ((g) + 1 < 14) scan_ld<(g) + 1>(buf, r, hh, fr[((g) + 1) & 1]); } while (0)
            bf16x8 Vb[2][2];
            {   f32x16 Y[2];
#pragma unroll
                for (int e = 0; e < 16; ++e) { Y[0][e] = 0.f; Y[1][e] = 0.f; }
                SCAN_Y(0, 1); SCAN_Y(1, 2); SCAN_Y(2, 3); SCAN_Y(3, 4);
                SCAN_VNEW(Y, uu, true);
            }
#define SCAN_Z(g0, rho) do { f32x16 Z; _Pragma("unroll") for (int e = 0; e < 16; ++e) Z[e] = 0.f; \
                SCAN_NEXT(g0); { const bf16x8 a0 = packS(S[0], 0), a1 = packS(S[0], 1), a2 = packS(S[1], 0), a3 = packS(S[1], 1); \
                    Z = MFMA32(fr[(g0) & 1][0], a0, Z); Z = MFMA32(fr[(g0) & 1][1], a1, Z); Z = MFMA32(fr[(g0) & 1][2], a2, Z); Z = MFMA32(fr[(g0) & 1][3], a3, Z); } SCAN_END(); \
                SCAN_NEXT((g0) + 1); { const bf16x8 a0 = packS(S[2], 0), a1 = packS(S[2], 1), a2 = packS(S[3], 0), a3 = packS(S[3], 1); \
                    Z = MFMA32(fr[((g0) + 1) & 1][0], a0, Z); Z = MFMA32(fr[((g0) + 1) & 1][1], a1, Z); Z = MFMA32(fr[((g0) + 1) & 1][2], a2, Z); Z = MFMA32(fr[((g0) + 1) & 1][3], a3, Z); } SCAN_END(); \
                SCAN_NEXT((g0) + 2); Z = MFMA32(fr[((g0) + 2) & 1][0], Vb[0][0], Z); Z = MFMA32(fr[((g0) + 2) & 1][1], Vb[0][1], Z); Z = MFMA32(fr[((g0) + 2) & 1][2], Vb[1][0], Z); Z = MFMA32(fr[((g0) + 2) & 1][3], Vb[1][1], Z); \
                { bf16_t* op = OB + (size_t)((n0 + n) * 64 + 32 * (rho) + 4 * hh) * 1024 + head * 128 + 32 * w + r; \
                  _Pragma("unroll") for (int e = 0; e < 16; ++e) op[((e & 3) + 8 * (e >> 2)) * 1024] = f2bf(Z[e]); } SCAN_END(); } while (0)
            SCAN_Z(4, 0); SCAN_Z(7, 1);
#undef SCAN_Z
#define SCAN_S(g, i) do { SCAN_NEXT(g); _Pragma("unroll") for (int e = 0; e < 16; ++e) S[i][e] *= gamma; \
                S[i] = MFMA32(fr[(g) & 1][0], Vb[0][0], S[i]); S[i] = MFMA32(fr[(g) & 1][1], Vb[0][1], S[i]); S[i] = MFMA32(fr[(g) & 1][2], Vb[1][0], S[i]); S[i] = MFMA32(fr[(g) & 1][3], Vb[1][1], S[i]); SCAN_END(); } while (0)
            SCAN_S(10, 0); SCAN_S(11, 1); SCAN_S(12, 2); SCAN_S(13, 3);
#undef SCAN_S
#undef SCAN_NEXT
        }
        asm volatile("s_waitcnt vmcnt(0)" ::: "memory");
        __syncthreads();
    }
}
#undef SCAN_Y
#undef SCAN_VNEW
#undef SCAN_END
DI void phase_gdn_out(const Ctx& c, int li) {
    unsigned char* ws = c.a->ws;
    const bf16_t* OB = (const bf16_t*)(ws + WS_OG); const bf16_t* P = (const bf16_t*)(ws + WS_P); unsigned char* MIX = ws + WS_MIX;
    const float* gn = c.a->gdn_onorm + li * 128;
    const int cg = c.tid & 15;
    const f32x4 g0 = *(const f32x4*)(gn + cg * 8), g1 = *(const f32x4*)(gn + cg * 8 + 4);
    for (int it0 = c.bid * 32 + (c.tid >> 4); it0 < M_TOK * 8; it0 += c.G * 32 * 4) {
        u32x4 ov4[4], zv4[4];
#pragma unroll
        for (int u = 0; u < 4; ++u) { const int it = it0 + u * c.G * 32; if (it < M_TOK * 8) { const int t = it >> 3, h = it & 7;
            ov4[u] = *(const u32x4*)(OB + (size_t)t * 1024 + h * 128 + cg * 8); zv4[u] = *(const u32x4*)(P + (size_t)t * LDP + GC_Z + h * 128 + cg * 8); } }
        asm volatile("" ::: "memory");
#pragma unroll
        for (int u = 0; u < 4; ++u) { const int it = it0 + u * c.G * 32; if (it < M_TOK * 8) { const int t = it >> 3, h = it & 7;
            const u32x4 ov = ov4[u], zv = zv4[u];
            const float o[8] = {bf_lo(ov.x), bf_hi(ov.x), bf_lo(ov.y), bf_hi(ov.y), bf_lo(ov.z), bf_hi(ov.z), bf_lo(ov.w), bf_hi(ov.w)};
            float ss = 0.f;
#pragma unroll
            for (int e = 0; e < 8; ++e) ss += o[e] * o[e];
            ss = row_sum16(ss);
            const float rr = __builtin_amdgcn_rsqf(ss * (1.0f / 128.0f) + RMS_EPS);
            u32x2 wv;
            wv.x = pk4_f8(o[0] * rr * g0[0] * siluf_(bf_lo(zv.x)), o[1] * rr * g0[1] * siluf_(bf_hi(zv.x)), o[2] * rr * g0[2] * siluf_(bf_lo(zv.y)), o[3] * rr * g0[3] * siluf_(bf_hi(zv.y)), F8_ACT);
            wv.y = pk4_f8(o[4] * rr * g1[0] * siluf_(bf_lo(zv.z)), o[5] * rr * g1[1] * siluf_(bf_hi(zv.z)), o[6] * rr * g1[2] * siluf_(bf_lo(zv.w)), o[7] * rr * g1[3] * siluf_(bf_hi(zv.w)), F8_ACT);
            *(u32x2*)(MIX + (size_t)t * MIXW + h * 128 + cg * 8) = wv; } }
    }
}

DI void ln_row(const float (&v)[32], const float* g, const float* b, float* dstf, bf16_t* dstb, int lane) {
    float s = 0.f;
#pragma unroll
    for (int i = 0; i < 32; ++i) s += v[i];
    const float mu = wave_sum(s) * (1.0f / 2048.0f);
    float qv = 0.f;
#pragma unroll
    for (int i = 0; i < 32; ++i) { const float d = v[i] - mu; qv += d * d; }
    const float rstd = __builtin_amdgcn_rsqf(wave_sum(qv) * (1.0f / 2048.0f) + LN_EPS);
#pragma unroll
    for (int i = 0; i < 4; ++i) {
        const int e0 = 512 * i + 8 * lane;
        const f32x4 ga = *(const f32x4*)(g + e0), gb = *(const f32x4*)(g + e0 + 4), ba = *(const f32x4*)(b + e0), bb = *(const f32x4*)(b + e0 + 4);
        f32x4 ya, yb;
#pragma unroll
        for (int j = 0; j < 4; ++j) { ya[j] = (v[8 * i + j] - mu) * rstd * ga[j] + ba[j]; yb[j] = (v[8 * i + 4 + j] - mu) * rstd * gb[j] + bb[j]; }
        *(f32x4*)(dstf + e0) = ya; *(f32x4*)(dstf + e0 + 4) = yb;
        if (dstb) { u32x4 wv; wv.x = pk2(ya[0], ya[1]); wv.y = pk2(ya[2], ya[3]); wv.z = pk2(yb[0], yb[1]); wv.w = pk2(yb[2], yb[3]); *(u32x4*)(dstb + e0) = wv; }
    }
}
template <class GP> DI void ln_row16(const float (&v)[32], GP g, GP b, float* dstf, bf16_t* dstb, unsigned char* dst8, int lane) {
    float s = 0.f;
#pragma unroll
    for (int i = 0; i < 32; ++i) s += v[i];
    const float mu = wave_sum(s) * (1.0f / 2048.0f);
    float qv = 0.f;
#pragma unroll
    for (int i = 0; i < 32; ++i) { const float d = v[i] - mu; qv += d * d; }
    const float rstd = __builtin_amdgcn_rsqf(wave_sum(qv) * (1.0f / 2048.0f) + LN_EPS);
#pragma unroll
    for (int j = 0; j < 8; ++j) {
        const int e0 = 256 * j + 4 * lane;
        const f32x4 ga = *(const f32x4 __attribute__((address_space(3)))*)(g + e0), ba = *(const f32x4 __attribute__((address_space(3)))*)(b + e0);
        f32x4 ya;
#pragma unroll
        for (int e = 0; e < 4; ++e) ya[e] = (v[4 * j + e] - mu) * rstd * ga[e] + ba[e];
        if (dstf) __builtin_nontemporal_store(ya, (f32x4*)(dstf + e0));
        if (dstb) { u32x2 wv; wv.x = pk2(ya[0], ya[1]); wv.y = pk2(ya[2], ya[3]); __builtin_nontemporal_store(wv, (u32x2*)(dstb + e0));
            __builtin_nontemporal_store(pk4_f8(ya[0], ya[1], ya[2], ya[3], F8_ACT), (unsigned*)(dst8 + e0)); }
    }
}
DI void phase_ln(const Ctx& c, const bf16_t* src, const float* g, const float* b, float* stats, bf16_t* dstb) {
    LAS float* pg = (LAS float*)c.lds; LAS float* pb = pg + DM;
    for (int e = c.tid * 4; e < DM; e += NTHREADS * 4) { *(LAS f32x4*)(pg + e) = *(const f32x4*)(g + e); *(LAS f32x4*)(pb + e) = *(const f32x4*)(b + e); }
    __syncthreads();
    for (int row = c.bid * 8 + c.wave; row < M_TOK; row += c.G * 8) {
        float v[32];
        const bf16_t* sp = src + (size_t)row * DM;
#pragma unroll
        for (int i = 0; i < 4; ++i) { const u32x4 a = *(const u32x4*)(sp + 512 * i + 8 * c.lane);
            v[8 * i] = bf_lo(a.x); v[8 * i + 1] = bf_hi(a.x); v[8 * i + 2] = bf_lo(a.y); v[8 * i + 3] = bf_hi(a.y); v[8 * i + 4] = bf_lo(a.z); v[8 * i + 5] = bf_hi(a.z); v[8 * i + 6] = bf_lo(a.w); v[8 * i + 7] = bf_hi(a.w); }
        float s = 0.f;
#pragma unroll
        for (int i = 0; i < 32; ++i) s += v[i];
        const float mu = wave_sum(s) * (1.0f / 2048.0f);
        float qv = 0.f;
#pragma unroll
        for (int i = 0; i < 32; ++i) { const float d = v[i] - mu; qv += d * d; }
        const float rstd = __builtin_amdgcn_rsqf(wave_sum(qv) * (1.0f / 2048.0f) + LN_EPS);
        if (c.lane == 0) { f32x2 st = {mu, rstd}; *(f32x2*)(stats + 2 * (size_t)row) = st; }
        bf16_t* db = dstb + (size_t)row * DM;
#pragma unroll
        for (int i = 0; i < 4; ++i) {
            const int e0 = 512 * i + 8 * c.lane;
            const f32x4 ga = *(const LAS f32x4*)(pg + e0), gb = *(const LAS f32x4*)(pg + e0 + 4), ba = *(const LAS f32x4*)(pb + e0), bb = *(const LAS f32x4*)(pb + e0 + 4);
            float y[8];
#pragma unroll
            for (int j = 0; j < 4; ++j) { y[j] = (v[8 * i + j] - mu) * rstd * ga[j] + ba[j]; y[4 + j] = (v[8 * i + 4 + j] - mu) * rstd * gb[j] + bb[j]; }
            u32x4 wv; wv.x = pk2(y[0], y[1]); wv.y = pk2(y[2], y[3]); wv.z = pk2(y[4], y[5]); wv.w = pk2(y[6], y[7]); *(u32x4*)(db + e0) = wv;
        }
    }
}

constexpr int SBA_K = 0, SBA_V = 65536;
DI void sb_attn_block(const Ctx& c, int task) {
    unsigned char* ws = c.a->ws;
    LAS unsigned char* L = c.lds;
    const bf16_t* P = (const bf16_t*)(ws + WS_P); const bf16_t* VT = (const bf16_t*)(ws + WS_VT); unsigned char* MIX = ws + WS_MIX;
    const int lane = c.lane, w = c.wave, r = lane & 15, q = lane >> 4;
    const int h = task & 7, q0 = (task >> 3) * 128, win_lo = q0 >= 128 ? q0 - 128 : 0;
    {
        const unsigned char* kg = (const unsigned char*)(P + (size_t)win_lo * LDP + SC_K + h * 128);
        const unsigned char* vg = (const unsigned char*)(VT + (size_t)(h * 128) * M_TOK + win_lo);
#pragma unroll
        for (int i = 0; i < 8; ++i) {
            const int pc = w * 8 + i;
            {   const int row = pc * 4 + (lane >> 4), slot = lane & 15, gs = slot ^ (row & 15);
                __builtin_amdgcn_global_load_lds((const unsigned*)(kg + (size_t)row * (LDP * 2) + gs * 16), (LAS unsigned*)(L + SBA_K + pc * 1024), 16, 0, 0); }
            {   const int row = pc * 2 + (lane >> 5), slot = lane & 31, gs = slot ^ (row & 15);
                __builtin_amdgcn_global_load_lds((const unsigned*)(vg + (size_t)row * (M_TOK * 2) + gs * 16), (LAS unsigned*)(L + SBA_V + pc * 1024), 16, 0, 0); }
        }
        asm volatile("s_waitcnt vmcnt(0)" ::: "memory");
        __syncthreads();
    }
    const int t0 = q0 + 16 * w, tq = t0 + r;
    bf16x8 qf[4];
#pragma unroll
    for (int ks = 0; ks < 4; ++ks) qf[ks] = *(const bf16x8*)(P + (size_t)tq * LDP + SC_Q + h * 128 + 32 * ks + 8 * q);
    f32x4 ot[8];
#pragma unroll
    for (int dt = 0; dt < 8; ++dt) ot[dt] = (f32x4){0.f, 0.f, 0.f, 0.f};
    float R = 0.f;
    const float sc = 0.08838834764831845f * 1.44269504088896f;
#pragma unroll 1
    for (int kb = (t0 + 15) >> 5; kb >= 0; --kb) {
        const int k0 = kb * 32;
        bf16x8 kf[2][4], vf[8];
        if (k0 >= win_lo) {
            const int kr = k0 - win_lo;
#pragma unroll
            for (int tl = 0; tl < 2; ++tl) { const int row = kr + 16 * tl + r;
#pragma unroll
                for (int ks = 0; ks < 4; ++ks) kf[tl][ks] = *(const LAS bf16x8*)(L + SBA_K + row * 256 + (((4 * ks + q) ^ (row & 15)) * 16)); }
#pragma unroll
            for (int dt = 0; dt < 8; ++dt) { const int row = 16 * dt + r; const int g = (kr >> 3) + (q >> 1);
                const LAS unsigned char* vp = L + SBA_V + row * 512 + (q & 1) * 8;
                const s16x4 lo = *(const LAS s16x4*)(vp + ((g ^ (row & 15)) * 16)), hi = *(const LAS s16x4*)(vp + (((g + 2) ^ (row & 15)) * 16));
                vf[dt] = __builtin_shufflevector(lo, hi, 0, 1, 2, 3, 4, 5, 6, 7); }
        } else {
#pragma unroll
            for (int tl = 0; tl < 2; ++tl)
#pragma unroll
                for (int ks = 0; ks < 4; ++ks) kf[tl][ks] = *(const bf16x8*)(P + (size_t)(k0 + 16 * tl + r) * LDP + SC_K + h * 128 + 32 * ks + 8 * q);
#pragma unroll
            for (int dt = 0; dt < 8; ++dt) { const bf16_t* vp = VT + (size_t)(h * 128 + 16 * dt + r) * M_TOK + k0 + 4 * q;
                const s16x4 lo = *(const s16x4*)vp, hi = *(const s16x4*)(vp + 16);
                vf[dt] = __builtin_shufflevector(lo, hi, 0, 1, 2, 3, 4, 5, 6, 7); }
        }
        f32x4 z[2];
#pragma unroll
        for (int tl = 0; tl < 2; ++tl) {
            f32x4 acc = {0.f, 0.f, 0.f, 0.f};
#pragma unroll
            for (int ks = 0; ks < 4; ++ks) acc = MFMA16(kf[tl][ks], qf[ks], acc);
            z[tl] = acc;
        }
        float ln[2][4], zz[2][4]; bool vis[2][4];
#pragma unroll
        for (int tl = 0; tl < 2; ++tl)
#pragma unroll
            for (int e = 0; e < 4; ++e) {
                const int key = k0 + 16 * tl + 4 * q + e;
                vis[tl][e] = key < tq;
                const float x = z[tl][e] * sc;
                const float l = fminf(-x, 0.f) - __builtin_amdgcn_logf(1.0f + __builtin_amdgcn_exp2f(-fabsf(x)));
                zz[tl][e] = x; ln[tl][e] = vis[tl][e] ? l : 0.f;
            }
        float g1 = ln[1][0] + ln[1][1] + ln[1][2] + ln[1][3], g0 = ln[0][0] + ln[0][1] + ln[0][2] + ln[0][3];
        const float b1 = __shfl_xor(g1, 16), c1 = __shfl_xor(g1, 32), d1 = __shfl_xor(b1, 32);
        const float b0 = __shfl_xor(g0, 16), c0 = __shfl_xor(g0, 32), d0 = __shfl_xor(b0, 32);
        const float tot1 = g1 + b1 + c1 + d1, tot0 = g0 + b0 + c0 + d0;
        const float e1 = (q == 3) ? 0.f : (q == 2) ? b1 : (q == 1) ? (c1 + d1) : (b1 + c1 + d1);
        const float e0 = ((q == 3) ? 0.f : (q == 2) ? b0 : (q == 1) ? (c0 + d0) : (b0 + c0 + d0)) + tot1;
        float p[2][4];
        {   float run = R + e1;
#pragma unroll
            for (int e = 3; e >= 0; --e) { p[1][e] = vis[1][e] ? __builtin_amdgcn_exp2f(ln[1][e] + zz[1][e] + run) : 0.f; run += ln[1][e]; }
            run = R + e0;
#pragma unroll
            for (int e = 3; e >= 0; --e) { p[0][e] = vis[0][e] ? __builtin_amdgcn_exp2f(ln[0][e] + zz[0][e] + run) : 0.f; run += ln[0][e]; }
        }
        R += tot0 + tot1;
        const bf16x8 pb = pack8(p[0][0], p[0][1], p[0][2], p[0][3], p[1][0], p[1][1], p[1][2], p[1][3]);
#pragma unroll
        for (int dt = 0; dt < 8; ++dt) ot[dt] = MFMA16(vf[dt], pb, ot[dt]);
        if (__all(R < -40.0f)) break;
    }
#pragma unroll
    for (int dt = 0; dt < 8; ++dt)
        *(unsigned*)(MIX + (size_t)tq * MIXW + h * 128 + 16 * dt + 4 * q) = pk4_f8(ot[dt][0], ot[dt][1], ot[dt][2], ot[dt][3], F8_ACT);
    __syncthreads();
}
DI void phase_sb_attn(const Ctx& c, int layer) {
    for (int task = c.bid; task < (M_TOK / 128) * 8; task += c.G) sb_attn_block(c, task);
#ifndef REP_MEMATT
#define REP_MEMATT 1
#endif
#pragma unroll 1
    for (int rm_ = 0; rm_ < REP_MEMATT; ++rm_) mem_attn_all(c, layer, SC_QM, c.bid, c.G);
}
template <int N> DI void topk_insert(float (&L)[N], float x) {
#pragma unroll
    for (int i = N - 1; i >= 1; --i) L[i] = __builtin_amdgcn_fmed3f(L[i - 1], L[i], x);
    L[0] = fmaxf(L[0], x);
}
DI float key_of(float v, int idx) { return __uint_as_float((__float_as_uint(v) & ~127u) | (unsigned)(127 - idx)); }
DI int idx_of(float k) { return 127 - (int)(__float_as_uint(k) & 127u); }
DI float val_of(float k) { return __uint_as_float(__float_as_uint(k) & ~127u); }
DI float gelu_erf(float x) {
    const float ax = fabsf(x) * 0.70710678118654752f;
    const float t = __builtin_amdgcn_rcpf(1.0f + 0.3275911f * ax);
    const float poly = ((((1.061405429f * t - 1.453152027f) * t + 1.421413741f) * t - 0.284496736f) * t + 0.254829592f) * t;
    const float er = 1.0f - poly * __expf(-ax * ax);
    return 0.5f * x * (1.0f + (x < 0.f ? -er : er));
}
template <int BITS> struct RowBits;
template <> struct RowBits<6> { u32x2 a, b, cc;
    DI void load(const unsigned char* tab, int ex, int lane) { const u32x2* rp = (const u32x2*)(tab + (size_t)ex * 1536 + 24 * lane); a = rp[0]; b = rp[1]; cc = rp[2]; }
    DI void decode(float (&d)[32]) const { const u32x6 pk = {a.x, a.y, b.x, b.y, cc.x, cc.y}; const f32x32 t = __builtin_amdgcn_cvt_scalef32_pk32_f32_fp6(pk, 1.0f);
        _Pragma("unroll") for (int i = 0; i < 32; ++i) d[i] = t[i]; } };
template <> struct RowBits<4> { u32x4 a;
    DI void load(const unsigned char* tab, int ex, int lane) { a = *(const u32x4*)(tab + (size_t)ex * 1024 + 16 * lane); }
    DI void decode(float (&d)[32]) const { fp4_unpack32(a, d); } };
constexpr int PK_EID = 0, PK_GATE = 8192;
DI void phase_peer(const Ctx& c, int layer, const float* g1, const float* b1, const float* lg, const float* lb, float* dstf) {
    unsigned char* ws = c.a->ws;
    const float* SC = (const float*)(ws + WS_SC);
    const bf16_t* T1 = (const bf16_t*)(ws + WS_F1);
    const unsigned char* UT = ws + WS_UT + (size_t)layer * 16384 * UROW;
    const unsigned char* VTB = ws + WS_VTAB + (size_t)layer * 16384 * VROW;
    const float* USC = (const float*)(ws + WS_USC) + layer * 16384; const float* VSC = (const float*)(ws + WS_VSC) + layer * 16384;
    bf16_t* XB = (bf16_t*)(ws + WS_XB);
    LAS int* eid = (LAS int*)(c.lds + PK_EID); LAS float* gat = (LAS float*)(c.lds + PK_GATE);
    const int lane = c.lane, w = c.wave;
    LAS float* pg1 = (LAS float*)(c.lds + 16384); LAS float* pb1 = pg1 + DM; LAS float* pg2 = pb1 + DM; LAS float* pb2 = pg2 + DM;
    LAS float* pc1 = pb2 + DM; LAS float* pc2 = pc1 + 1024; LAS float* stl = pc2 + 1024;
    const float* c12 = (const float*)(ws + WS_C12) + (size_t)layer * 2 * 1024;
    for (int e = c.tid * 4; e < 2048; e += NTHREADS * 4) *(LAS f32x4*)(pc1 + e) = *(const f32x4*)(c12 + e);
    for (int e = c.tid * 4; e < DM; e += NTHREADS * 4) { *(LAS f32x4*)(pg1 + e) = *(const f32x4*)(g1 + e); *(LAS f32x4*)(pb1 + e) = *(const f32x4*)(b1 + e); *(LAS f32x4*)(pg2 + e) = *(const f32x4*)(lg + e); *(LAS f32x4*)(pb2 + e) = *(const f32x4*)(lb + e); }
    __syncthreads();
    for (int tb = c.bid; tb < M_TOK / 64; tb += c.G) {
        const int tok0 = tb * 64;
        if (w < 4) __builtin_amdgcn_s_setprio(2);
#pragma unroll 1
        for (int t4 = 0; t4 < 8; t4 += 4) {
            u32x2 raw[4][8];
#pragma unroll
            for (int q = 0; q < 4; ++q) { const bf16_t* xp = T1 + (size_t)(tok0 + w * 8 + t4 + q) * DM + 4 * lane;
#pragma unroll
                for (int j = 0; j < 8; ++j) raw[q][j] = *(const u32x2*)(xp + 256 * j); }
            asm volatile("" ::: "memory");
#pragma unroll
            for (int q = 0; q < 4; ++q) {
                float tv[32];
#pragma unroll
                for (int j = 0; j < 8; ++j) { const u32x2 ta = raw[q][j]; tv[4 * j] = bf_lo(ta.x); tv[4 * j + 1] = bf_hi(ta.x); tv[4 * j + 2] = bf_lo(ta.y); tv[4 * j + 3] = bf_hi(ta.y); }
                float s = 0.f;
#pragma unroll
                for (int i = 0; i < 32; ++i) s += tv[i];
                const float mu = wave_sum(s) * (1.0f / 2048.0f);
                float qv = 0.f;
#pragma unroll
                for (int i = 0; i < 32; ++i) { const float d = tv[i] - mu; qv += d * d; }
                const float rstd = __builtin_amdgcn_rsqf(wave_sum(qv) * (1.0f / 2048.0f) + LN_EPS);
                if (lane == 0) { stl[2 * (w * 8 + t4 + q)] = mu; stl[2 * (w * 8 + t4 + q) + 1] = rstd; }
            }
        }
#ifndef REP_TOPK
#define REP_TOPK 1
#endif
#pragma unroll 1
        for (int rtk_ = 0; rtk_ < REP_TOPK; ++rtk_)
        {
            const int pr = w * 32 + (lane & 31), tl = pr >> 2, hd = pr & 3, hf = lane >> 5;
            const float* sp = SC + (size_t)(tok0 + tl) * 1024 + hd * 256 + hf * 128;
            LAS float* q1 = pc1 + hd * 256 + hf * 128; LAS float* q2 = pc2 + hd * 256 + hf * 128;
            const float tmu = stl[2 * tl], trs = stl[2 * tl + 1];
            float L[8];
#pragma unroll
            for (int i = 0; i < 8; ++i) L[i] = -3.0e38f;
#pragma unroll 1
            for (int i0 = 0; i0 < 128; i0 += 32) {
                f32x4 a8[8];
#pragma unroll
                for (int q = 0; q < 8; ++q) a8[q] = *(const f32x4*)(sp + i0 + 4 * q);
                asm volatile("" ::: "memory");
#pragma unroll
                for (int q = 0; q < 8; ++q) {
                    const int i = i0 + 4 * q;
                    const f32x4 ca = *(const LAS f32x4*)(q1 + i), da = *(const LAS f32x4*)(q2 + i);
#pragma unroll
                    for (int j = 0; j < 4; ++j) topk_insert<8>(L, key_of((a8[q][j] - tmu * ca[j]) * trs + da[j], i + j));
                }
            }
            float L1[8], L2[8];
#pragma unroll
            for (int i = 0; i < 8; ++i) { auto r = __builtin_amdgcn_permlane32_swap(__float_as_uint(L[i]), __float_as_uint(L[i]), false, false); L1[i] = __uint_as_float(r[0]); L2[i] = __uint_as_float(r[1]); }
            float cv[8], ce[8];
#pragma unroll
            for (int i = 0; i < 8; ++i) { cv[i] = -3.0e38f; ce[i] = 0.f; }
#pragma unroll
            for (int i = 0; i < 8; ++i)
#pragma unroll
                for (int j = 0; j < 8; ++j)
                    if ((i + 1) * (j + 1) <= 8) {
                        float v = val_of(L1[i]) + val_of(L2[j]);
                        float ex = __int_as_float(idx_of(L1[i]) * 128 + idx_of(L2[j]));
#pragma unroll
                        for (int k = 0; k < 8; ++k) { const bool gt = v > cv[k]; const float tv = gt ? cv[k] : v, te = gt ? ce[k] : ex; cv[k] = gt ? v : cv[k]; ce[k] = gt ? ex : ce[k]; v = tv; ex = te; }
                    }
            float sm = 0.f, pe[8];
#pragma unroll
            for (int k = 0; k < 8; ++k) { pe[k] = __expf(cv[k] - cv[0]); sm += pe[k]; }
            const float inv = 1.0f / sm;
            if (lane < 32)
#pragma unroll
            for (int k = 0; k < 8; ++k) { eid[tl * 32 + hd * 8 + k] = __float_as_int(ce[k]); gat[tl * 32 + hd * 8 + k] = pe[k] * inv; }
        }
        if (w < 4) __builtin_amdgcn_s_setprio(0);
#define PEER_LD4(R, TAB, B0) _Pragma("unroll") for (int k = 0; k < 4; ++k) R[k].load(TAB, __builtin_amdgcn_readlane(my_e, (B0) + k), lane); asm volatile("" ::: "memory")
#define PEER_U4(R, B0) do { float s4[4]; \
                _Pragma("unroll") for (int k = 0; k < 4; ++k) { float d[32]; R[k].decode(d); f32x2 a0 = {0.f, 0.f}, a1 = {0.f, 0.f}; \
                    _Pragma("unroll") for (int i = 0; i < 32; i += 4) { a0 = __builtin_elementwise_fma(f32x2{xv[i], xv[i + 1]}, f32x2{d[i], d[i + 1]}, a0); a1 = __builtin_elementwise_fma(f32x2{xv[i + 2], xv[i + 3]}, f32x2{d[i + 2], d[i + 3]}, a1); } \
                    s4[k] = (a0.x + a0.y) + (a1.x + a1.y); } \
                const float r4 = wave_sum4(s4[0], s4[1], s4[2], s4[3]); \
                _Pragma("unroll") for (int k = 0; k < 4; ++k) { const float sk = __int_as_float(__builtin_amdgcn_readlane(__float_as_int(r4), 16 * k)); if (lane == (B0) + k) hsum = sk; } } while (0)
#define PEER_V4(R, B0) do { _Pragma("unroll") for (int k = 0; k < 4; ++k) { const float ak = __int_as_float(__builtin_amdgcn_readlane(__float_as_int(act), (B0) + k)); float d[32]; R[k].decode(d); \
                    _Pragma("unroll") for (int i = 0; i < 32; i += 2) { const f32x2 o = __builtin_elementwise_fma(f32x2{ak, ak}, f32x2{d[i], d[i + 1]}, f32x2{ov[i], ov[i + 1]}); ov[i] = o.x; ov[i + 1] = o.y; } } } while (0)
        u32x2 traw[8];
        {   const bf16_t* xp = T1 + (size_t)(tok0 + w * 8) * DM + 4 * lane;
#pragma unroll
            for (int j = 0; j < 8; ++j) traw[j] = *(const u32x2*)(xp + 256 * j); }
        int my_e = eid[(w * 8) * 32 + (lane & 31)];
        RowBits<PEER_UBITS> ra[4], rb[4];
        PEER_LD4(ra, UT, 0);
#pragma unroll 1
        for (int tt = 0; tt < 8; ++tt) {
            const int tl = w * 8 + tt, tok = tok0 + tl, tln = w * 8 + (tt < 7 ? tt + 1 : 7);
            float xv[32];
            const f32x2 st = {stl[2 * tl], stl[2 * tl + 1]};
            {   int l4 = 4 * lane; asm volatile("" : "+v"(l4));
#pragma unroll
                for (int j = 0; j < 8; ++j) {
                    const u32x2 ta = traw[j];
                    const f32x4 gg = *(const LAS f32x4*)(pg1 + l4 + 256 * j), bb = *(const LAS f32x4*)(pb1 + l4 + 256 * j);
                    xv[4 * j] = (bf_lo(ta.x) - st.x) * st.y * gg[0] + bb[0]; xv[4 * j + 1] = (bf_hi(ta.x) - st.x) * st.y * gg[1] + bb[1];
                    xv[4 * j + 2] = (bf_lo(ta.y) - st.x) * st.y * gg[2] + bb[2]; xv[4 * j + 3] = (bf_hi(ta.y) - st.x) * st.y * gg[3] + bb[3]; } }
            if (tt < 7) {   const bf16_t* xp = T1 + (size_t)(tok0 + tln) * DM + 4 * lane;
#pragma unroll
                for (int j = 0; j < 8; ++j) traw[j] = *(const u32x2*)(xp + 256 * j); }
            const float my_g = gat[tl * 32 + (lane & 31)];
            const float my_us = USC[my_e], my_vs = VSC[my_e];
            float hsum = 0.f;
            RowBits<PEER_VBITS> va[4], vb[4];
#pragma unroll 1
            for (int e0 = 0; e0 < 24; e0 += 8) { PEER_LD4(rb, UT, e0 + 4); PEER_U4(ra, e0); PEER_LD4(ra, UT, e0 + 8); PEER_U4(rb, e0 + 4); }
            PEER_LD4(rb, UT, 28); PEER_U4(ra, 24);
            PEER_LD4(va, VTB, 0);
            PEER_U4(rb, 28);
            const float act = gelu_erf(hsum * my_us) * my_g * my_vs;
            float ov[32];
#pragma unroll
            for (int i = 0; i < 32; ++i) ov[i] = 0.f;
#pragma unroll 1
            for (int e0 = 0; e0 < 24; e0 += 8) { PEER_LD4(vb, VTB, e0 + 4); PEER_V4(va, e0); PEER_LD4(va, VTB, e0 + 8); PEER_V4(vb, e0 + 4); }
            PEER_LD4(vb, VTB, 28); PEER_V4(va, 24);
            if (tt < 7) { my_e = eid[tln * 32 + (lane & 31)]; PEER_LD4(ra, UT, 0); }
            PEER_V4(vb, 28);
#pragma unroll
            for (int i = 0; i < 32; ++i) ov[i] += DN_ALPHA * xv[i];
            {   LAS float* g2_ = pg2; LAS float* b2_ = pb2; asm volatile("" : "+v"(g2_), "+v"(b2_));
                ln_row16<LAS float*>(ov, g2_, b2_, dstf ? dstf + (size_t)tok * DM : nullptr, dstf ? (bf16_t*)nullptr : XB + (size_t)tok * DM, ws + WS_X8 + (size_t)tok * DM, lane); }
        }
        __syncthreads();
    }
}
#ifndef REP_PRO
#define REP_PRO 1
#endif
#ifndef REP_GEMM0
#define REP_GEMM0 1
#endif
#ifndef REP_PREP
#define REP_PREP 1
#endif
#ifndef REP_SB
#define REP_SB 1
#endif
#ifndef REP_SCAN
#define REP_SCAN 1
#endif
#ifndef REP_SCANB
#define REP_SCANB 1
#endif
#ifndef REP_SCANC
#define REP_SCANC 1
#endif
#ifndef REP_GOUT
#define REP_GOUT 1
#endif
#ifndef REP_GEMM4
#define REP_GEMM4 1
#endif
#ifndef REP_LN
#define REP_LN 1
#endif
#ifndef REP_GEMM6
#define REP_GEMM6 1
#endif
#ifndef REP_PEER
#define REP_PEER 1
#endif
#ifndef REP_PRO
#define REP_PRO 1
#endif
#ifndef REP_GEMM0
#define REP_GEMM0 1
#endif
#ifndef REP_PREP
#define REP_PREP 1
#endif
#ifndef REP_SB
#define REP_SB 1
#endif
#ifndef REP_SCAN
#define REP_SCAN 1
#endif
#ifndef REP_SCANB
#define REP_SCANB 1
#endif
#ifndef REP_SCANC
#define REP_SCANC 1
#endif
#ifndef REP_GOUT
#define REP_GOUT 1
#endif
#ifndef REP_GEMM4
#define REP_GEMM4 1
#endif
#ifndef REP_LN
#define REP_LN 1
#endif
#ifndef REP_GEMM6
#define REP_GEMM6 1
#endif
#ifndef REP_PEER
#define REP_PEER 1
#endif
#ifndef REP_PBS
#define REP_PBS 1
#endif
#ifndef REP_OTH
#define REP_OTH 1
#endif
#ifndef REP_CT
#define REP_CT 1
#endif
#ifndef EN_PRO
#define EN_PRO 1
#endif
#ifndef EN_GEMM0
#define EN_GEMM0 1
#endif
#ifndef EN_PREP
#define EN_PREP 1
#endif
#ifndef EN_SB
#define EN_SB 1
#endif
#ifndef EN_SCAN
#define EN_SCAN 1
#endif
#ifndef EN_GOUT
#define EN_GOUT 1
#endif
#ifndef EN_GEMM4
#define EN_GEMM4 1
#endif
#ifndef EN_LN
#define EN_LN 1
#endif
#ifndef EN_GEMM6
#define EN_GEMM6 1
#endif
#ifndef EN_PEER
#define EN_PEER 1
#endif
constexpr int NPL = 10, NPH = 1 + NPL * DEPTH;
__host__ __device__ constexpr bool phase_exists(int ph) { return ph == 0 || !(((((ph - 1) / NPL) & 1) != 0) && (((ph - 1) % NPL) >= 2) && (((ph - 1) % NPL) <= 5)) && (((ph - 1) % NPL) != 7) && (((ph - 1) % NPL) != 5); }

__global__ void __launch_bounds__(NTHREADS, 2) hybrid_fwd(Args args) {
    extern __shared__ __attribute__((aligned(16))) unsigned char lds_raw[];
    Ctx c;
    c.a = (ArgsP)__builtin_amdgcn_kernarg_segment_ptr(); c.lds = (LAS unsigned char*)lds_raw; c.tid = threadIdx.x; c.lane = c.tid & 63; c.wave = __builtin_amdgcn_readfirstlane(c.tid >> 6); c.G = gridDim.x; c.bid = blockIdx.x;
    unsigned char* ws = c.a->ws;
    const int lo = c.a->ph_lo, hi = c.a->ph_hi;
    const bool fused = (hi - lo) > 1;
    volatile LAS unsigned* xbst = (volatile LAS unsigned*)(c.lds + LDS_CTL);
    if (c.tid < 4) xbst[c.tid] = 0u;
    __syncthreads();
    XcdBarrier bar; bar.bar = (unsigned*)(ws + WS_CTL); bar.x = 0; bar.st = xbst;
    if (fused) bar = xcd_barrier_post((unsigned*)(ws + WS_CTL), xbst);
#define IN(k) (lo <= (k) && (k) < hi)
#define FRESH() do { int t_ = threadIdx.x; asm volatile("" : "+v"(t_)); c.tid = t_; c.lane = t_ & 63; c.wave = __builtin_amdgcn_readfirstlane(t_ >> 6); ArgsP a_ = (ArgsP)__builtin_amdgcn_kernarg_segment_ptr(); asm volatile("" : "+s"(a_)); c.a = a_; ws = a_->ws; } while (0)
#ifndef SEAM_REP
#define SEAM_REP 1
#endif
#define SEAM(k) do { if (fused && (k) + 1 < hi) { for (int sr_ = 0; sr_ < SEAM_REP; ++sr_) xcd_barrier(bar); } } while (0)
    LAS unsigned char* glds = (LAS unsigned char*)c.lds;

    if (IN(0)) {
#if EN_PRO
#pragma unroll 1
 for (int rep_ = 0; rep_ < REP_PRO; ++rep_) { if (rep_) __syncthreads();
 FRESH(); phase_prologue(c);
 }
#endif
 SEAM(0); }

#pragma unroll 1
    for (int L = 0; L < DEPTH; ++L) {
        const int base = 1 + NPL * L, li = L >> 1;
        const bool gdn = (L & 1) == 0;

        if (IN(base + 0)) {
#if EN_GEMM0
#pragma unroll 1
 for (int rep_ = 0; rep_ < REP_GEMM0; ++rep_) { if (rep_) __syncthreads();
            FRESH();
            {   pg8::MultiOrder S; S.G = c.G; S.c = c.bid; S.nj = 0;
                const bf16_t* const X8p = (const bf16_t*)(ws + WS_X8); bf16_t* const Pp = (bf16_t*)(ws + WS_P);
                pg8::Job jz{X8p, X8p, Pp, 0, 0, 0};
                S.j[0] = jz; S.j[1] = jz; S.j[2] = jz; S.j[3] = jz;
                if (gdn) { S.j[0] = pg8::Job{X8p, (const bf16_t*)(ws + WS_WG + (size_t)li * GDN_NP * DM), Pp, M_TOK, GDN_NP, LDP}; S.nj = 1; }
                else { S.j[0] = pg8::Job{X8p, (const bf16_t*)(ws + WS_WSB + (size_t)li * SB_NP * DM), Pp, M_TOK, SB_NP, LDP};
                       S.j[1] = pg8::Job{(const bf16_t*)(ws + WS_WSBV + (size_t)li * 1024 * DM), X8p, (bf16_t*)(ws + WS_VT), 1024, M_TOK, M_TOK}; S.nj = 2; }
                if (L == 0) {
                    S.j[1] = pg8::Job{(const bf16_t*)(ws + WS_MEMB), (const bf16_t*)(ws + WS_WK), (bf16_t*)(ws + WS_KM), NMEM, 2048, 2048};
                    S.j[2] = pg8::Job{(const bf16_t*)(ws + WS_WV), (const bf16_t*)(ws + WS_MEMB), (bf16_t*)(ws + WS_VMT), 2048, NMEM, NMEM}; S.nj = 3; }
                pg8::Gemm g{X8p, X8p, M_TOK, 256, DM / 2, E8_WIN, E8_ACT};
                pg8::EpiBf16Multi E{S.j[0].O, S.j[1].O, S.j[2].O, S.j[3].O, S.j[0].ldc, S.j[1].ldc, S.j[2].ldc, S.j[3].ldc};
                pg8::gemm_phase<pg8::EpiBf16Multi, pg8::MultiOrder, false, true, E8_WIN, E8_ACT>(glds, g, S, E, nullptr); }
            {
                const int units = (gdn ? (M_TOK / 256) * (GDN_NP / 256) : (M_TOK / 256) * (SB_NP / 256) + (1024 / 256) * (M_TOK / 256)) + (L == 0 ? (NMEM / 256) * (2048 / 256) + (2048 / 256) * (NMEM / 256) : 0);
                const int rem = units % c.G;
                peer_c12_finalize(c, L, rem == 0 ? c.bid : c.bid - rem, rem == 0 ? c.G : c.G - rem);
                convert_tables_early(c, L, rem == 0 ? c.bid : c.bid - rem, rem == 0 ? c.G : c.G - rem); }
 }
#endif
            SEAM(base + 0);
        }
        if (IN(base + 1)) {

#if EN_PREP
#pragma unroll 1
 for (int rep_ = 0; rep_ < REP_PREP; ++rep_) { if (rep_) __syncthreads();
 FRESH(); if (gdn) phase_gdn_prep(c, li);
 }
#endif
#if EN_SB
#pragma unroll 1
 for (int rep_ = 0; rep_ < REP_SB; ++rep_) { if (rep_) __syncthreads();
 FRESH(); if (!gdn) phase_sb_attn(c, L);
 }
#endif

            SEAM(base + 1);
        }
        if (gdn && IN(base + 2)) {
#if EN_SCAN
#pragma unroll 1
            for (int rep_ = 0; rep_ < REP_SCAN; ++rep_) { if (rep_) __syncthreads();
            FRESH();
            for (int u = c.bid; u < 8 * SCAN_NG; u += c.G) { scan_pass_a(c, u); __syncthreads(); } }
#endif
            SEAM(base + 2);
        }
        if (gdn && IN(base + 3)) {
#if EN_SCAN
#pragma unroll 1
            for (int rep_ = 0; rep_ < REP_SCANB; ++rep_) { if (rep_) __syncthreads();
            FRESH();
            if (c.G > 8) { if (c.bid < 8) { for (int rb_ = 0; rb_ < REP_PBS; ++rb_) { if (rb_) __syncthreads(); scan_pass_b(c, c.bid); } } else { mem_attn_all(c, L, GC_QM, c.bid - 8, c.G - 8); if (REP_OTH > 1) { __syncthreads(); mem_attn_all(c, L, GC_QM, c.bid - 8, c.G - 8); } if (REP_OTH > 2) { __syncthreads(); mem_attn_all(c, L, GC_QM, c.bid - 8, c.G - 8); } for (int rb_ = 0; rb_ < REP_CT; ++rb_) { if (rb_) __syncthreads(); convert_tables(c, L, c.bid - 8, c.G - 8); } } }
            else { for (int hd = c.bid; hd < 8; hd += c.G) scan_pass_b(c, hd); mem_attn_all(c, L, GC_QM, c.bid, c.G); convert_tables(c, L, c.bid, c.G); } }
#endif
            SEAM(base + 3);
        }
        if (gdn && IN(base + 4)) {
#if EN_SCAN
#pragma unroll 1
            for (int rep_ = 0; rep_ < REP_SCANC; ++rep_) { if (rep_) __syncthreads();
            FRESH();
            for (int u = c.bid; u < 8 * SCAN_NG; u += c.G) { scan_pass_c(c, u); __syncthreads(); gdn_gate_group(c, c.a->gdn_onorm + li * 128, u / SCAN_NG, (u % SCAN_NG) * SCAN_G * 64); } }
#endif
            SEAM(base + 4);
        }
        if (false && gdn && IN(base + 5)) {
#if EN_GOUT
#pragma unroll 1
 for (int rep_ = 0; rep_ < REP_GOUT; ++rep_) { if (rep_) __syncthreads();
 FRESH(); phase_gdn_out(c, li);
 }
#endif
 SEAM(base + 5); }
        if (IN(base + 6)) {
#if EN_GEMM4
#pragma unroll 1
 for (int rep_ = 0; rep_ < REP_GEMM4; ++rep_) { if (rep_) __syncthreads();
            FRESH();
            pg8::Gemm g{(const bf16_t*)(ws + WS_MIX), (const bf16_t*)(ws + WS_WO + (size_t)L * DM * MIXW), M_TOK, DM, MIXW / 2, E8_WOUT, E8_ACT};
            pg8::StaticOrder S; S.init(M_TOK, DM, c.G, c.bid);
            pg8::EpiResid E{(const bf16_t*)(ws + WS_XB), (bf16_t*)(ws + WS_F1), DM, DN_ALPHA};
            pg8::gemm_phase<pg8::EpiResid, pg8::StaticOrder, false, true, E8_WOUT, E8_ACT>(glds, g, S, E, nullptr);
 }
#endif
            SEAM(base + 6);
        }
        if (IN(base + 8)) {
#if EN_GEMM6
#pragma unroll 1
 for (int rep_ = 0; rep_ < REP_GEMM6; ++rep_) { if (rep_) __syncthreads();
            FRESH();
            pg8::Gemm g{(const bf16_t*)(ws + WS_F1), (const bf16_t*)(ws + WS_WP) + (size_t)L * 1024 * DM, M_TOK, 1024, DM};
            pg8::StaticOrder S; S.init(M_TOK, 1024, c.G, c.bid);
            pg8::EpiF32 E{(float*)(ws + WS_SC), 1024};
            pg8::gemm_phase<pg8::EpiF32, pg8::StaticOrder>(glds, g, S, E, nullptr);
 }
#endif
            SEAM(base + 8);
        }
        if (IN(base + 9)) {
#if EN_PEER
#pragma unroll 1
 for (int rep_ = 0; rep_ < REP_PEER; ++rep_) { if (rep_) __syncthreads();
FRESH();             phase_peer(c, L, c.a->ln_mix_g + L * DM, c.a->ln_mix_b + L * DM, c.a->ln_ffn_g + L * DM, c.a->ln_ffn_b + L * DM, (L == DEPTH - 1) ? c.a->out : (float*)nullptr);
 }
#endif
            SEAM(base + 9);
        }
    }
#undef IN
#undef SEAM
}

#ifndef MK_FUSED
#define MK_FUSED 1
#endif
extern "C" void kernel_launch(void* const* d_in, const int* in_sizes, int n_in, void* d_out, int out_size, void* d_ws, size_t ws_size, hipStream_t stream) {
    static int grid = 0;
    if (grid == 0) {
        if (n_in != 18 || out_size != M_TOK * DM || ws_size < WS_END) { fprintf(stderr, "kernel_launch: unexpected shapes (n_in %d out %d ws %zu need %zu)\n", n_in, out_size, ws_size, (size_t)WS_END); grid = -1; return; }
        int dev = 0, cus = 0, per_cu = 0;
        if (hipGetDevice(&dev) != hipSuccess || hipDeviceGetAttribute(&cus, hipDeviceAttributeMultiprocessorCount, dev) != hipSuccess) { grid = -1; return; }
        if (hipFuncSetAttribute((const void*)hybrid_fwd, hipFuncAttributeMaxDynamicSharedMemorySize, LDS_BYTES) != hipSuccess) { fprintf(stderr, "kernel_launch: hipFuncSetAttribute failed\n"); grid = -1; return; }
        if (hipOccupancyMaxActiveBlocksPerMultiprocessor(&per_cu, (const void*)hybrid_fwd, NTHREADS, LDS_BYTES) != hipSuccess || per_cu < 1) { fprintf(stderr, "kernel_launch: occupancy query says %d\n", per_cu); (void)hipGetLastError(); }
        grid = cus;
    }
    if (grid < 0) return;
    hipMemsetAsync((char*)d_ws + WS_CTL, 0, WS_CTL_BYTES, stream);
    Args a{};
    a.x = (const float*)d_in[0]; a.mem = (const float*)d_in[1]; a.gdn_w_in = (const float*)d_in[2]; a.gdn_conv = (const float*)d_in[3]; a.gdn_a_log = (const float*)d_in[4];
    a.gdn_dt_bias = (const float*)d_in[5]; a.gdn_onorm = (const float*)d_in[6]; a.sb_w_in = (const float*)d_in[7]; a.mem_w_kv = (const float*)d_in[8]; a.w_out = (const float*)d_in[9];
    a.ln_mix_g = (const float*)d_in[10]; a.ln_mix_b = (const float*)d_in[11]; a.peer_w_q = (const float*)d_in[12]; a.peer_keys = (const float*)d_in[13]; a.peer_u = (const float*)d_in[14];
    a.peer_v = (const float*)d_in[15]; a.ln_ffn_g = (const float*)d_in[16]; a.ln_ffn_b = (const float*)d_in[17];
    a.out = (float*)d_out; a.ws = (unsigned char*)d_ws;
#if MK_FUSED
    a.ph_lo = 0; a.ph_hi = NPH;
    hipLaunchKernelGGL(hybrid_fwd, dim3(grid), dim3(NTHREADS), LDS_BYTES, stream, a);
#else
    for (int ph = 0; ph < NPH; ++ph) {
        if (!phase_exists(ph)) continue;
        a.ph_lo = ph; a.ph_hi = ph + 1;
        hipLaunchKernelGGL(hybrid_fwd, dim3(grid), dim3(NTHREADS), LDS_BYTES, stream, a);
    }
#endif
}
```
